# Optimizing an MI355X kernel written in HIP

```python
import math
import jax, jax.numpy as jnp
from jax import lax
import numpy as np

D_MODEL = 1024
BATCH = 4
SEQ = 4096
DEPTH = 2

M_HEADS = 4
M_DQK = 64
M_DV = 128
M_CHUNK = 64
M_CONV = 4
M_QK_W = M_HEADS * M_DQK
M_V_W = M_HEADS * M_DV

A_HEADS = 8
A_KV_HEADS = 2
A_HEAD_DIM = 64
A_GROUP = A_HEADS // A_KV_HEADS
A_Q_W = A_HEADS * A_HEAD_DIM
A_KV_W = A_KV_HEADS * A_HEAD_DIM
WINDOW = 128

N_BUCKETS = 32
MAX_DISTANCE = 128

N_EXPERTS = 16
N_GROUPS = 4
EXPERTS_PER_GROUP = N_EXPERTS // N_GROUPS
GROUP_SCORE_TOPK = 2
TOP_K = 2
D_EXPERT = 512

IN_SIZES = (M_QK_W, M_QK_W, M_V_W, M_V_W, M_HEADS, M_HEADS,
            A_Q_W, A_KV_W, A_KV_W, D_MODEL, D_MODEL)
D_IN = M_QK_W * 2 + M_V_W * 2 + M_HEADS * 2 + A_Q_W + A_KV_W * 2 + D_MODEL * 2

EPS = 1e-6
NEG_INF = -1e30

kernel_name = 'hybrid_mlstm_swa_groupmoe_block'


def _rmsnorm(x, w):
    xf = x.astype(jnp.float32)
    y = xf * lax.rsqrt(jnp.mean(xf * xf, axis=-1, keepdims=True) + EPS)
    return (y * w.astype(jnp.float32)).astype(x.dtype)


def _modulate(h, shift, scale):
    return h * (1 + scale[:, None, :]) + shift[:, None, :]


def _split_points(sizes):
    pts, acc = [], 0
    for sz in sizes[:-1]:
        acc += sz
        pts.append(acc)
    return pts


def _causal_conv(x, w, b):
    s = x.shape[1]
    xp = jnp.pad(x, ((0, 0), (M_CONV - 1, 0), (0, 0)))
    y = b
    for j in range(M_CONV):
        y = y + w[j] * xp[:, j:j + s, :]
    return y


def _t5_bucket(n):
    max_exact = N_BUCKETS // 2
    large = max_exact + (np.log(np.maximum(n, 1) / max_exact)
                         / math.log(MAX_DISTANCE / max_exact)
                         * (N_BUCKETS - max_exact)).astype(np.int32)
    large = np.minimum(large, N_BUCKETS - 1)
    return np.where(n < max_exact, n, large).astype(np.int32)


def _chunk_step(carry, inp):
    C, n, m = carry
    C_loc, n_loc, m_loc, b_last = inp
    m_new = jnp.maximum(b_last + m, m_loc)
    decay = jnp.exp(b_last + m - m_new)
    fresh = jnp.exp(m_loc - m_new)
    C_new = decay[..., None, None] * C + fresh[..., None, None] * C_loc
    n_new = decay[..., None] * n + fresh[..., None] * n_loc
    return (C_new, n_new, m_new), (C, n, m)


def _mlstm(q, k, v, i_pre, f_pre):
    b, s, _ = q.shape
    nc = s // M_CHUNK

    def heads(t, d):
        t = t.astype(jnp.float32).reshape(b, s, M_HEADS, d).transpose(0, 2, 1, 3)
        return t.reshape(b, M_HEADS, nc, M_CHUNK, d)

    def gates(t):
        return t.astype(jnp.float32).transpose(0, 2, 1).reshape(b, M_HEADS, nc, M_CHUNK)

    q = heads(q, M_DQK) * (M_DQK ** -0.5)
    k = heads(k, M_DQK)
    v = heads(v, M_DV)
    ig = gates(i_pre)
    logf = jax.nn.log_sigmoid(gates(f_pre))
    bcum = jnp.cumsum(logf, axis=-1)
    b_last = bcum[..., -1]

    w_state = b_last[..., None] - bcum + ig
    m_loc = jnp.max(w_state, axis=-1)
    a = jnp.exp(w_state - m_loc[..., None])
    C_loc = jnp.einsum('bhcl,bhcld,bhcle->bhcde', a, v, k)
    n_loc = jnp.einsum('bhcl,bhcle->bhce', a, k)

    init = (jnp.zeros((b, M_HEADS, M_DV, M_DQK), jnp.float32),
            jnp.zeros((b, M_HEADS, M_DQK), jnp.float32),
            jnp.zeros((b, M_HEADS), jnp.float32))
    xs = (jnp.moveaxis(C_loc, 2, 0), jnp.moveaxis(n_loc, 2, 0),
          jnp.moveaxis(m_loc, 2, 0), jnp.moveaxis(b_last, 2, 0))
    _, (C_prev, n_prev, m_prev) = lax.scan(_chunk_step, init, xs)
    C_prev = jnp.moveaxis(C_prev, 0, 2)
    n_prev = jnp.moveaxis(n_prev, 0, 2)
    m_prev = jnp.moveaxis(m_prev, 0, 2)

    causal = jnp.tril(jnp.ones((M_CHUNK, M_CHUNK), dtype=bool))
    d_log = jnp.where(causal, bcum[..., :, None] - bcum[..., None, :] + ig[..., None, :], -jnp.inf)
    m_inter = bcum + m_prev[..., None]
    m_row = jnp.maximum(m_inter, jnp.max(d_log, axis=-1))
    scores = jnp.einsum('bhcld,bhcsd->bhcls', q, k) * jnp.exp(d_log - m_row[..., None])
    inter = jnp.exp(m_inter - m_row)
    num = (jnp.einsum('bhcls,bhcsd->bhcld', scores, v)
           + inter[..., None] * jnp.einsum('bhcle,bhcde->bhcld', q, C_prev))
    den = scores.sum(-1) + inter * jnp.einsum('bhcle,bhce->bhcl', q, n_prev)
    h = num / jnp.maximum(jnp.abs(den), jnp.exp(-m_row))[..., None]
    return h.reshape(b, M_HEADS, s, M_DV).transpose(0, 2, 1, 3).reshape(b, s, M_V_W)


def _sliding_window_attention(q, k, v, sinks, rel_bias):
    b, s, _ = q.shape
    nb = s // WINDOW
    qb = q.reshape(b, nb, WINDOW, A_KV_HEADS, A_GROUP, A_HEAD_DIM).astype(jnp.float32)

    def band(t):
        t = t.reshape(b, s, A_KV_HEADS, A_HEAD_DIM)
        tp = jnp.pad(t, ((0, 0), (WINDOW, 0), (0, 0), (0, 0)))
        tp = tp.reshape(b, nb + 1, WINDOW, A_KV_HEADS, A_HEAD_DIM)
        return jnp.concatenate([tp[:, :-1], tp[:, 1:]], axis=2)

    kb = band(k).astype(jnp.float32)
    vb = band(v)

    q_pos = np.arange(WINDOW)[:, None]
    k_pos = np.arange(2 * WINDOW)[None, :]
    dist = q_pos + WINDOW - k_pos
    in_window = (dist >= 0) & (dist < WINDOW)
    key_valid = (np.arange(nb)[:, None] * WINDOW + np.arange(2 * WINDOW)[None, :] - WINDOW) >= 0
    mask = jnp.asarray(in_window[None] & key_valid[:, None, :])
    bucket = jnp.asarray(_t5_bucket(np.maximum(dist, 0)))
    bias = jnp.take(rel_bias.astype(jnp.float32), bucket, axis=0)
    bias = bias.transpose(2, 0, 1).reshape(A_KV_HEADS, A_GROUP, WINDOW, 2 * WINDOW)

    scores = jnp.einsum('bnqkgd,bnskd->bnkgqs', qb, kb) * (A_HEAD_DIM ** -0.5)
    scores = jnp.where(mask[None, :, None, None], scores + bias, NEG_INF)
    sink = jnp.broadcast_to(sinks.astype(jnp.float32).reshape(A_KV_HEADS, A_GROUP, 1, 1),
                            scores.shape[:-1] + (1,))
    probs = jax.nn.softmax(jnp.concatenate([scores, sink], axis=-1), axis=-1)[..., :-1]
    out = jnp.einsum('bnkgqs,bnskd->bnqkgd', probs.astype(v.dtype), vb)
    return out.reshape(b, s, A_Q_W)


def _hybrid_mixer(h, w_in, conv_w, conv_b, b_igate, b_fgate, w_mnorm, sinks, rel_bias,
                  w_br_m, w_br_a, w_out):
    z = h @ w_in
    (q_m, k_m, v_m, o_m, i_m, f_m, q_a, k_a, v_a, g_m, g_a) = jnp.split(
        z, _split_points(IN_SIZES), axis=-1)
    qk = jax.nn.silu(_causal_conv(jnp.concatenate([q_m, k_m], axis=-1), conv_w, conv_b))
    q_m, k_m = jnp.split(qk, 2, axis=-1)
    h_m = _mlstm(q_m, k_m, v_m, i_m + b_igate, f_m + b_fgate).astype(h.dtype)
    bsz, s = h_m.shape[0], h_m.shape[1]
    h_m = _rmsnorm(h_m.reshape(bsz, s, M_HEADS, M_DV), w_mnorm.reshape(M_HEADS, M_DV))
    h_m = h_m.reshape(bsz, s, M_V_W) * jax.nn.sigmoid(o_m)
    h_a = _sliding_window_attention(q_a, k_a, v_a, sinks, rel_bias)
    merged = jax.nn.sigmoid(g_m) * (h_m @ w_br_m) + jax.nn.sigmoid(g_a) * (h_a @ w_br_a)
    return merged @ w_out


def _grouped_moe(h, w_router, router_bias, w_gate, w_up, w_down):
    b, s, d = h.shape
    t = h.reshape(b * s, d)
    scores = jax.nn.sigmoid((t @ w_router).astype(jnp.float32))
    sel = scores + router_bias.astype(jnp.float32)
    grp = lax.top_k(sel.reshape(-1, N_GROUPS, EXPERTS_PER_GROUP), GROUP_SCORE_TOPK)[0].sum(-1)
    gsel = jnp.argmax(grp, axis=-1)
    gmask = jnp.repeat(gsel[:, None] == jnp.arange(N_GROUPS)[None, :], EXPERTS_PER_GROUP, axis=-1)
    _, idx = lax.top_k(jnp.where(gmask, sel, -jnp.inf), TOP_K)
    wts = jnp.take_along_axis(scores, idx, axis=-1)
    wts = wts / jnp.sum(wts, axis=-1, keepdims=True)
    gates = jnp.sum(jax.nn.one_hot(idx, N_EXPERTS, dtype=jnp.float32) * wts[..., None], axis=1)
    gates = gates.astype(h.dtype)
    y = jnp.zeros_like(t)
    for e in range(N_EXPERTS):
        act = jax.nn.silu(t @ w_gate[e]) * (t @ w_up[e])
        y = y + gates[:, e:e + 1] * (act @ w_down[e])
    return y.reshape(b, s, d)


def setup_inputs(seed: int = 0) -> dict:
    key = jax.random.key(seed)
    ks = jax.random.split(key, 23)

    def nrm(k, shape, scale):
        return jax.random.normal(k, shape, jnp.float32) * scale

    return {
        'x': nrm(ks[0], (BATCH, SEQ, D_MODEL), 1.0),
        'c': nrm(ks[1], (BATCH, D_MODEL), 1.0),
        'w_ada': nrm(ks[2], (DEPTH, D_MODEL, 6 * D_MODEL), 0.5 * D_MODEL ** -0.5),
        'b_ada': nrm(ks[3], (DEPTH, 6 * D_MODEL), 0.02),
        'w_norm1': 1.0 + nrm(ks[4], (DEPTH, D_MODEL), 0.02),
        'w_in': nrm(ks[5], (DEPTH, D_MODEL, D_IN), D_MODEL ** -0.5),
        'conv_w': nrm(ks[6], (DEPTH, M_CONV, 2 * M_QK_W), M_CONV ** -0.5),
        'conv_b': nrm(ks[7], (DEPTH, 2 * M_QK_W), 0.02),
        'b_igate': nrm(ks[8], (DEPTH, M_HEADS), 0.1),
        'b_fgate': jnp.linspace(3.0, 6.0, M_HEADS, dtype=jnp.float32)[None, :]
                   + nrm(ks[9], (DEPTH, M_HEADS), 0.1),
        'w_mnorm': 1.0 + nrm(ks[10], (DEPTH, M_V_W), 0.02),
        'sinks': nrm(ks[11], (DEPTH, A_HEADS), 0.5),
        'rel_bias': nrm(ks[12], (N_BUCKETS, A_HEADS), 0.3),
        'w_br_m': nrm(ks[13], (DEPTH, M_V_W, D_MODEL), M_V_W ** -0.5),
        'w_br_a': nrm(ks[14], (DEPTH, A_Q_W, D_MODEL), A_Q_W ** -0.5),
        'w_out': nrm(ks[15], (DEPTH, D_MODEL, D_MODEL), D_MODEL ** -0.5),
        'w_norm2': 1.0 + nrm(ks[16], (DEPTH, D_MODEL), 0.02),
        'w_router': nrm(ks[17], (D_MODEL, N_EXPERTS), D_MODEL ** -0.5),
        'router_bias': nrm(ks[18], (N_EXPERTS,), 0.01),
        'w_gate_e': nrm(ks[19], (DEPTH, N_EXPERTS, D_MODEL, D_EXPERT), D_MODEL ** -0.5),
        'w_up_e': nrm(ks[20], (DEPTH, N_EXPERTS, D_MODEL, D_EXPERT), D_MODEL ** -0.5),
        'w_down_e': nrm(ks[21], (DEPTH, N_EXPERTS, D_EXPERT, D_MODEL), D_EXPERT ** -0.5),
        'w_final': 1.0 + nrm(ks[22], (D_MODEL,), 0.02),
    }


def reference(x, c, w_ada, b_ada, w_norm1, w_in, conv_w, conv_b, b_igate, b_fgate, w_mnorm,
              sinks, rel_bias, w_br_m, w_br_a, w_out, w_norm2, w_router, router_bias,
              w_gate_e, w_up_e, w_down_e, w_final):
    cond = jax.nn.silu(c)
    for l in range(DEPTH):
        mod = cond @ w_ada[l] + b_ada[l]
        sh1, sc1, g1, sh2, sc2, g2 = jnp.split(mod, 6, axis=-1)
        h = _modulate(_rmsnorm(x, w_norm1[l]), sh1, sc1)
        x = x + g1[:, None, :] * _hybrid_mixer(
            h, w_in[l], conv_w[l], conv_b[l], b_igate[l], b_fgate[l], w_mnorm[l], sinks[l],
            rel_bias, w_br_m[l], w_br_a[l], w_out[l])
        h = _modulate(_rmsnorm(x, w_norm2[l]), sh2, sc2)
        x = x + g2[:, None, :] * _grouped_moe(
            h, w_router, router_bias, w_gate_e[l], w_up_e[l], w_down_e[l])
    return _rmsnorm(x, w_final)
```

```cpp
#include <hip/hip_runtime.h>
#include <cstdio>
#include <cstdint>

constexpr int NB = 4, SEQ = 4096, T = NB * SEQ, D = 1024, DEPTH = 2;
constexpr int MH = 4, DQK = 64, DV = 128;
constexpr int AH = 8, AKV = 2, AD = 64;
constexpr int NE = 16, DE = 512;
constexpr int D_IN = 4360, ZW = 4352;
constexpr int Z_QM = 0, Z_KM = 256, Z_VM = 512, Z_OM = 1024, Z_QA = 1536, Z_KA = 2048, Z_VA = 2176, Z_GM = 2304, Z_GA = 3328;
constexpr float EPS = 1e-6f;
constexpr int MOE_ROWS = 2 * T + NE * 256;

constexpr size_t MiB = 1u << 20;
constexpr size_t WS_CTL = 0, CTL_BYTES = 1 * MiB;
constexpr size_t WS_MOD = 1 * MiB;
constexpr size_t WS_IFG = WS_MOD + 256 * 1024;
constexpr size_t WS_RIDX = WS_IFG + 512 * 1024;
constexpr size_t WS_RW = WS_RIDX + 128 * 1024;
constexpr size_t WS_SLOT = WS_RW + 128 * 1024;
constexpr size_t WS_ROWTOK = WS_SLOT + 128 * 1024;
constexpr size_t WS_SMALL_END = WS_ROWTOK + 256 * 1024;
static_assert(WS_SMALL_END <= 4 * MiB, "small region");
constexpr size_t WS_W = 4 * MiB;
constexpr size_t W_IN = 0;
constexpr size_t W_BR = W_IN + (size_t)ZW * D * 2;
constexpr size_t W_OUT = W_BR + (size_t)D * D * 2;
constexpr size_t W_GU = W_OUT + (size_t)D * D * 2;
constexpr size_t W_DN = W_GU + (size_t)NE * 1024 * D * 2;
constexpr size_t LAYER_W = W_DN + (size_t)NE * D * DE * 2;
constexpr size_t WS_Z = WS_W + 2 * LAYER_W;
constexpr size_t WS_ACT = WS_Z;
constexpr size_t WS_Y = WS_ACT + (size_t)MOE_ROWS * DE * 2;
constexpr size_t WS_XA = WS_Z + (size_t)T * ZW * 2;
constexpr size_t WS_HCAT = WS_XA + (size_t)T * D * 2;
constexpr size_t WS_END = WS_HCAT + (size_t)T * D * 2;
static_assert(WS_Y + (size_t)MOE_ROWS * D * 2 <= WS_XA, "MoE overlay fits in z");
constexpr int CW_CNT = 1024;
constexpr int CW_CUR = 2048;

typedef unsigned short bf16;
typedef float f32x4 __attribute__((ext_vector_type(4)));
typedef unsigned u32x4 __attribute__((ext_vector_type(4)));
typedef unsigned u32x2 __attribute__((ext_vector_type(2)));
#define LAS __attribute__((address_space(3)))

__device__ __forceinline__ unsigned f2bf(float f) { unsigned u = __builtin_bit_cast(unsigned, f); return (u + 0x7fffu + ((u >> 16) & 1u)) >> 16; }
__device__ __forceinline__ unsigned pk2(float lo, float hi) { return f2bf(lo) | (f2bf(hi) << 16); }
__device__ __forceinline__ float bf2f(unsigned b) { return __builtin_bit_cast(float, b << 16); }
__device__ __forceinline__ float bflo(unsigned w) { return __builtin_bit_cast(float, w << 16); }
__device__ __forceinline__ float bfhi(unsigned w) { return __builtin_bit_cast(float, w & 0xffff0000u); }
__device__ __forceinline__ float sigmoidf_(float x) { return 1.f / (1.f + __expf(-x)); }
__device__ __forceinline__ float siluf_(float x) { return x / (1.f + __expf(-x)); }
__device__ __forceinline__ float wave_sum(float v) {
#pragma unroll
    for (int o = 1; o < 64; o <<= 1) v += __shfl_xor(v, o);
    return v;
}

__device__ const unsigned char T5_BUCKET[128] = {0,1,2,3,4,5,6,7,8,9,10,11,12,13,14,15,16,16,16,17,17,18,18,18,19,19,19,20,20,20,20,21,21,21,21,22,22,22,22,22,23,23,23,23,23,23,24,24,24,24,24,24,25,25,25,25,25,25,25,26,26,26,26,26,26,26,26,27,27,27,27,27,27,27,27,27,27,28,28,28,28,28,28,28,28,28,28,29,29,29,29,29,29,29,29,29,29,29,29,30,30,30,30,30,30,30,30,30,30,30,30,30,30,31,31,31,31,31,31,31,31,31,31,31,31,31,31,31};

struct Args {
    const float* in[23];
    float* out; unsigned char* ws;
    int ph_lo, ph_hi;
};
enum { I_X = 0, I_C, I_WADA, I_BADA, I_WN1, I_WIN, I_CONVW, I_CONVB, I_BIG, I_BFG, I_WMN, I_SINK, I_RELB, I_WBRM, I_WBRA, I_WOUT, I_WN2, I_WR, I_RB, I_WG, I_WU, I_WD, I_WF };

constexpr int NT = 512, NWAVES = 8;
constexpr int LDS_BYTES = 147456;

struct Ctx {
    Args a; LAS unsigned char* lds; int tid, lane, wave, G, bid;
    __device__ __forceinline__ unsigned* ctl() const { return (unsigned*)(a.ws + WS_CTL); }
    __device__ __forceinline__ float* mod(int l) const { return (float*)(a.ws + WS_MOD) + (size_t)l * 4 * 6144; }
    __device__ __forceinline__ unsigned char* wl(int l) const { return a.ws + WS_W + (size_t)l * LAYER_W; }
};

__device__ __forceinline__ void conv_tile(const float* src, int ldsrc, int k0, int n_src0, bf16* dst, int ldd, int dst_row0, LAS float* scr, int lane) {
#pragma unroll 4
    for (int i = 0; i < 16; ++i) { const int kk = 4 * i + (lane >> 4); const f32x4 v = *(const f32x4*)(src + (size_t)(k0 + kk) * ldsrc + n_src0 + 4 * (lane & 15));
        LAS float* p = scr + kk * 65 + 4 * (lane & 15); p[0] = v.x; p[1] = v.y; p[2] = v.z; p[3] = v.w; }
    asm volatile("s_waitcnt lgkmcnt(0)" ::: "memory");
    const int c = lane & 7;
#pragma unroll
    for (int j = 0; j < 8; ++j) { const int n = (lane >> 3) + 8 * j; const LAS float* s = scr + (8 * c) * 65 + n;
        u32x4 o; o.x = pk2(s[0], s[65]); o.y = pk2(s[2 * 65], s[3 * 65]); o.z = pk2(s[4 * 65], s[5 * 65]); o.w = pk2(s[6 * 65], s[7 * 65]);
        *(u32x4*)(dst + (size_t)(dst_row0 + n) * ldd + k0 + 8 * c) = o; }
    asm volatile("s_waitcnt lgkmcnt(0)" ::: "memory");
}

__device__ __forceinline__ void phase_prologue(const Ctx& c) {
    {
        LAS float* cond = (LAS float*)c.lds;
        LAS float* red = cond + 4096;
        for (int item = c.bid; item < 192; item += c.G) {
            __syncthreads();
            for (int i = c.tid; i < 4096; i += NT) cond[i] = siluf_(c.a.in[I_C][i]);
            __syncthreads();
            const int l = item / 96, col = (item % 96) * 64 + c.lane;
            const float* w = c.a.in[I_WADA] + (size_t)l * D * 6144 + col;
            float acc[4] = {0.f, 0.f, 0.f, 0.f};
            for (int k = c.wave * 128; k < c.wave * 128 + 128; ++k) { const float wv = w[(size_t)k * 6144];
#pragma unroll
                for (int b = 0; b < 4; ++b) acc[b] += cond[b * 1024 + k] * wv; }
#pragma unroll
            for (int b = 0; b < 4; ++b) red[(c.wave * 4 + b) * 64 + c.lane] = acc[b];
            __syncthreads();
            if (c.tid < 256) { const int b = c.tid >> 6, ln = c.tid & 63; float s = 0.f;
#pragma unroll
                for (int wv = 0; wv < 8; ++wv) s += red[(wv * 4 + b) * 64 + ln];
                const int cc = (item % 96) * 64 + ln;
                c.mod(l)[b * 6144 + cc] = s + c.a.in[I_BADA][l * 6144 + cc]; }
        }
        __syncthreads();
    }
    {
        LAS float* scr = (LAS float*)c.lds + c.wave * (64 * 65 + 64);
        const int gw = c.bid * NWAVES + c.wave, NGW = c.G * NWAVES;
        constexpr int I_IN = 16 * 68, I_BRM = 8 * 16, I_BRA = 8 * 16, I_OUT = 16 * 16, I_GU1 = 16 * 8, I_DN1 = 8 * 16;
        constexpr int PER_LAYER = I_IN + I_BRM + I_BRA + I_OUT + NE * 2 * I_GU1 + NE * I_DN1;
        for (int it = gw; it < 2 * PER_LAYER; it += NGW) {
            const int l = it / PER_LAYER; int r = it % PER_LAYER; unsigned char* wl = c.wl(l);
            if (r < I_IN) { const int kb = r / 68, nb = r % 68; const int n0 = nb * 64; const int ns = n0 < 1536 ? n0 : n0 + 8;
                conv_tile(c.a.in[I_WIN] + (size_t)l * D * D_IN, D_IN, kb * 64, ns, (bf16*)(wl + W_IN), D, n0, scr, c.lane); continue; } r -= I_IN;
            if (r < I_BRM) { const int kb = r / 16, nb = r % 16;
                conv_tile(c.a.in[I_WBRM] + (size_t)l * 512 * D, D, kb * 64, nb * 64, (bf16*)(wl + W_BR), D, nb * 64, scr, c.lane); continue; } r -= I_BRM;
            if (r < I_BRA) { const int kb = r / 16, nb = r % 16;
                conv_tile(c.a.in[I_WBRA] + (size_t)l * 512 * D, D, kb * 64, nb * 64, (bf16*)(wl + W_BR) + 512, D, nb * 64, scr, c.lane); continue; } r -= I_BRA;
            if (r < I_OUT) { const int kb = r / 16, nb = r % 16;
                conv_tile(c.a.in[I_WOUT] + (size_t)l * D * D, D, kb * 64, nb * 64, (bf16*)(wl + W_OUT), D, nb * 64, scr, c.lane); continue; } r -= I_OUT;
            if (r < NE * 2 * I_GU1) { const int e = r / (2 * I_GU1); int q = r % (2 * I_GU1); const int up = q / I_GU1; q %= I_GU1; const int kb = q / 8, nb = q % 8;
                const float* src = (up ? c.a.in[I_WU] : c.a.in[I_WG]) + ((size_t)l * NE + e) * D * DE;
                const int j0 = nb * 64; const int drow = (j0 / 128) * 256 + up * 128 + (j0 % 128);
                conv_tile(src, DE, kb * 64, j0, (bf16*)(wl + W_GU) + (size_t)e * 1024 * D, D, drow, scr, c.lane); continue; } r -= NE * 2 * I_GU1;
            { const int e = r / I_DN1; const int q = r % I_DN1; const int kb = q / 16, nb = q % 16;
                conv_tile(c.a.in[I_WD] + ((size_t)l * NE + e) * DE * D, D, kb * 64, nb * 64, (bf16*)(wl + W_DN) + (size_t)e * D * DE, DE, nb * 64, scr, c.lane); }
        }
    }
}

__device__ __forceinline__ void phase_xn(const Ctx& c, int l) {
    LAS float* w8 = (LAS float*)c.lds;
    const float* win = c.a.in[I_WIN] + (size_t)l * D * D_IN;
    for (int i = c.tid; i < 8192; i += NT) { const int k = i >> 3, j = i & 7; w8[j * 1024 + k] = win[(size_t)k * D_IN + 1536 + j]; }
    __syncthreads();
    const float* xs = (l == 0) ? c.a.in[I_X] : c.a.out;
    const float* wn = c.a.in[I_WN1] + l * D; const float* mod = c.mod(l);
    bf16* XN = (bf16*)(c.a.ws + WS_XA); float* IFG = (float*)(c.a.ws + WS_IFG);
    const int gw = c.bid * NWAVES + c.wave, NGW = c.G * NWAVES;
    for (int m = gw; m < T; m += NGW) {
        const int b = m / SEQ; const f32x4* xr = (const f32x4*)(xs + (size_t)m * D) + c.lane;
        f32x4 v[4]; float s = 0.f;
#pragma unroll
        for (int j = 0; j < 4; ++j) { v[j] = xr[64 * j]; s += (v[j].x * v[j].x + v[j].y * v[j].y) + (v[j].z * v[j].z + v[j].w * v[j].w); }
        const float rstd = rsqrtf(wave_sum(s) * (1.f / D) + EPS);
        float g[8] = {0.f, 0.f, 0.f, 0.f, 0.f, 0.f, 0.f, 0.f};
        u32x2* o8 = (u32x2*)(XN + (size_t)m * D) + c.lane;
#pragma unroll
        for (int j = 0; j < 4; ++j) { const int col = 256 * j + 4 * c.lane;
            const f32x4 w = *(const f32x4*)(wn + col), sh = *(const f32x4*)(mod + b * 6144 + col), sc = *(const f32x4*)(mod + b * 6144 + 1024 + col);
            v[j] = (v[j] * rstd * w) * (sc + 1.f) + sh;
            u32x2 o; o.x = pk2(v[j].x, v[j].y); o.y = pk2(v[j].z, v[j].w); o8[64 * j] = o; }
#pragma unroll
        for (int q = 0; q < 8; ++q) {
#pragma unroll
            for (int j = 0; j < 4; ++j) { const f32x4 ww = *(const LAS f32x4*)(w8 + q * 1024 + 256 * j + 4 * c.lane); g[q] += (v[j].x * ww.x + v[j].y * ww.y) + (v[j].z * ww.z + v[j].w * ww.w); }
            asm volatile("" ::: "memory"); }
#pragma unroll
        for (int q = 0; q < 8; ++q) g[q] = wave_sum(g[q]);
        if (c.lane < 8) { float val = 0.f;
#pragma unroll
            for (int q = 0; q < 8; ++q) val = (c.lane == q) ? g[q] : val;
            const float bias = (c.lane < 4) ? c.a.in[I_BIG][l * 4 + c.lane] : c.a.in[I_BFG][l * 4 + c.lane - 4];
            IFG[(size_t)m * 8 + c.lane] = val + bias; }
    }
}

template <class RowA, class RowB0, class RowB1, class Epi>
__device__ __forceinline__ void naive_gemm_tile(const Ctx& c, int m0, int n0, int K0, int K1, const RowA& ra, const RowA& ra1, const RowB0& rb0, const RowB1& rb1, const Epi& epi) {
    LAS float* As = (LAS float*)c.lds;
    LAS float* Bs = As + 32 * 132;
    const int ty = c.tid >> 4, tx = c.tid & 15;
    f32x4 acc[2][4];
#pragma unroll
    for (int p = 0; p < 2; ++p)
#pragma unroll
        for (int i = 0; i < 4; ++i) acc[p][i] = (f32x4){0.f, 0.f, 0.f, 0.f};
#pragma unroll
    for (int p = 0; p < 2; ++p) {
        const int K = p ? K1 : K0;
        const int ar = c.tid >> 2, akc = c.tid & 3;
        const bf16* arow = p ? ra1(m0 + ar) : ra(m0 + ar);
        const int br = (c.tid & 255) >> 2, bkc = c.tid & 3;
        const bf16* brow = p ? rb1(n0 + br) : rb0(n0 + br);
        for (int k0 = 0; k0 < K; k0 += 32) {
            __syncthreads();
            { const u32x4 v = *(const u32x4*)(arow + k0 + 8 * akc); LAS float* d = As + (8 * akc) * 132 + ar;
              d[0] = bflo(v.x); d[132] = bfhi(v.x); d[2 * 132] = bflo(v.y); d[3 * 132] = bfhi(v.y); d[4 * 132] = bflo(v.z); d[5 * 132] = bfhi(v.z); d[6 * 132] = bflo(v.w); d[7 * 132] = bfhi(v.w); }
            if (c.tid < 256) { const u32x4 v = *(const u32x4*)(brow + k0 + 8 * bkc); LAS float* d = Bs + (8 * bkc) * 68 + br;
              d[0] = bflo(v.x); d[68] = bfhi(v.x); d[2 * 68] = bflo(v.y); d[3 * 68] = bfhi(v.y); d[4 * 68] = bflo(v.z); d[5 * 68] = bfhi(v.z); d[6 * 68] = bflo(v.w); d[7 * 68] = bfhi(v.w); }
            __syncthreads();
#pragma unroll 8
            for (int k = 0; k < 32; ++k) { const f32x4 av = *(const LAS f32x4*)(As + k * 132 + 4 * ty), bv = *(const LAS f32x4*)(Bs + k * 68 + 4 * tx);
                acc[p][0] += av.x * bv; acc[p][1] += av.y * bv; acc[p][2] += av.z * bv; acc[p][3] += av.w * bv; }
        }
    }
#pragma unroll
    for (int i = 0; i < 4; ++i) epi(m0 + 4 * ty + i, n0 + 4 * tx, acc[0][i], acc[1][i]);
}

struct RowPlain { const bf16* p; int ld; __device__ __forceinline__ const bf16* operator()(int r) const { return p + (size_t)r * ld; } };
struct RowGather { const bf16* p; int ld; const int* map; __device__ __forceinline__ const bf16* operator()(int r) const { return p + (size_t)map[r] * ld; } };
struct RowGU { const bf16* p; int up; __device__ __forceinline__ const bf16* operator()(int j) const { return p + (size_t)((j >> 7) * 256 + up * 128 + (j & 127)) * D; } };

struct EpiZ { bf16* z; __device__ __forceinline__ void operator()(int r, int cc, f32x4 a, f32x4) const { u32x2 o; o.x = pk2(a.x, a.y); o.y = pk2(a.z, a.w); *(u32x2*)(z + (size_t)r * ZW + cc) = o; } };
struct EpiBR { const bf16* z; bf16* mg; __device__ __forceinline__ void operator()(int r, int cc, f32x4 a, f32x4 b) const {
    const u32x2 gm = *(const u32x2*)(z + (size_t)r * ZW + Z_GM + cc), ga = *(const u32x2*)(z + (size_t)r * ZW + Z_GA + cc);
    const float m0 = sigmoidf_(bflo(gm.x)) * a.x + sigmoidf_(bflo(ga.x)) * b.x, m1 = sigmoidf_(bfhi(gm.x)) * a.y + sigmoidf_(bfhi(ga.x)) * b.y;
    const float m2 = sigmoidf_(bflo(gm.y)) * a.z + sigmoidf_(bflo(ga.y)) * b.z, m3 = sigmoidf_(bfhi(gm.y)) * a.w + sigmoidf_(bfhi(ga.y)) * b.w;
    u32x2 o; o.x = pk2(m0, m1); o.y = pk2(m2, m3); *(u32x2*)(mg + (size_t)r * D + cc) = o; } };
struct EpiOut { const float* xin; float* xout; const float* g1; __device__ __forceinline__ void operator()(int r, int cc, f32x4 a, f32x4) const {
    const int b = r / SEQ; const f32x4 g = *(const f32x4*)(g1 + b * 6144 + cc), xo = *(const f32x4*)(xin + (size_t)r * D + cc);
    *(f32x4*)(xout + (size_t)r * D + cc) = xo + g * a; } };
struct EpiAct { bf16* act; __device__ __forceinline__ void operator()(int r, int cc, f32x4 a, f32x4 b) const {
    u32x2 o; o.x = pk2(siluf_(a.x) * b.x, siluf_(a.y) * b.y); o.y = pk2(siluf_(a.z) * b.z, siluf_(a.w) * b.w); *(u32x2*)(act + (size_t)r * DE + cc) = o; } };
struct EpiY { bf16* y; __device__ __forceinline__ void operator()(int r, int cc, f32x4 a, f32x4) const { u32x2 o; o.x = pk2(a.x, a.y); o.y = pk2(a.z, a.w); *(u32x2*)(y + (size_t)r * D + cc) = o; } };

__device__ __forceinline__ void phase_inproj(const Ctx& c, int l) {
    const RowPlain ra{(const bf16*)(c.a.ws + WS_XA), D}, rb{(const bf16*)(c.wl(l) + W_IN), D}; const EpiZ e{(bf16*)(c.a.ws + WS_Z)};
    constexpr int NTN = ZW / 64, NTM = T / 128;
    for (int u = c.bid; u < NTN * NTM; u += c.G) naive_gemm_tile(c, (u / NTN) * 128, (u % NTN) * 64, D, 0, ra, ra, rb, rb, e);
}
__device__ __forceinline__ void phase_br(const Ctx& c, int l) {
    const bf16* hc = (const bf16*)(c.a.ws + WS_HCAT); const bf16* w = (const bf16*)(c.wl(l) + W_BR);
    const RowPlain ra{hc, D}, ra1{hc + 512, D}, rb0{w, D}, rb1{w + 512, D}; const EpiBR e{(const bf16*)(c.a.ws + WS_Z), (bf16*)(c.a.ws + WS_XA)};
    constexpr int NTN = D / 64, NTM = T / 128;
    for (int u = c.bid; u < NTN * NTM; u += c.G) naive_gemm_tile(c, (u / NTN) * 128, (u % NTN) * 64, 512, 512, ra, ra1, rb0, rb1, e);
}
__device__ __forceinline__ void phase_out(const Ctx& c, int l) {
    const RowPlain ra{(const bf16*)(c.a.ws + WS_XA), D}, rb{(const bf16*)(c.wl(l) + W_OUT), D};
    const EpiOut e{l == 0 ? c.a.in[I_X] : c.a.out, c.a.out, c.mod(l) + 2048};
    constexpr int NTN = D / 64, NTM = T / 128;
    for (int u = c.bid; u < NTN * NTM; u += c.G) naive_gemm_tile(c, (u / NTN) * 128, (u % NTN) * 64, D, 0, ra, ra, rb, rb, e);
}

__device__ __forceinline__ void naive_mlstm(const Ctx& c, int l, int bh) {
    const int b = bh >> 2, h = bh & 3, d = c.tid >> 2, eq = c.tid & 3, e0 = eq * 16;
    const bf16* z = (const bf16*)(c.a.ws + WS_Z); const float* IFG = (const float*)(c.a.ws + WS_IFG); float* HR = (float*)(c.a.ws + WS_XA);
    const float* cw = c.a.in[I_CONVW] + (size_t)l * 4 * 512; const float* cb = c.a.in[I_CONVB] + l * 512;
    float C[16], n[16], m = 0.f;
#pragma unroll
    for (int i = 0; i < 16; ++i) { C[i] = 0.f; n[i] = 0.f; }
    LAS float* cwl = (LAS float*)c.lds;
    for (int i = c.tid; i < 640; i += NT) { if (i < 512) { const int j = i >> 7, ch = i & 127; cwl[i] = cw[j * 512 + (ch < 64 ? h * 64 + ch : 256 + h * 64 + ch - 64)]; } else { const int ch = i - 512; cwl[i] = cb[ch < 64 ? h * 64 + ch : 256 + h * 64 + ch - 64]; } }
    __syncthreads();
    for (int s = 0; s < SEQ; ++s) {
        const size_t t = (size_t)b * SEQ + s;
        float q[16], k[16];
#pragma unroll
        for (int i = 0; i < 16; ++i) { q[i] = cwl[512 + e0 + i]; k[i] = cwl[512 + 64 + e0 + i]; }
#pragma unroll
        for (int j = 0; j < 4; ++j) { const int sj = s - 3 + j; if (sj >= 0) { const bf16* zr = z + ((size_t)b * SEQ + sj) * ZW;
            const u32x4 q0 = *(const u32x4*)(zr + Z_QM + h * 64 + e0), q1 = *(const u32x4*)(zr + Z_QM + h * 64 + e0 + 8);
            const u32x4 k0 = *(const u32x4*)(zr + Z_KM + h * 64 + e0), k1 = *(const u32x4*)(zr + Z_KM + h * 64 + e0 + 8);
            const unsigned qa[8] = {q0.x, q0.y, q0.z, q0.w, q1.x, q1.y, q1.z, q1.w}, ka[8] = {k0.x, k0.y, k0.z, k0.w, k1.x, k1.y, k1.z, k1.w};
#pragma unroll
            for (int i = 0; i < 8; ++i) { q[2 * i] += cwl[j * 128 + e0 + 2 * i] * bflo(qa[i]); q[2 * i + 1] += cwl[j * 128 + e0 + 2 * i + 1] * bfhi(qa[i]); k[2 * i] += cwl[j * 128 + 64 + e0 + 2 * i] * bflo(ka[i]); k[2 * i + 1] += cwl[j * 128 + 64 + e0 + 2 * i + 1] * bfhi(ka[i]); } }
            asm volatile("" ::: "memory"); }
#pragma unroll
        for (int i = 0; i < 16; ++i) { q[i] = siluf_(q[i]) * 0.125f; k[i] = siluf_(k[i]); }
        const float v = bf2f(z[t * ZW + Z_VM + h * 128 + d]);
        const float ig = IFG[t * 8 + h], fp = IFG[t * 8 + 4 + h];
        const float logf = fminf(fp, 0.f) - log1pf(__expf(-fabsf(fp)));
        const float mn = fmaxf(logf + m, ig), dec = __expf(logf + m - mn), fr = __expf(ig - mn);
        float num = 0.f, den = 0.f;
#pragma unroll
        for (int i = 0; i < 16; ++i) { C[i] = dec * C[i] + fr * v * k[i]; n[i] = dec * n[i] + fr * k[i]; num += C[i] * q[i]; den += n[i] * q[i]; }
        num += __shfl_xor(num, 1); num += __shfl_xor(num, 2); den += __shfl_xor(den, 1); den += __shfl_xor(den, 2);
        m = mn;
        if (eq == 0) HR[t * 512 + h * 128 + d] = num / fmaxf(fabsf(den), __expf(-mn));
    }
}
__device__ __forceinline__ void naive_swa(const Ctx& c, int l, int first_blk) {
    const bf16* z = (const bf16*)(c.a.ws + WS_Z); bf16* hc = (bf16*)(c.a.ws + WS_HCAT);
    const float* relb = c.a.in[I_RELB]; const float* sinks = c.a.in[I_SINK] + l * AH;
    const int nblk = c.G - first_blk;
    for (int idx = (c.bid - first_blk) * NT + c.tid; idx < T * AH * 4; idx += nblk * NT) {
        const int part = idx & 3, hd = (idx >> 2) & 7, t = idx >> 5, kh = hd >> 2, s = t % SEQ, d0 = part * 16;
        float q[16], o[16];
        { const bf16* qp = z + (size_t)t * ZW + Z_QA + hd * 64 + d0;
#pragma unroll
          for (int i = 0; i < 2; ++i) { const u32x4 v = *(const u32x4*)(qp + 8 * i); q[8 * i] = bflo(v.x); q[8 * i + 1] = bfhi(v.x); q[8 * i + 2] = bflo(v.y); q[8 * i + 3] = bfhi(v.y); q[8 * i + 4] = bflo(v.z); q[8 * i + 5] = bfhi(v.z); q[8 * i + 6] = bflo(v.w); q[8 * i + 7] = bfhi(v.w); } }
#pragma unroll
        for (int i = 0; i < 16; ++i) o[i] = 0.f;
        float mx = sinks[hd], lsum = 1.f;
        const int j0 = s - 127 < 0 ? 0 : s - 127;
        for (int j = j0; j <= s; ++j) {
            const bf16* kp = z + (size_t)(t - s + j) * ZW + Z_KA + kh * 64 + d0; const bf16* vp = z + (size_t)(t - s + j) * ZW + Z_VA + kh * 64 + d0;
            float sc = 0.f;
#pragma unroll
            for (int i = 0; i < 2; ++i) { const u32x4 v = *(const u32x4*)(kp + 8 * i);
                sc += q[8 * i] * bflo(v.x) + q[8 * i + 1] * bfhi(v.x) + q[8 * i + 2] * bflo(v.y) + q[8 * i + 3] * bfhi(v.y) + q[8 * i + 4] * bflo(v.z) + q[8 * i + 5] * bfhi(v.z) + q[8 * i + 6] * bflo(v.w) + q[8 * i + 7] * bfhi(v.w); }
            sc += __shfl_xor(sc, 1); sc += __shfl_xor(sc, 2);
            sc = sc * 0.125f + relb[T5_BUCKET[s - j] * AH + hd];
            const float mn = fmaxf(mx, sc), corr = __expf(mx - mn), p = __expf(sc - mn);
            lsum = lsum * corr + p; mx = mn;
#pragma unroll
            for (int i = 0; i < 2; ++i) { const u32x4 v = *(const u32x4*)(vp + 8 * i);
                o[8 * i] = o[8 * i] * corr + p * bflo(v.x); o[8 * i + 1] = o[8 * i + 1] * corr + p * bfhi(v.x); o[8 * i + 2] = o[8 * i + 2] * corr + p * bflo(v.y); o[8 * i + 3] = o[8 * i + 3] * corr + p * bfhi(v.y);
                o[8 * i + 4] = o[8 * i + 4] * corr + p * bflo(v.z); o[8 * i + 5] = o[8 * i + 5] * corr + p * bfhi(v.z); o[8 * i + 6] = o[8 * i + 6] * corr + p * bflo(v.w); o[8 * i + 7] = o[8 * i + 7] * corr + p * bfhi(v.w); }
        }
        const float inv = 1.f / lsum; bf16* op = hc + (size_t)t * D + 512 + hd * 64 + d0;
#pragma unroll
        for (int i = 0; i < 2; ++i) { u32x4 w; w.x = pk2(o[8 * i] * inv, o[8 * i + 1] * inv); w.y = pk2(o[8 * i + 2] * inv, o[8 * i + 3] * inv); w.z = pk2(o[8 * i + 4] * inv, o[8 * i + 5] * inv); w.w = pk2(o[8 * i + 6] * inv, o[8 * i + 7] * inv); *(u32x4*)(op + 8 * i) = w; }
    }
}
__device__ __forceinline__ void phase_mix1(const Ctx& c, int l) {
    if (c.bid < 16) naive_mlstm(c, l, c.bid); else naive_swa(c, l, 16);
}
__device__ __forceinline__ void phase_mix2(const Ctx& c, int l) {
    const float* HR = (const float*)(c.a.ws + WS_XA); const bf16* z = (const bf16*)(c.a.ws + WS_Z); bf16* hc = (bf16*)(c.a.ws + WS_HCAT);
    const float* wm = c.a.in[I_WMN] + l * 512;
    const int gw = c.bid * NWAVES + c.wave, NGW = c.G * NWAVES;
    for (int it = gw; it < T * MH; it += NGW) { const int t = it >> 2, h = it & 3; const int col = h * 128 + 2 * c.lane;
        const float a0 = HR[(size_t)t * 512 + col], a1 = HR[(size_t)t * 512 + col + 1];
        const float rstd = rsqrtf(wave_sum(a0 * a0 + a1 * a1) * (1.f / 128.f) + EPS);
        const unsigned og = *(const unsigned*)(z + (size_t)t * ZW + Z_OM + col);
        *(unsigned*)(hc + (size_t)t * D + col) = pk2(a0 * rstd * wm[col] * sigmoidf_(bflo(og)), a1 * rstd * wm[col + 1] * sigmoidf_(bfhi(og))); }
}

__device__ __forceinline__ void phase_route(const Ctx& c, int l) {
    LAS float* wr = (LAS float*)c.lds;
    for (int i = c.tid; i < 16384; i += NT) { const int k = i >> 4, e = i & 15; wr[e * 1024 + k] = c.a.in[I_WR][i]; }
    __syncthreads();
    int* ROWTOK = (int*)(c.a.ws + WS_ROWTOK);
    for (int i = c.bid * NT + c.tid; i < MOE_ROWS; i += c.G * NT) ROWTOK[i] = 0;
    const float* wn = c.a.in[I_WN2] + l * D; const float* mod = c.mod(l); const float* rbias = c.a.in[I_RB];
    bf16* XN = (bf16*)(c.a.ws + WS_XA); int* RIDX = (int*)(c.a.ws + WS_RIDX); float* RW = (float*)(c.a.ws + WS_RW);
    unsigned* cnt = c.ctl() + CW_CNT + 64 * l;
    const int gw = c.bid * NWAVES + c.wave, NGW = c.G * NWAVES;
    for (int m = gw; m < T; m += NGW) {
        const int b = m / SEQ; const f32x4* xr = (const f32x4*)(c.a.out + (size_t)m * D) + c.lane;
        f32x4 v[4]; float s = 0.f;
#pragma unroll
        for (int j = 0; j < 4; ++j) { v[j] = xr[64 * j]; s += (v[j].x * v[j].x + v[j].y * v[j].y) + (v[j].z * v[j].z + v[j].w * v[j].w); }
        const float rstd = rsqrtf(wave_sum(s) * (1.f / D) + EPS);
        float lg[16];
#pragma unroll
        for (int e = 0; e < 16; ++e) lg[e] = 0.f;
        u32x2* o8 = (u32x2*)(XN + (size_t)m * D) + c.lane;
#pragma unroll
        for (int j = 0; j < 4; ++j) { const int col = 256 * j + 4 * c.lane;
            const f32x4 w = *(const f32x4*)(wn + col), sh = *(const f32x4*)(mod + b * 6144 + 3072 + col), sc = *(const f32x4*)(mod + b * 6144 + 4096 + col);
            v[j] = (v[j] * rstd * w) * (sc + 1.f) + sh;
            u32x2 o; o.x = pk2(v[j].x, v[j].y); o.y = pk2(v[j].z, v[j].w); o8[64 * j] = o; }
#pragma unroll
        for (int e = 0; e < 16; ++e) {
#pragma unroll
            for (int j = 0; j < 4; ++j) { const f32x4 ww = *(const LAS f32x4*)(wr + e * 1024 + 256 * j + 4 * c.lane); lg[e] += (v[j].x * ww.x + v[j].y * ww.y) + (v[j].z * ww.z + v[j].w * ww.w); }
            asm volatile("" ::: "memory"); }
#pragma unroll
        for (int e = 0; e < 16; ++e) lg[e] = wave_sum(lg[e]);
        float sc[16], sel[16];
#pragma unroll
        for (int e = 0; e < 16; ++e) { sc[e] = 1.f / (1.f + expf(-lg[e])); sel[e] = sc[e] + rbias[e]; }
        int bg = 0; float bgs = -INFINITY;
#pragma unroll
        for (int g = 0; g < 4; ++g) { float m1 = -INFINITY, m2 = -INFINITY;
#pragma unroll
            for (int i = 0; i < 4; ++i) { const float x = sel[4 * g + i]; if (x > m1) { m2 = m1; m1 = x; } else if (x > m2) m2 = x; }
            const float gs = m1 + m2; if (gs > bgs) { bgs = gs; bg = g; } }
        int i1 = -1, i2 = -1; float v1 = -INFINITY, v2 = -INFINITY;
#pragma unroll
        for (int e = 0; e < 16; ++e) { if ((e >> 2) == bg) { const float x = sel[e]; if (x > v1) { v2 = v1; i2 = i1; v1 = x; i1 = e; } else if (x > v2) { v2 = x; i2 = e; } } }
        float s1 = 0.f, s2 = 0.f;
#pragma unroll
        for (int e = 0; e < 16; ++e) { s1 = (e == i1) ? sc[e] : s1; s2 = (e == i2) ? sc[e] : s2; }
        if (c.lane == 0) { const float inv = 1.f / (s1 + s2); RIDX[2 * m] = i1; RIDX[2 * m + 1] = i2; RW[2 * m] = s1 * inv; RW[2 * m + 1] = s2 * inv;
            atomicAdd(cnt + i1, 1u); atomicAdd(cnt + i2, 1u); }
    }
}
__device__ __forceinline__ void phase_fill(const Ctx& c, int l) {
    LAS int* offs = (LAS int*)c.lds;
    const unsigned* cnt = c.ctl() + CW_CNT + 64 * l; unsigned* cur = c.ctl() + CW_CUR + 64 * l;
    if (c.tid == 0) { int o = 0; for (int e = 0; e < NE; ++e) { offs[e] = o; o += (int)((__hip_atomic_load(cnt + e, __ATOMIC_RELAXED, __HIP_MEMORY_SCOPE_AGENT) + 255u) & ~255u); } offs[NE] = o; }
    __syncthreads();
    const int* RIDX = (const int*)(c.a.ws + WS_RIDX); int* SLOT = (int*)(c.a.ws + WS_SLOT); int* ROWTOK = (int*)(c.a.ws + WS_ROWTOK);
    for (int i = c.bid * NT + c.tid; i < 2 * T; i += c.G * NT) { const int e = RIDX[i]; const int pos = (int)atomicAdd(cur + e, 1u); const int row = offs[e] + pos; ROWTOK[row] = i >> 1; SLOT[i] = row; }
    __syncthreads();
}
__device__ __forceinline__ void phase_g1(const Ctx& c, int l) {
    LAS int* offs = (LAS int*)(c.lds + 65536);
    const unsigned* cnt = c.ctl() + CW_CNT + 64 * l;
    if (c.tid == 0) { int o = 0; for (int e = 0; e < NE; ++e) { offs[e] = o; o += (int)((__hip_atomic_load(cnt + e, __ATOMIC_RELAXED, __HIP_MEMORY_SCOPE_AGENT) + 255u) & ~255u); } offs[NE] = o; }
    __syncthreads();
    const int R = offs[NE]; const int NTM = R / 128; constexpr int NTN = DE / 64;
    const RowGather ra{(const bf16*)(c.a.ws + WS_XA), D, (const int*)(c.a.ws + WS_ROWTOK)}; const EpiAct ep{(bf16*)(c.a.ws + WS_ACT)};
    for (int u = c.bid; u < NTM * NTN; u += c.G) { const int m0 = (u / NTN) * 128, n0 = (u % NTN) * 64; int e = 0; for (int i = 1; i < NE; ++i) if (m0 >= offs[i]) e = i;
        const bf16* w = (const bf16*)(c.wl(l) + W_GU) + (size_t)e * 1024 * D; const RowGU rb0{w, 0}, rb1{w, 1};
        naive_gemm_tile(c, m0, n0, D, D, ra, ra, rb0, rb1, ep); }
    __syncthreads();
}
__device__ __forceinline__ void phase_g2(const Ctx& c, int l) {
    LAS int* offs = (LAS int*)(c.lds + 65536);
    const unsigned* cnt = c.ctl() + CW_CNT + 64 * l;
    if (c.tid == 0) { int o = 0; for (int e = 0; e < NE; ++e) { offs[e] = o; o += (int)((__hip_atomic_load(cnt + e, __ATOMIC_RELAXED, __HIP_MEMORY_SCOPE_AGENT) + 255u) & ~255u); } offs[NE] = o; }
    __syncthreads();
    const int R = offs[NE]; const int NTM = R / 128; constexpr int NTN = D / 64;
    const RowPlain ra{(const bf16*)(c.a.ws + WS_ACT), DE}; const EpiY ep{(bf16*)(c.a.ws + WS_Y)};
    for (int u = c.bid; u < NTM * NTN; u += c.G) { const int m0 = (u / NTN) * 128, n0 = (u % NTN) * 64; int e = 0; for (int i = 1; i < NE; ++i) if (m0 >= offs[i]) e = i;
        const RowPlain rb{(const bf16*)(c.wl(l) + W_DN) + (size_t)e * D * DE, DE};
        naive_gemm_tile(c, m0, n0, DE, 0, ra, ra, rb, rb, ep); }
    __syncthreads();
}
__device__ __forceinline__ void phase_combine(const Ctx& c, int l) {
    const float* mod = c.mod(l); const bf16* Y = (const bf16*)(c.a.ws + WS_Y); const int* SLOT = (const int*)(c.a.ws + WS_SLOT); const float* RW = (const float*)(c.a.ws + WS_RW);
    const float* wf = c.a.in[I_WF];
    const int gw = c.bid * NWAVES + c.wave, NGW = c.G * NWAVES;
    for (int m = gw; m < T; m += NGW) {
        const int b = m / SEQ; f32x4* xr = (f32x4*)(c.a.out + (size_t)m * D) + c.lane;
        const int s0 = SLOT[2 * m], s1 = SLOT[2 * m + 1]; const float w0 = RW[2 * m], w1 = RW[2 * m + 1];
        const u32x2* y0 = (const u32x2*)(Y + (size_t)s0 * D) + c.lane; const u32x2* y1 = (const u32x2*)(Y + (size_t)s1 * D) + c.lane;
        f32x4 v[4]; float s = 0.f;
#pragma unroll
        for (int j = 0; j < 4; ++j) { const int col = 256 * j + 4 * c.lane; const f32x4 g = *(const f32x4*)(mod + b * 6144 + 5120 + col);
            const u32x2 a = y0[64 * j], bb = y1[64 * j];
            const f32x4 ya = {bflo(a.x), bfhi(a.x), bflo(a.y), bfhi(a.y)}, yb = {bflo(bb.x), bfhi(bb.x), bflo(bb.y), bfhi(bb.y)};
            v[j] = xr[64 * j] + g * (ya * w0 + yb * w1);
            s += (v[j].x * v[j].x + v[j].y * v[j].y) + (v[j].z * v[j].z + v[j].w * v[j].w); }
        if (l == DEPTH - 1) { const float rstd = rsqrtf(wave_sum(s) * (1.f / D) + EPS);
#pragma unroll
            for (int j = 0; j < 4; ++j) xr[64 * j] = v[j] * rstd * *(const f32x4*)(wf + 256 * j + 4 * c.lane); }
        else {
#pragma unroll
            for (int j = 0; j < 4; ++j) xr[64 * j] = v[j]; }
    }
}

constexpr int PH_PER_LAYER = 11, NPHASES = 1 + DEPTH * PH_PER_LAYER;
__global__ void __launch_bounds__(NT, 2) mega(Args a) {
    extern __shared__ __attribute__((aligned(16))) unsigned char lds_raw[];
    Ctx c; c.a = a; c.lds = (LAS unsigned char*)lds_raw; c.tid = threadIdx.x; c.lane = c.tid & 63; c.wave = __builtin_amdgcn_readfirstlane(c.tid >> 6); c.G = gridDim.x; c.bid = blockIdx.x;
    { const int ph = a.ph_lo;
#ifndef ONLY
#define ONLY -1
#endif
        if (ph == 0) { if (ONLY < 0 || ONLY == 100) phase_prologue(c); return; }
        const int l = (ph - 1) / PH_PER_LAYER, p = (ph - 1) % PH_PER_LAYER;
        switch (p) {
            case 0: if (ONLY < 0 || ONLY == 0) phase_xn(c, l); break;
            case 1: if (ONLY < 0 || ONLY == 1) phase_inproj(c, l); break;
            case 2: if (ONLY < 0 || ONLY == 2) phase_mix1(c, l); break;
            case 3: if (ONLY < 0 || ONLY == 3) phase_mix2(c, l); break;
            case 4: if (ONLY < 0 || ONLY == 4) phase_br(c, l); break;
            case 5: if (ONLY < 0 || ONLY == 5) phase_out(c, l); break;
            case 6: if (ONLY < 0 || ONLY == 6) phase_route(c, l); break;
            case 7: if (ONLY < 0 || ONLY == 7) phase_fill(c, l); break;
            case 8: if (ONLY < 0 || ONLY == 8) phase_g1(c, l); break;
            case 9: if (ONLY < 0 || ONLY == 9) phase_g2(c, l); break;
            case 10: if (ONLY < 0 || ONLY == 10) phase_combine(c, l); break;
        }
    }
}

extern "C" void kernel_launch(void* const* d_in, const int* in_sizes, int n_in, void* d_out, int out_size, void* d_ws, size_t ws_size, hipStream_t stream) {
    static int grid = 0;
    if (grid == 0) {
        if (n_in != 23 || out_size != T * D || ws_size < WS_END) { fprintf(stderr, "kernel_launch: unexpected shapes (n_in %d out %d ws %zu need %zu)\n", n_in, out_size, ws_size, (size_t)WS_END); grid = -1; return; }
        int dev = 0, cus = 0;
        if (hipGetDevice(&dev) != hipSuccess || hipDeviceGetAttribute(&cus, hipDeviceAttributeMultiprocessorCount, dev) != hipSuccess) { grid = -1; return; }
        if (hipFuncSetAttribute((const void*)mega, hipFuncAttributeMaxDynamicSharedMemorySize, LDS_BYTES) != hipSuccess) { grid = -1; return; }
        grid = cus;
    }
    if (grid < 0) return;
    (void)hipMemsetAsync((char*)d_ws + WS_CTL, 0, CTL_BYTES, stream);
    Args a{};
    for (int i = 0; i < 23; ++i) a.in[i] = (const float*)d_in[i];
    a.out = (float*)d_out; a.ws = (unsigned char*)d_ws;
    for (int ph = 0; ph < NPHASES; ++ph) { a.ph_lo = ph; a.ph_hi = ph + 1; hipLaunchKernelGGL(mega, dim3(grid), dim3(NT), LDS_BYTES, stream, a); }
}
```

```cpp
#include <hip/hip_runtime.h>
#include <cstdio>
#include <cstdint>

constexpr int NB = 4, SEQ = 4096, T = NB * SEQ, D = 1024, DEPTH = 2;
constexpr int MH = 4, DQK = 64, DV = 128;
constexpr int AH = 8, AKV = 2, AD = 64;
constexpr int NE = 16, DE = 512;
constexpr int D_IN = 4360, ZW = 4352;
constexpr int Z_QM = 0, Z_KM = 256, Z_VM = 512, Z_OM = 1024, Z_QA = 1536, Z_KA = 2048, Z_VA = 2176, Z_GM = 2304, Z_GA = 3328;
constexpr float EPS = 1e-6f;
constexpr int MOE_ROWS = 2 * T + NE * 256;

constexpr size_t MiB = 1u << 20;
constexpr size_t WS_CTL = 0, CTL_BYTES = 1 * MiB;
constexpr size_t WS_MOD = 1 * MiB;
constexpr size_t WS_IFG = WS_MOD + 256 * 1024;
constexpr size_t WS_RIDX = WS_IFG + 512 * 1024;
constexpr size_t WS_RW = WS_RIDX + 128 * 1024;
constexpr size_t WS_SLOT = WS_RW + 128 * 1024;
constexpr size_t WS_ROWTOK = WS_SLOT + 128 * 1024;
constexpr size_t WS_SMALL_END = WS_ROWTOK + 256 * 1024;
static_assert(WS_SMALL_END <= 4 * MiB, "small region");
constexpr size_t WS_W = 4 * MiB;
constexpr size_t W_IN = 0;
constexpr size_t W_BR = W_IN + (size_t)ZW * D * 2;
constexpr size_t W_OUT = W_BR + (size_t)D * D * 2;
constexpr size_t W_GU = W_OUT + (size_t)D * D * 2;
constexpr size_t W_DN = W_GU + (size_t)NE * 1024 * D * 2;
constexpr size_t LAYER_W = W_DN + (size_t)NE * D * DE * 2;
constexpr size_t WS_Z = WS_W + 2 * LAYER_W;
constexpr size_t WS_ACT = WS_Z;
constexpr size_t WS_Y = WS_ACT + (size_t)MOE_ROWS * DE * 2;
constexpr size_t WS_XA = WS_Z + (size_t)T * ZW * 2;
constexpr size_t WS_HCAT = WS_XA + (size_t)T * D * 2;
constexpr size_t WS_END = WS_HCAT + (size_t)T * D * 2;
static_assert(WS_Y + (size_t)MOE_ROWS * D * 2 <= WS_XA, "MoE overlay fits in z");
constexpr int CW_CNT = 1024;
constexpr int CW_CUR = 2048;

typedef unsigned short bf16;
typedef float f32x4 __attribute__((ext_vector_type(4)));
typedef unsigned u32x4 __attribute__((ext_vector_type(4)));
typedef unsigned u32x2 __attribute__((ext_vector_type(2)));
#define LAS __attribute__((address_space(3)))

__device__ __forceinline__ unsigned f2bf(float f) { unsigned u = __builtin_bit_cast(unsigned, f); return (u + 0x7fffu + ((u >> 16) & 1u)) >> 16; }
__device__ __forceinline__ unsigned pk2(float lo, float hi) { return f2bf(lo) | (f2bf(hi) << 16); }
__device__ __forceinline__ float bf2f(unsigned b) { return __builtin_bit_cast(float, b << 16); }
__device__ __forceinline__ float bflo(unsigned w) { return __builtin_bit_cast(float, w << 16); }
__device__ __forceinline__ float bfhi(unsigned w) { return __builtin_bit_cast(float, w & 0xffff0000u); }
__device__ __forceinline__ float sigmoidf_(float x) { return 1.f / (1.f + __expf(-x)); }
__device__ __forceinline__ float siluf_(float x) { return x / (1.f + __expf(-x)); }
__device__ __forceinline__ float wave_sum(float v) {
#pragma unroll
    for (int o = 1; o < 64; o <<= 1) v += __shfl_xor(v, o);
    return v;
}

__device__ const unsigned char T5_BUCKET[128] = {0,1,2,3,4,5,6,7,8,9,10,11,12,13,14,15,16,16,16,17,17,18,18,18,19,19,19,20,20,20,20,21,21,21,21,22,22,22,22,22,23,23,23,23,23,23,24,24,24,24,24,24,25,25,25,25,25,25,25,26,26,26,26,26,26,26,26,27,27,27,27,27,27,27,27,27,27,28,28,28,28,28,28,28,28,28,28,29,29,29,29,29,29,29,29,29,29,29,29,30,30,30,30,30,30,30,30,30,30,30,30,30,30,31,31,31,31,31,31,31,31,31,31,31,31,31,31,31};

struct Args {
    const float* in[23];
    float* out; unsigned char* ws;
    int ph_lo, ph_hi;
};
enum { I_X = 0, I_C, I_WADA, I_BADA, I_WN1, I_WIN, I_CONVW, I_CONVB, I_BIG, I_BFG, I_WMN, I_SINK, I_RELB, I_WBRM, I_WBRA, I_WOUT, I_WN2, I_WR, I_RB, I_WG, I_WU, I_WD, I_WF };

constexpr int NT = 512, NWAVES = 8;
constexpr int LDS_BYTES = 147456;

struct Ctx {
    Args a; LAS unsigned char* lds; int tid, lane, wave, G, bid;
    __device__ __forceinline__ unsigned* ctl() const { return (unsigned*)(a.ws + WS_CTL); }
    __device__ __forceinline__ float* mod(int l) const { return (float*)(a.ws + WS_MOD) + (size_t)l * 4 * 6144; }
    __device__ __forceinline__ unsigned char* wl(int l) const { return a.ws + WS_W + (size_t)l * LAYER_W; }
};

__device__ __forceinline__ void conv_tile(const float* src, int ldsrc, int k0, int n_src0, bf16* dst, int ldd, int dst_row0, LAS float* scr, int lane) {
#pragma unroll 4
    for (int i = 0; i < 16; ++i) { const int kk = 4 * i + (lane >> 4); const f32x4 v = *(const f32x4*)(src + (size_t)(k0 + kk) * ldsrc + n_src0 + 4 * (lane & 15));
        LAS float* p = scr + kk * 65 + 4 * (lane & 15); p[0] = v.x; p[1] = v.y; p[2] = v.z; p[3] = v.w; }
    asm volatile("s_waitcnt lgkmcnt(0)" ::: "memory");
    const int c = lane & 7;
#pragma unroll
    for (int j = 0; j < 8; ++j) { const int n = (lane >> 3) + 8 * j; const LAS float* s = scr + (8 * c) * 65 + n;
        u32x4 o; o.x = pk2(s[0], s[65]); o.y = pk2(s[2 * 65], s[3 * 65]); o.z = pk2(s[4 * 65], s[5 * 65]); o.w = pk2(s[6 * 65], s[7 * 65]);
        *(u32x4*)(dst + (size_t)(dst_row0 + n) * ldd + k0 + 8 * c) = o; }
    asm volatile("s_waitcnt lgkmcnt(0)" ::: "memory");
}

__device__ __forceinline__ void phase_prologue(const Ctx& c) {
    {
        LAS float* cond = (LAS float*)c.lds;
        LAS float* red = cond + 4096;
        for (int item = c.bid; item < 192; item += c.G) {
            __syncthreads();
            for (int i = c.tid; i < 4096; i += NT) cond[i] = siluf_(c.a.in[I_C][i]);
            __syncthreads();
            const int l = item / 96, col = (item % 96) * 64 + c.lane;
            const float* w = c.a.in[I_WADA] + (size_t)l * D * 6144 + col;
            float acc[4] = {0.f, 0.f, 0.f, 0.f};
            for (int k = c.wave * 128; k < c.wave * 128 + 128; ++k) { const float wv = w[(size_t)k * 6144];
#pragma unroll
                for (int b = 0; b < 4; ++b) acc[b] += cond[b * 1024 + k] * wv; }
#pragma unroll
            for (int b = 0; b < 4; ++b) red[(c.wave * 4 + b) * 64 + c.lane] = acc[b];
            __syncthreads();
            if (c.tid < 256) { const int b = c.tid >> 6, ln = c.tid & 63; float s = 0.f;
#pragma unroll
                for (int wv = 0; wv < 8; ++wv) s += red[(wv * 4 + b) * 64 + ln];
                const int cc = (item % 96) * 64 + ln;
                c.mod(l)[b * 6144 + cc] = s + c.a.in[I_BADA][l * 6144 + cc]; }
        }
        __syncthreads();
    }
    {
        LAS float* scr = (LAS float*)c.lds + c.wave * (64 * 65 + 64);
        const int gw = c.bid * NWAVES + c.wave, NGW = c.G * NWAVES;
        constexpr int I_IN = 16 * 68, I_BRM = 8 * 16, I_BRA = 8 * 16, I_OUT = 16 * 16, I_GU1 = 16 * 8, I_DN1 = 8 * 16;
        constexpr int PER_LAYER = I_IN + I_BRM + I_BRA + I_OUT + NE * 2 * I_GU1 + NE * I_DN1;
        for (int it = gw; it < 2 * PER_LAYER; it += NGW) {
            const int l = it / PER_LAYER; int r = it % PER_LAYER; unsigned char* wl = c.wl(l);
            if (r < I_IN) { const int kb = r / 68, nb = r % 68; const int n0 = nb * 64; const int ns = n0 < 1536 ? n0 : n0 + 8;
                conv_tile(c.a.in[I_WIN] + (size_t)l * D * D_IN, D_IN, kb * 64, ns, (bf16*)(wl + W_IN), D, n0, scr, c.lane); continue; } r -= I_IN;
            if (r < I_BRM) { const int kb = r / 16, nb = r % 16;
                conv_tile(c.a.in[I_WBRM] + (size_t)l * 512 * D, D, kb * 64, nb * 64, (bf16*)(wl + W_BR), D, nb * 64, scr, c.lane); continue; } r -= I_BRM;
            if (r < I_BRA) { const int kb = r / 16, nb = r % 16;
                conv_tile(c.a.in[I_WBRA] + (size_t)l * 512 * D, D, kb * 64, nb * 64, (bf16*)(wl + W_BR) + 512, D, nb * 64, scr, c.lane); continue; } r -= I_BRA;
            if (r < I_OUT) { const int kb = r / 16, nb = r % 16;
                conv_tile(c.a.in[I_WOUT] + (size_t)l * D * D, D, kb * 64, nb * 64, (bf16*)(wl + W_OUT), D, nb * 64, scr, c.lane); continue; } r -= I_OUT;
            if (r < NE * 2 * I_GU1) { const int e = r / (2 * I_GU1); int q = r % (2 * I_GU1); const int up = q / I_GU1; q %= I_GU1; const int kb = q / 8, nb = q % 8;
                const float* src = (up ? c.a.in[I_WU] : c.a.in[I_WG]) + ((size_t)l * NE + e) * D * DE;
                const int j0 = nb * 64; const int drow = (j0 / 128) * 256 + up * 128 + (j0 % 128);
                conv_tile(src, DE, kb * 64, j0, (bf16*)(wl + W_GU) + (size_t)e * 1024 * D, D, drow, scr, c.lane); continue; } r -= NE * 2 * I_GU1;
            { const int e = r / I_DN1; const int q = r % I_DN1; const int kb = q / 16, nb = q % 16;
                conv_tile(c.a.in[I_WD] + ((size_t)l * NE + e) * DE * D, D, kb * 64, nb * 64, (bf16*)(wl + W_DN) + (size_t)e * D * DE, DE, nb * 64, scr, c.lane); }
        }
    }
}

__device__ __forceinline__ void phase_xn(const Ctx& c, int l) {
    LAS float* w8 = (LAS float*)c.lds;
    const float* win = c.a.in[I_WIN] + (size_t)l * D * D_IN;
    for (int i = c.tid; i < 8192; i += NT) { const int k = i >> 3, j = i & 7; w8[j * 1024 + k] = win[(size_t)k * D_IN + 1536 + j]; }
    __syncthreads();
    const float* xs = (l == 0) ? c.a.in[I_X] : c.a.out;
    const float* wn = c.a.in[I_WN1] + l * D; const float* mod = c.mod(l);
    bf16* XN = (bf16*)(c.a.ws + WS_XA); float* IFG = (float*)(c.a.ws + WS_IFG);
    const int gw = c.bid * NWAVES + c.wave, NGW = c.G * NWAVES;
    for (int m = gw; m < T; m += NGW) {
        const int b = m / SEQ; const f32x4* xr = (const f32x4*)(xs + (size_t)m * D) + c.lane;
        f32x4 v[4]; float s = 0.f;
#pragma unroll
        for (int j = 0; j < 4; ++j) { v[j] = xr[64 * j]; s += (v[j].x * v[j].x + v[j].y * v[j].y) + (v[j].z * v[j].z + v[j].w * v[j].w); }
        const float rstd = rsqrtf(wave_sum(s) * (1.f / D) + EPS);
        float g[8] = {0.f, 0.f, 0.f, 0.f, 0.f, 0.f, 0.f, 0.f};
        u32x2* o8 = (u32x2*)(XN + (size_t)m * D) + c.lane;
#pragma unroll
        for (int j = 0; j < 4; ++j) { const int col = 256 * j + 4 * c.lane;
            const f32x4 w = *(const f32x4*)(wn + col), sh = *(const f32x4*)(mod + b * 6144 + col), sc = *(const f32x4*)(mod + b * 6144 + 1024 + col);
            v[j] = (v[j] * rstd * w) * (sc + 1.f) + sh;
            u32x2 o; o.x = pk2(v[j].x, v[j].y); o.y = pk2(v[j].z, v[j].w); o8[64 * j] = o; }
#pragma unroll
        for (int q = 0; q < 8; ++q) {
#pragma unroll
            for (int j = 0; j < 4; ++j) { const f32x4 ww = *(const LAS f32x4*)(w8 + q * 1024 + 256 * j + 4 * c.lane); g[q] += (v[j].x * ww.x + v[j].y * ww.y) + (v[j].z * ww.z + v[j].w * ww.w); }
            asm volatile("" ::: "memory"); }
#pragma unroll
        for (int q = 0; q < 8; ++q) g[q] = wave_sum(g[q]);
        if (c.lane < 8) { float val = 0.f;
#pragma unroll
            for (int q = 0; q < 8; ++q) val = (c.lane == q) ? g[q] : val;
            const float bias = (c.lane < 4) ? c.a.in[I_BIG][l * 4 + c.lane] : c.a.in[I_BFG][l * 4 + c.lane - 4];
            IFG[(size_t)m * 8 + c.lane] = val + bias; }
    }
}

template <class RowA, class RowB0, class RowB1, class Epi>
__device__ __forceinline__ void naive_gemm_tile(const Ctx& c, int m0, int n0, int K0, int K1, const RowA& ra, const RowA& ra1, const RowB0& rb0, const RowB1& rb1, const Epi& epi) {
    LAS float* As = (LAS float*)c.lds;
    LAS float* Bs = As + 32 * 132;
    const int ty = c.tid >> 4, tx = c.tid & 15;
    f32x4 acc[2][4];
#pragma unroll
    for (int p = 0; p < 2; ++p)
#pragma unroll
        for (int i = 0; i < 4; ++i) acc[p][i] = (f32x4){0.f, 0.f, 0.f, 0.f};
#pragma unroll
    for (int p = 0; p < 2; ++p) {
        const int K = p ? K1 : K0;
        const int ar = c.tid >> 2, akc = c.tid & 3;
        const bf16* arow = p ? ra1(m0 + ar) : ra(m0 + ar);
        const int br = (c.tid & 255) >> 2, bkc = c.tid & 3;
        const bf16* brow = p ? rb1(n0 + br) : rb0(n0 + br);
        for (int k0 = 0; k0 < K; k0 += 32) {
            __syncthreads();
            { const u32x4 v = *(const u32x4*)(arow + k0 + 8 * akc); LAS float* d = As + (8 * akc) * 132 + ar;
              d[0] = bflo(v.x); d[132] = bfhi(v.x); d[2 * 132] = bflo(v.y); d[3 * 132] = bfhi(v.y); d[4 * 132] = bflo(v.z); d[5 * 132] = bfhi(v.z); d[6 * 132] = bflo(v.w); d[7 * 132] = bfhi(v.w); }
            if (c.tid < 256) { const u32x4 v = *(const u32x4*)(brow + k0 + 8 * bkc); LAS float* d = Bs + (8 * bkc) * 68 + br;
              d[0] = bflo(v.x); d[68] = bfhi(v.x); d[2 * 68] = bflo(v.y); d[3 * 68] = bfhi(v.y); d[4 * 68] = bflo(v.z); d[5 * 68] = bfhi(v.z); d[6 * 68] = bflo(v.w); d[7 * 68] = bfhi(v.w); }
            __syncthreads();
#pragma unroll 8
            for (int k = 0; k < 32; ++k) { const f32x4 av = *(const LAS f32x4*)(As + k * 132 + 4 * ty), bv = *(const LAS f32x4*)(Bs + k * 68 + 4 * tx);
                acc[p][0] += av.x * bv; acc[p][1] += av.y * bv; acc[p][2] += av.z * bv; acc[p][3] += av.w * bv; }
        }
    }
#pragma unroll
    for (int i = 0; i < 4; ++i) epi(m0 + 4 * ty + i, n0 + 4 * tx, acc[0][i], acc[1][i]);
}

struct RowPlain { const bf16* p; int ld; __device__ __forceinline__ const bf16* operator()(int r) const { return p + (size_t)r * ld; } };
struct RowGather { const bf16* p; int ld; const int* map; __device__ __forceinline__ const bf16* operator()(int r) const { return p + (size_t)map[r] * ld; } };
struct RowGU { const bf16* p; int up; __device__ __forceinline__ const bf16* operator()(int j) const { return p + (size_t)((j >> 7) * 256 + up * 128 + (j & 127)) * D; } };

struct EpiZ { bf16* z; __device__ __forceinline__ void operator()(int r, int cc, f32x4 a, f32x4) const { u32x2 o; o.x = pk2(a.x, a.y); o.y = pk2(a.z, a.w); *(u32x2*)(z + (size_t)r * ZW + cc) = o; } };
struct EpiBR { const bf16* z; bf16* mg; __device__ __forceinline__ void operator()(int r, int cc, f32x4 a, f32x4 b) const {
    const u32x2 gm = *(const u32x2*)(z + (size_t)r * ZW + Z_GM + cc), ga = *(const u32x2*)(z + (size_t)r * ZW + Z_GA + cc);
    const float m0 = sigmoidf_(bflo(gm.x)) * a.x + sigmoidf_(bflo(ga.x)) * b.x, m1 = sigmoidf_(bfhi(gm.x)) * a.y + sigmoidf_(bfhi(ga.x)) * b.y;
    const float m2 = sigmoidf_(bflo(gm.y)) * a.z + sigmoidf_(bflo(ga.y)) * b.z, m3 = sigmoidf_(bfhi(gm.y)) * a.w + sigmoidf_(bfhi(ga.y)) * b.w;
    u32x2 o; o.x = pk2(m0, m1); o.y = pk2(m2, m3); *(u32x2*)(mg + (size_t)r * D + cc) = o; } };
struct EpiOut { const float* xin; float* xout; const float* g1; __device__ __forceinline__ void operator()(int r, int cc, f32x4 a, f32x4) const {
    const int b = r / SEQ; const f32x4 g = *(const f32x4*)(g1 + b * 6144 + cc), xo = *(const f32x4*)(xin + (size_t)r * D + cc);
    *(f32x4*)(xout + (size_t)r * D + cc) = xo + g * a; } };
struct EpiAct { bf16* act; __device__ __forceinline__ void operator()(int r, int cc, f32x4 a, f32x4 b) const {
    u32x2 o; o.x = pk2(siluf_(a.x) * b.x, siluf_(a.y) * b.y); o.y = pk2(siluf_(a.z) * b.z, siluf_(a.w) * b.w); *(u32x2*)(act + (size_t)r * DE + cc) = o; } };
struct EpiY { bf16* y; __device__ __forceinline__ void operator()(int r, int cc, f32x4 a, f32x4) const { u32x2 o; o.x = pk2(a.x, a.y); o.y = pk2(a.z, a.w); *(u32x2*)(y + (size_t)r * D + cc) = o; } };

__device__ __forceinline__ void phase_inproj(const Ctx& c, int l) {
    const RowPlain ra{(const bf16*)(c.a.ws + WS_XA), D}, rb{(const bf16*)(c.wl(l) + W_IN), D}; const EpiZ e{(bf16*)(c.a.ws + WS_Z)};
    constexpr int NTN = ZW / 64, NTM = T / 128;
    for (int u = c.bid; u < NTN * NTM; u += c.G) naive_gemm_tile(c, (u / NTN) * 128, (u % NTN) * 64, D, 0, ra, ra, rb, rb, e);
}
__device__ __forceinline__ void phase_br(const Ctx& c, int l) {
    const bf16* hc = (const bf16*)(c.a.ws + WS_HCAT); const bf16* w = (const bf16*)(c.wl(l) + W_BR);
    const RowPlain ra{hc, D}, ra1{hc + 512, D}, rb0{w, D}, rb1{w + 512, D}; const EpiBR e{(const bf16*)(c.a.ws + WS_Z), (bf16*)(c.a.ws + WS_XA)};
    constexpr int NTN = D / 64, NTM = T / 128;
    for (int u = c.bid; u < NTN * NTM; u += c.G) naive_gemm_tile(c, (u / NTN) * 128, (u % NTN) * 64, 512, 512, ra, ra1, rb0, rb1, e);
}
__device__ __forceinline__ void phase_out(const Ctx& c, int l) {
    const RowPlain ra{(const bf16*)(c.a.ws + WS_XA), D}, rb{(const bf16*)(c.wl(l) + W_OUT), D};
    const EpiOut e{l == 0 ? c.a.in[I_X] : c.a.out, c.a.out, c.mod(l) + 2048};
    constexpr int NTN = D / 64, NTM = T / 128;
    for (int u = c.bid; u < NTN * NTM; u += c.G) naive_gemm_tile(c, (u / NTN) * 128, (u % NTN) * 64, D, 0, ra, ra, rb, rb, e);
}

__device__ __forceinline__ void naive_mlstm(const Ctx& c, int l, int bh) {
    const int b = bh >> 2, h = bh & 3, d = c.tid >> 2, eq = c.tid & 3, e0 = eq * 16;
    const bf16* z = (const bf16*)(c.a.ws + WS_Z); const float* IFG = (const float*)(c.a.ws + WS_IFG); float* HR = (float*)(c.a.ws + WS_XA);
    const float* cw = c.a.in[I_CONVW] + (size_t)l * 4 * 512; const float* cb = c.a.in[I_CONVB] + l * 512;
    float C[16], n[16], m = 0.f;
#pragma unroll
    for (int i = 0; i < 16; ++i) { C[i] = 0.f; n[i] = 0.f; }
    LAS float* cwl = (LAS float*)c.lds;
    for (int i = c.tid; i < 640; i += NT) { if (i < 512) { const int j = i >> 7, ch = i & 127; cwl[i] = cw[j * 512 + (ch < 64 ? h * 64 + ch : 256 + h * 64 + ch - 64)]; } else { const int ch = i - 512; cwl[i] = cb[ch < 64 ? h * 64 + ch : 256 + h * 64 + ch - 64]; } }
    __syncthreads();
    for (int s = 0; s < SEQ; ++s) {
        const size_t t = (size_t)b * SEQ + s;
        float q[16], k[16];
#pragma unroll
        for (int i = 0; i < 16; ++i) { q[i] = cwl[512 + e0 + i]; k[i] = cwl[512 + 64 + e0 + i]; }
#pragma unroll
        for (int j = 0; j < 4; ++j) { const int sj = s - 3 + j; if (sj >= 0) { const bf16* zr = z + ((size_t)b * SEQ + sj) * ZW;
            const u32x4 q0 = *(const u32x4*)(zr + Z_QM + h * 64 + e0), q1 = *(const u32x4*)(zr + Z_QM + h * 64 + e0 + 8);
            const u32x4 k0 = *(const u32x4*)(zr + Z_KM + h * 64 + e0), k1 = *(const u32x4*)(zr + Z_KM + h * 64 + e0 + 8);
            const unsigned qa[8] = {q0.x, q0.y, q0.z, q0.w, q1.x, q1.y, q1.z, q1.w}, ka[8] = {k0.x, k0.y, k0.z, k0.w, k1.x, k1.y, k1.z, k1.w};
#pragma unroll
            for (int i = 0; i < 8; ++i) { q[2 * i] += cwl[j * 128 + e0 + 2 * i] * bflo(qa[i]); q[2 * i + 1] += cwl[j * 128 + e0 + 2 * i + 1] * bfhi(qa[i]); k[2 * i] += cwl[j * 128 + 64 + e0 + 2 * i] * bflo(ka[i]); k[2 * i + 1] += cwl[j * 128 + 64 + e0 + 2 * i + 1] * bfhi(ka[i]); } }
            asm volatile("" ::: "memory"); }
#pragma unroll
        for (int i = 0; i < 16; ++i) { q[i] = siluf_(q[i]) * 0.125f; k[i] = siluf_(k[i]); }
        const float v = bf2f(z[t * ZW + Z_VM + h * 128 + d]);
        const float ig = IFG[t * 8 + h], fp = IFG[t * 8 + 4 + h];
        const float logf = fminf(fp, 0.f) - log1pf(__expf(-fabsf(fp)));
        const float mn = fmaxf(logf + m, ig), dec = __expf(logf + m - mn), fr = __expf(ig - mn);
        float num = 0.f, den = 0.f;
#pragma unroll
        for (int i = 0; i < 16; ++i) { C[i] = dec * C[i] + fr * v * k[i]; n[i] = dec * n[i] + fr * k[i]; num += C[i] * q[i]; den += n[i] * q[i]; }
        num += __shfl_xor(num, 1); num += __shfl_xor(num, 2); den += __shfl_xor(den, 1); den += __shfl_xor(den, 2);
        m = mn;
        if (eq == 0) HR[t * 512 + h * 128 + d] = num / fmaxf(fabsf(den), __expf(-mn));
    }
}
__device__ __forceinline__ void naive_swa(const Ctx& c, int l, int first_blk) {
    const bf16* z = (const bf16*)(c.a.ws + WS_Z); bf16* hc = (bf16*)(c.a.ws + WS_HCAT);
    const float* relb = c.a.in[I_RELB]; const float* sinks = c.a.in[I_SINK] + l * AH;
    const int nblk = c.G - first_blk;
    for (int idx = (c.bid - first_blk) * NT + c.tid; idx < T * AH * 4; idx += nblk * NT) {
        const int part = idx & 3, hd = (idx >> 2) & 7, t = idx >> 5, kh = hd >> 2, s = t % SEQ, d0 = part * 16;
        float q[16], o[16];
        { const bf16* qp = z + (size_t)t * ZW + Z_QA + hd * 64 + d0;
#pragma unroll
          for (int i = 0; i < 2; ++i) { const u32x4 v = *(const u32x4*)(qp + 8 * i); q[8 * i] = bflo(v.x); q[8 * i + 1] = bfhi(v.x); q[8 * i + 2] = bflo(v.y); q[8 * i + 3] = bfhi(v.y); q[8 * i + 4] = bflo(v.z); q[8 * i + 5] = bfhi(v.z); q[8 * i + 6] = bflo(v.w); q[8 * i + 7] = bfhi(v.w); } }
#pragma unroll
        for (int i = 0; i < 16; ++i) o[i] = 0.f;
        float mx = sinks[hd], lsum = 1.f;
        const int j0 = s - 127 < 0 ? 0 : s - 127;
        for (int j = j0; j <= s; ++j) {
            const bf16* kp = z + (size_t)(t - s + j) * ZW + Z_KA + kh * 64 + d0; const bf16* vp = z + (size_t)(t - s + j) * ZW + Z_VA + kh * 64 + d0;
            float sc = 0.f;
#pragma unroll
            for (int i = 0; i < 2; ++i) { const u32x4 v = *(const u32x4*)(kp + 8 * i);
                sc += q[8 * i] * bflo(v.x) + q[8 * i + 1] * bfhi(v.x) + q[8 * i + 2] * bflo(v.y) + q[8 * i + 3] * bfhi(v.y) + q[8 * i + 4] * bflo(v.z) + q[8 * i + 5] * bfhi(v.z) + q[8 * i + 6] * bflo(v.w) + q[8 * i + 7] * bfhi(v.w); }
            sc += __shfl_xor(sc, 1); sc += __shfl_xor(sc, 2);
            sc = sc * 0.125f + relb[T5_BUCKET[s - j] * AH + hd];
            const float mn = fmaxf(mx, sc), corr = __expf(mx - mn), p = __expf(sc - mn);
            lsum = lsum * corr + p; mx = mn;
#pragma unroll
            for (int i = 0; i < 2; ++i) { const u32x4 v = *(const u32x4*)(vp + 8 * i);
                o[8 * i] = o[8 * i] * corr + p * bflo(v.x); o[8 * i + 1] = o[8 * i + 1] * corr + p * bfhi(v.x); o[8 * i + 2] = o[8 * i + 2] * corr + p * bflo(v.y); o[8 * i + 3] = o[8 * i + 3] * corr + p * bfhi(v.y);
                o[8 * i + 4] = o[8 * i + 4] * corr + p * bflo(v.z); o[8 * i + 5] = o[8 * i + 5] * corr + p * bfhi(v.z); o[8 * i + 6] = o[8 * i + 6] * corr + p * bflo(v.w); o[8 * i + 7] = o[8 * i + 7] * corr + p * bfhi(v.w); }
        }
        const float inv = 1.f / lsum; bf16* op = hc + (size_t)t * D + 512 + hd * 64 + d0;
#pragma unroll
        for (int i = 0; i < 2; ++i) { u32x4 w; w.x = pk2(o[8 * i] * inv, o[8 * i + 1] * inv); w.y = pk2(o[8 * i + 2] * inv, o[8 * i + 3] * inv); w.z = pk2(o[8 * i + 4] * inv, o[8 * i + 5] * inv); w.w = pk2(o[8 * i + 6] * inv, o[8 * i + 7] * inv); *(u32x4*)(op + 8 * i) = w; }
    }
}
__device__ __forceinline__ void phase_mix1(const Ctx& c, int l) {
    if (c.bid < 16) naive_mlstm(c, l, c.bid); else naive_swa(c, l, 16);
}
__device__ __forceinline__ void phase_mix2(const Ctx& c, int l) {
    const float* HR = (const float*)(c.a.ws + WS_XA); const bf16* z = (const bf16*)(c.a.ws + WS_Z); bf16* hc = (bf16*)(c.a.ws + WS_HCAT);
    const float* wm = c.a.in[I_WMN] + l * 512;
    const int gw = c.bid * NWAVES + c.wave, NGW = c.G * NWAVES;
    for (int it = gw; it < T * MH; it += NGW) { const int t = it >> 2, h = it & 3; const int col = h * 128 + 2 * c.lane;
        const float a0 = HR[(size_t)t * 512 + col], a1 = HR[(size_t)t * 512 + col + 1];
        const float rstd = rsqrtf(wave_sum(a0 * a0 + a1 * a1) * (1.f / 128.f) + EPS);
        const unsigned og = *(const unsigned*)(z + (size_t)t * ZW + Z_OM + col);
        *(unsigned*)(hc + (size_t)t * D + col) = pk2(a0 * rstd * wm[col] * sigmoidf_(bflo(og)), a1 * rstd * wm[col + 1] * sigmoidf_(bfhi(og))); }
}

__device__ __forceinline__ void phase_route(const Ctx& c, int l) {
    LAS float* wr = (LAS float*)c.lds;
    for (int i = c.tid; i < 16384; i += NT) { const int k = i >> 4, e = i & 15; wr[e * 1024 + k] = c.a.in[I_WR][i]; }
    __syncthreads();
    int* ROWTOK = (int*)(c.a.ws + WS_ROWTOK);
    for (int i = c.bid * NT + c.tid; i < MOE_ROWS; i += c.G * NT) ROWTOK[i] = 0;
    const float* wn = c.a.in[I_WN2] + l * D; const float* mod = c.mod(l); const float* rbias = c.a.in[I_RB];
    bf16* XN = (bf16*)(c.a.ws + WS_XA); int* RIDX = (int*)(c.a.ws + WS_RIDX); float* RW = (float*)(c.a.ws + WS_RW);
    unsigned* cnt = c.ctl() + CW_CNT + 64 * l;
    const int gw = c.bid * NWAVES + c.wave, NGW = c.G * NWAVES;
    for (int m = gw; m < T; m += NGW) {
        const int b = m / SEQ; const f32x4* xr = (const f32x4*)(c.a.out + (size_t)m * D) + c.lane;
        f32x4 v[4]; float s = 0.f;
#pragma unroll
        for (int j = 0; j < 4; ++j) { v[j] = xr[64 * j]; s += (v[j].x * v[j].x + v[j].y * v[j].y) + (v[j].z * v[j].z + v[j].w * v[j].w); }
        const float rstd = rsqrtf(wave_sum(s) * (1.f / D) + EPS);
        float lg[16];
#pragma unroll
        for (int e = 0; e < 16; ++e) lg[e] = 0.f;
        u32x2* o8 = (u32x2*)(XN + (size_t)m * D) + c.lane;
#pragma unroll
        for (int j = 0; j < 4; ++j) { const int col = 256 * j + 4 * c.lane;
            const f32x4 w = *(const f32x4*)(wn + col), sh = *(const f32x4*)(mod + b * 6144 + 3072 + col), sc = *(const f32x4*)(mod + b * 6144 + 4096 + col);
            v[j] = (v[j] * rstd * w) * (sc + 1.f) + sh;
            u32x2 o; o.x = pk2(v[j].x, v[j].y); o.y = pk2(v[j].z, v[j].w); o8[64 * j] = o; }
#pragma unroll
        for (int e = 0; e < 16; ++e) {
#pragma unroll
            for (int j = 0; j < 4; ++j) { const f32x4 ww = *(const LAS f32x4*)(wr + e * 1024 + 256 * j + 4 * c.lane); lg[e] += (v[j].x * ww.x + v[j].y * ww.y) + (v[j].z * ww.z + v[j].w * ww.w); }
            asm volatile("" ::: "memory"); }
#pragma unroll
        for (int e = 0; e < 16; ++e) lg[e] = wave_sum(lg[e]);
        float sc[16], sel[16];
#pragma unroll
        for (int e = 0; e < 16; ++e) { sc[e] = 1.f / (1.f + expf(-lg[e])); sel[e] = sc[e] + rbias[e]; }
        int bg = 0; float bgs = -INFINITY;
#pragma unroll
        for (int g = 0; g < 4; ++g) { float m1 = -INFINITY, m2 = -INFINITY;
#pragma unroll
            for (int i = 0; i < 4; ++i) { const float x = sel[4 * g + i]; if (x > m1) { m2 = m1; m1 = x; } else if (x > m2) m2 = x; }
            const float gs = m1 + m2; if (gs > bgs) { bgs = gs; bg = g; } }
        int i1 = -1, i2 = -1; float v1 = -INFINITY, v2 = -INFINITY;
#pragma unroll
        for (int e = 0; e < 16; ++e) { if ((e >> 2) == bg) { const float x = sel[e]; if (x > v1) { v2 = v1; i2 = i1; v1 = x; i1 = e; } else if (x > v2) { v2 = x; i2 = e; } } }
        float s1 = 0.f, s2 = 0.f;
#pragma unroll
        for (int e = 0; e < 16; ++e) { s1 = (e == i1) ? sc[e] : s1; s2 = (e == i2) ? sc[e] : s2; }
        if (c.lane == 0) { const float inv = 1.f / (s1 + s2); RIDX[2 * m] = i1; RIDX[2 * m + 1] = i2; RW[2 * m] = s1 * inv; RW[2 * m + 1] = s2 * inv;
            atomicAdd(cnt + i1, 1u); atomicAdd(cnt + i2, 1u); }
    }
}
__device__ __forceinline__ void phase_fill(const Ctx& c, int l) {
    LAS int* offs = (LAS int*)c.lds;
    const unsigned* cnt = c.ctl() + CW_CNT + 64 * l; unsigned* cur = c.ctl() + CW_CUR + 64 * l;
    if (c.tid == 0) { int o = 0; for (int e = 0; e < NE; ++e) { offs[e] = o; o += (int)((__hip_atomic_load(cnt + e, __ATOMIC_RELAXED, __HIP_MEMORY_SCOPE_AGENT) + 255u) & ~255u); } offs[NE] = o; }
    __syncthreads();
    const int* RIDX = (const int*)(c.a.ws + WS_RIDX); int* SLOT = (int*)(c.a.ws + WS_SLOT); int* ROWTOK = (int*)(c.a.ws + WS_ROWTOK);
    for (int i = c.bid * NT + c.tid; i < 2 * T; i += c.G * NT) { const int e = RIDX[i]; const int pos = (int)atomicAdd(cur + e, 1u); const int row = offs[e] + pos; ROWTOK[row] = i >> 1; SLOT[i] = row; }
    __syncthreads();
}
__device__ __forceinline__ void phase_g1(const Ctx& c, int l) {
    LAS int* offs = (LAS int*)(c.lds + 65536);
    const unsigned* cnt = c.ctl() + CW_CNT + 64 * l;
    if (c.tid == 0) { int o = 0; for (int e = 0; e < NE; ++e) { offs[e] = o; o += (int)((__hip_atomic_load(cnt + e, __ATOMIC_RELAXED, __HIP_MEMORY_SCOPE_AGENT) + 255u) & ~255u); } offs[NE] = o; }
    __syncthreads();
    const int R = offs[NE]; const int NTM = R / 128; constexpr int NTN = DE / 64;
    const RowGather ra{(const bf16*)(c.a.ws + WS_XA), D, (const int*)(c.a.ws + WS_ROWTOK)}; const EpiAct ep{(bf16*)(c.a.ws + WS_ACT)};
    for (int u = c.bid; u < NTM * NTN; u += c.G) { const int m0 = (u / NTN) * 128, n0 = (u % NTN) * 64; int e = 0; for (int i = 1; i < NE; ++i) if (m0 >= offs[i]) e = i;
        const bf16* w = (const bf16*)(c.wl(l) + W_GU) + (size_t)e * 1024 * D; const RowGU rb0{w, 0}, rb1{w, 1};
        naive_gemm_tile(c, m0, n0, D, D, ra, ra, rb0, rb1, ep); }
    __syncthreads();
}
__device__ __forceinline__ void phase_g2(const Ctx& c, int l) {
    LAS int* offs = (LAS int*)(c.lds + 65536);
    const unsigned* cnt = c.ctl() + CW_CNT + 64 * l;
    if (c.tid == 0) { int o = 0; for (int e = 0; e < NE; ++e) { offs[e] = o; o += (int)((__hip_atomic_load(cnt + e, __ATOMIC_RELAXED, __HIP_MEMORY_SCOPE_AGENT) + 255u) & ~255u); } offs[NE] = o; }
    __syncthreads();
    const int R = offs[NE]; const int NTM = R / 128; constexpr int NTN = D / 64;
    const RowPlain ra{(const bf16*)(c.a.ws + WS_ACT), DE}; const EpiY ep{(bf16*)(c.a.ws + WS_Y)};
    for (int u = c.bid; u < NTM * NTN; u += c.G) { const int m0 = (u / NTN) * 128, n0 = (u % NTN) * 64; int e = 0; for (int i = 1; i < NE; ++i) if (m0 >= offs[i]) e = i;
        const RowPlain rb{(const bf16*)(c.wl(l) + W_DN) + (size_t)e * D * DE, DE};
        naive_gemm_tile(c, m0, n0, DE, 0, ra, ra, rb, rb, ep); }
    __syncthreads();
}
__device__ __forceinline__ void phase_combine(const Ctx& c, int l) {
    const float* mod = c.mod(l); const bf16* Y = (const bf16*)(c.a.ws + WS_Y); const int* SLOT = (const int*)(c.a.ws + WS_SLOT); const float* RW = (const float*)(c.a.ws + WS_RW);
    const float* wf = c.a.in[I_WF];
    const int gw = c.bid * NWAVES + c.wave, NGW = c.G * NWAVES;
    for (int m = gw; m < T; m += NGW) {
        const int b = m / SEQ; f32x4* xr = (f32x4*)(c.a.out + (size_t)m * D) + c.lane;
        const int s0 = SLOT[2 * m], s1 = SLOT[2 * m + 1]; const float w0 = RW[2 * m], w1 = RW[2 * m + 1];
        const u32x2* y0 = (const u32x2*)(Y + (size_t)s0 * D) + c.lane; const u32x2* y1 = (const u32x2*)(Y + (size_t)s1 * D) + c.lane;
        f32x4 v[4]; float s = 0.f;
#pragma unroll
        for (int j = 0; j < 4; ++j) { const int col = 256 * j + 4 * c.lane; const f32x4 g = *(const f32x4*)(mod + b * 6144 + 5120 + col);
            const u32x2 a = y0[64 * j], bb = y1[64 * j];
            const f32x4 ya = {bflo(a.x), bfhi(a.x), bflo(a.y), bfhi(a.y)}, yb = {bflo(bb.x), bfhi(bb.x), bflo(bb.y), bfhi(bb.y)};
            v[j] = xr[64 * j] + g * (ya * w0 + yb * w1);
            s += (v[j].x * v[j].x + v[j].y * v[j].y) + (v[j].z * v[j].z + v[j].w * v[j].w); }
        if (l == DEPTH - 1) { const float rstd = rsqrtf(wave_sum(s) * (1.f / D) + EPS);
#pragma unroll
            for (int j = 0; j < 4; ++j) xr[64 * j] = v[j] * rstd * *(const f32x4*)(wf + 256 * j + 4 * c.lane); }
        else {
#pragma unroll
            for (int j = 0; j < 4; ++j) xr[64 * j] = v[j]; }
    }
}

#define XB_TMO      128
#define XB_XCNT(j)  (256  + 64 * (j))
#define XB_XSUB(j)  (1280 + 64 * (j))
#define XB_XGEN(j)  (2304 + 64 * (j))
#define XB_TOP      3328
#define XB_TOPGEN   3392
#define XCD_BAR_WORDS 3456
#define XB_SPIN_CAP (1u << 22)
constexpr int CW_BAR = 8192;
__device__ __forceinline__ unsigned xb_ld(unsigned* p)              { return __hip_atomic_load(p, __ATOMIC_RELAXED, __HIP_MEMORY_SCOPE_AGENT); }
__device__ __forceinline__ unsigned xb_add(unsigned* p, unsigned v) { return __hip_atomic_fetch_add(p, v, __ATOMIC_RELAXED, __HIP_MEMORY_SCOPE_AGENT); }
__device__ __forceinline__ unsigned xb_xcc_id() { return (unsigned)__builtin_amdgcn_s_getreg((3 << 11) | 20) & 0xFu; }
#define XB_SPIN(cond, bar) do { unsigned _sp = 0; while (cond) { __builtin_amdgcn_s_sleep(1); \
    if ((++_sp & 255u) == 0u) { if (xb_ld(&(bar)[XB_TMO])) break; if (_sp > XB_SPIN_CAP) { atomicAdd(&(bar)[XB_TMO], 1u); break; } } } } while (0)
struct XcdBarrier { unsigned* bar; unsigned x; volatile LAS unsigned* st; };
__device__ __forceinline__ XcdBarrier xcd_barrier_post(unsigned* bar, volatile LAS unsigned* st) {
    XcdBarrier b; b.bar = bar; b.x = xb_xcc_id(); b.st = st;
    if (threadIdx.x == 0) (void)xb_add(&bar[XB_XCNT(b.x)], 1u);
    return b;
}
__device__ __forceinline__ void xcd_barrier_complete(unsigned* bar, unsigned x, unsigned& nloc, unsigned& nx) {
    const unsigned G = gridDim.x * gridDim.y * gridDim.z;
    unsigned sum, cnt, mine, sp = 0u;
    for (;;) {
        sum = 0u; cnt = 0u; mine = 0u;
#pragma unroll
        for (unsigned j = 0; j < 16; ++j) { const unsigned c = xb_ld(&bar[XB_XCNT(j)]); sum += c; cnt += (c > 0u) ? 1u : 0u; mine = (j == x) ? c : mine; }
        if (sum == G) break;
        __builtin_amdgcn_s_sleep(1);
        if ((++sp & 255u) == 0u) { if (xb_ld(&bar[XB_TMO])) break; if (sp > XB_SPIN_CAP) { atomicAdd(&bar[XB_TMO], 1u); break; } }
    }
    nloc = mine > 0u ? mine : 1u; nx = cnt > 0u ? cnt : 1u;
}
__device__ __forceinline__ void xcd_barrier(const XcdBarrier& b) {
    asm volatile("s_waitcnt vmcnt(0)" ::: "memory");
    __syncthreads();
    if (threadIdx.x == 0) {
        unsigned* bar = b.bar;
        __builtin_amdgcn_s_waitcnt(0);
        unsigned nloc = b.st[0], nx = b.st[1];
        if (nloc == 0u) { xcd_barrier_complete(bar, b.x, nloc, nx); b.st[0] = nloc; b.st[1] = nx; }
        const unsigned old = xb_add(&bar[XB_XSUB(b.x)], 1u);
        const unsigned gen = old / nloc;
        if (old + 1u == (gen + 1u) * nloc) {
            __builtin_amdgcn_fence(__ATOMIC_RELEASE, "agent");
            asm volatile("s_waitcnt vmcnt(0)" ::: "memory");
            const unsigned og = xb_add(&bar[XB_TOP], 1u);
            const unsigned tg = og / nx;
            if (og + 1u == (tg + 1u) * nx) xb_add(&bar[XB_TOPGEN], 1u);
            else XB_SPIN(xb_ld(&bar[XB_TOPGEN]) == tg, bar);
            __builtin_amdgcn_fence(__ATOMIC_ACQUIRE, "agent");
            xb_add(&bar[XB_XGEN(b.x)], 1u);
            asm volatile("s_waitcnt vmcnt(0)" ::: "memory");
        } else {
            XB_SPIN(xb_ld(&bar[XB_XGEN(b.x)]) == gen, bar);
            __builtin_amdgcn_fence(__ATOMIC_ACQUIRE, "agent");
            asm volatile("s_waitcnt vmcnt(0)" ::: "memory");
        }
    }
    __syncthreads();
}

constexpr int MISC_OFF = 143360 + 320;
#ifndef MK_MULTI
#define MK_MULTI 0
#endif
constexpr int PH_PER_LAYER = 11, NPHASES = 1 + DEPTH * PH_PER_LAYER;
__device__ __forceinline__ void run_phase(const Ctx& c, int l, int p) {
    switch (p) {
        case 0: phase_xn(c, l); break;
        case 1: phase_inproj(c, l); break;
        case 2: phase_mix1(c, l); break;
        case 3: phase_mix2(c, l); break;
        case 4: phase_br(c, l); break;
        case 5: phase_out(c, l); break;
        case 6: phase_route(c, l); break;
        case 7: phase_fill(c, l); break;
        case 8: phase_g1(c, l); break;
        case 9: phase_g2(c, l); break;
        case 10: phase_combine(c, l); break;
    }
}
__global__ void __launch_bounds__(NT, 2) mega(Args a) {
    extern __shared__ __attribute__((aligned(16))) unsigned char lds_raw[];
    Ctx c; c.a = a; c.lds = (LAS unsigned char*)lds_raw; c.tid = threadIdx.x; c.lane = c.tid & 63; c.wave = __builtin_amdgcn_readfirstlane(c.tid >> 6); c.G = gridDim.x; c.bid = blockIdx.x;
#if MK_MULTI
    { const int ph = a.ph_lo; if (ph == 0) { phase_prologue(c); return; } run_phase(c, (ph - 1) / PH_PER_LAYER, (ph - 1) % PH_PER_LAYER); }
#else
    volatile LAS unsigned* MISC = (volatile LAS unsigned*)(c.lds + MISC_OFF);
    if (c.tid < 32) MISC[c.tid] = 0u;
    __syncthreads();
    const XcdBarrier bar = xcd_barrier_post(c.ctl() + CW_BAR, MISC + 8);
    phase_prologue(c); xcd_barrier(bar);
#pragma unroll 1
    for (int l = 0; l < DEPTH; ++l) {
        phase_xn(c, l); xcd_barrier(bar);
        phase_inproj(c, l); xcd_barrier(bar);
        phase_mix1(c, l); xcd_barrier(bar);
        phase_mix2(c, l); xcd_barrier(bar);
        phase_br(c, l); xcd_barrier(bar);
        phase_out(c, l); xcd_barrier(bar);
        phase_route(c, l); xcd_barrier(bar);
        phase_fill(c, l); xcd_barrier(bar);
        phase_g1(c, l); xcd_barrier(bar);
        phase_g2(c, l); xcd_barrier(bar);
        phase_combine(c, l); if (l + 1 < DEPTH) xcd_barrier(bar);
    }
#endif
}

extern "C" void kernel_launch(void* const* d_in, const int* in_sizes, int n_in, void* d_out, int out_size, void* d_ws, size_t ws_size, hipStream_t stream) {
    static int grid = 0;
    if (grid == 0) {
        if (n_in != 23 || out_size != T * D || ws_size < WS_END) { fprintf(stderr, "kernel_launch: unexpected shapes (n_in %d out %d ws %zu need %zu)\n", n_in, out_size, ws_size, (size_t)WS_END); grid = -1; return; }
        int dev = 0, cus = 0, per_cu = 0;
        if (hipGetDevice(&dev) != hipSuccess || hipDeviceGetAttribute(&cus, hipDeviceAttributeMultiprocessorCount, dev) != hipSuccess) { grid = -1; return; }
        if (hipFuncSetAttribute((const void*)mega, hipFuncAttributeMaxDynamicSharedMemorySize, LDS_BYTES) != hipSuccess) { grid = -1; return; }
        if (hipOccupancyMaxActiveBlocksPerMultiprocessor(&per_cu, (const void*)mega, NT, LDS_BYTES) != hipSuccess || per_cu < 1) { fprintf(stderr, "kernel_launch: occupancy query says %d blocks per CU\n", per_cu); (void)hipGetLastError(); grid = -1; return; }
        grid = cus;
    }
    if (grid < 0) return;
    (void)hipMemsetAsync((char*)d_ws + WS_CTL, 0, CTL_BYTES, stream);
    Args a{};
    for (int i = 0; i < 23; ++i) a.in[i] = (const float*)d_in[i];
    a.out = (float*)d_out; a.ws = (unsigned char*)d_ws;
#if MK_MULTI
    for (int ph = 0; ph < NPHASES; ++ph) { a.ph_lo = ph; a.ph_hi = ph + 1; hipLaunchKernelGGL(mega, dim3(grid), dim3(NT), LDS_BYTES, stream, a); }
#else
    a.ph_lo = 0; a.ph_hi = NPHASES;
    hipLaunchKernelGGL(mega, dim3(grid), dim3(NT), LDS_BYTES, stream, a);
#endif
}
```

```cpp
#include <hip/hip_runtime.h>
#include <cstdio>
#include <cstdint>

constexpr int NB = 4, SEQ = 4096, T = NB * SEQ, D = 1024, DEPTH = 2;
constexpr int MH = 4, DQK = 64, DV = 128;
constexpr int AH = 8, AKV = 2, AD = 64;
constexpr int NE = 16, DE = 512;
constexpr int D_IN = 4360, ZW = 4352;
constexpr int Z_QM = 0, Z_KM = 256, Z_VM = 512, Z_OM = 1024, Z_QA = 1536, Z_KA = 2048, Z_VA = 2176, Z_GM = 2304, Z_GA = 3328;
constexpr float EPS = 1e-6f;
constexpr int MOE_ROWS = 2 * T + NE * 256;

constexpr size_t MiB = 1u << 20;
constexpr size_t WS_CTL = 0, CTL_BYTES = 1 * MiB;
constexpr size_t WS_MOD = 1 * MiB;
constexpr size_t WS_IFG = WS_MOD + 256 * 1024;
constexpr size_t WS_RIDX = WS_IFG + 512 * 1024;
constexpr size_t WS_RW = WS_RIDX + 128 * 1024;
constexpr size_t WS_SLOT = WS_RW + 128 * 1024;
constexpr size_t WS_ROWTOK = WS_SLOT + 128 * 1024;
constexpr size_t WS_SMALL_END = WS_ROWTOK + 256 * 1024;
static_assert(WS_SMALL_END <= 4 * MiB, "small region");
constexpr size_t WS_W = 4 * MiB;
constexpr size_t W_IN = 0;
constexpr size_t W_BR = W_IN + (size_t)ZW * D * 2;
constexpr size_t W_OUT = W_BR + (size_t)D * D * 2;
constexpr size_t W_GU = W_OUT + (size_t)D * D * 2;
constexpr size_t W_DN = W_GU + (size_t)NE * 1024 * D * 2;
constexpr size_t LAYER_W = W_DN + (size_t)NE * D * DE * 2;
constexpr size_t WS_Z = WS_W + 2 * LAYER_W;
constexpr size_t WS_ACT = WS_Z;
constexpr size_t WS_Y = WS_ACT + (size_t)MOE_ROWS * DE * 2;
constexpr size_t WS_XA = WS_Z + (size_t)T * ZW * 2;
constexpr size_t WS_HCAT = WS_XA + (size_t)T * D * 2;
constexpr size_t WS_END = WS_HCAT + (size_t)T * D * 2;
static_assert(WS_Y + (size_t)MOE_ROWS * D * 2 <= WS_XA, "MoE overlay fits in z");
constexpr int CW_CNT = 1024;
constexpr int CW_CUR = 2048;

typedef unsigned short bf16;
typedef float f32x4 __attribute__((ext_vector_type(4)));
typedef unsigned u32x4 __attribute__((ext_vector_type(4)));
typedef unsigned u32x2 __attribute__((ext_vector_type(2)));
#define LAS __attribute__((address_space(3)))

__device__ __forceinline__ unsigned f2bf(float f) { unsigned u = __builtin_bit_cast(unsigned, f); return (u + 0x7fffu + ((u >> 16) & 1u)) >> 16; }
__device__ __forceinline__ unsigned pk2(float lo, float hi) { return f2bf(lo) | (f2bf(hi) << 16); }
__device__ __forceinline__ float bf2f(unsigned b) { return __builtin_bit_cast(float, b << 16); }
__device__ __forceinline__ float bflo(unsigned w) { return __builtin_bit_cast(float, w << 16); }
__device__ __forceinline__ float bfhi(unsigned w) { return __builtin_bit_cast(float, w & 0xffff0000u); }
__device__ __forceinline__ float sigmoidf_(float x) { return 1.f / (1.f + __expf(-x)); }
__device__ __forceinline__ float siluf_(float x) { return x / (1.f + __expf(-x)); }
__device__ __forceinline__ float wave_sum(float v) {
#pragma unroll
    for (int o = 1; o < 64; o <<= 1) v += __shfl_xor(v, o);
    return v;
}

__device__ const unsigned char T5_BUCKET[128] = {0,1,2,3,4,5,6,7,8,9,10,11,12,13,14,15,16,16,16,17,17,18,18,18,19,19,19,20,20,20,20,21,21,21,21,22,22,22,22,22,23,23,23,23,23,23,24,24,24,24,24,24,25,25,25,25,25,25,25,26,26,26,26,26,26,26,26,27,27,27,27,27,27,27,27,27,27,28,28,28,28,28,28,28,28,28,28,29,29,29,29,29,29,29,29,29,29,29,29,30,30,30,30,30,30,30,30,30,30,30,30,30,30,31,31,31,31,31,31,31,31,31,31,31,31,31,31,31};

struct Args {
    const float* in[23];
    float* out; unsigned char* ws;
    int ph_lo, ph_hi;
};
enum { I_X = 0, I_C, I_WADA, I_BADA, I_WN1, I_WIN, I_CONVW, I_CONVB, I_BIG, I_BFG, I_WMN, I_SINK, I_RELB, I_WBRM, I_WBRA, I_WOUT, I_WN2, I_WR, I_RB, I_WG, I_WU, I_WD, I_WF };

constexpr int NT = 512, NWAVES = 8;
constexpr int LDS_BYTES = 147456;

struct Ctx {
    Args a; LAS unsigned char* lds; int tid, lane, wave, G, bid;
    __device__ __forceinline__ unsigned* ctl() const { return (unsigned*)(a.ws + WS_CTL); }
    __device__ __forceinline__ float* mod(int l) const { return (float*)(a.ws + WS_MOD) + (size_t)l * 4 * 6144; }
    __device__ __forceinline__ unsigned char* wl(int l) const { return a.ws + WS_W + (size_t)l * LAYER_W; }
};

__device__ __forceinline__ void conv_tile(const float* src, int ldsrc, int k0, int n_src0, bf16* dst, int ldd, int dst_row0, LAS float* scr, int lane) {
#pragma unroll 4
    for (int i = 0; i < 16; ++i) { const int kk = 4 * i + (lane >> 4); const f32x4 v = *(const f32x4*)(src + (size_t)(k0 + kk) * ldsrc + n_src0 + 4 * (lane & 15));
        LAS float* p = scr + kk * 65 + 4 * (lane & 15); p[0] = v.x; p[1] = v.y; p[2] = v.z; p[3] = v.w; }
    asm volatile("s_waitcnt lgkmcnt(0)" ::: "memory");
    const int c = lane & 7;
#pragma unroll
    for (int j = 0; j < 8; ++j) { const int n = (lane >> 3) + 8 * j; const LAS float* s = scr + (8 * c) * 65 + n;
        u32x4 o; o.x = pk2(s[0], s[65]); o.y = pk2(s[2 * 65], s[3 * 65]); o.z = pk2(s[4 * 65], s[5 * 65]); o.w = pk2(s[6 * 65], s[7 * 65]);
        *(u32x4*)(dst + (size_t)(dst_row0 + n) * ldd + k0 + 8 * c) = o; }
    asm volatile("s_waitcnt lgkmcnt(0)" ::: "memory");
}

__device__ __forceinline__ void phase_prologue(const Ctx& c) {
    {
        LAS float* cond = (LAS float*)c.lds;
        LAS float* red = cond + 4096;
        for (int item = c.bid; item < 192; item += c.G) {
            __syncthreads();
            for (int i = c.tid; i < 4096; i += NT) cond[i] = siluf_(c.a.in[I_C][i]);
            __syncthreads();
            const int l = item / 96, col = (item % 96) * 64 + c.lane;
            const float* w = c.a.in[I_WADA] + (size_t)l * D * 6144 + col;
            float acc[4] = {0.f, 0.f, 0.f, 0.f};
            for (int k = c.wave * 128; k < c.wave * 128 + 128; ++k) { const float wv = w[(size_t)k * 6144];
#pragma unroll
                for (int b = 0; b < 4; ++b) acc[b] += cond[b * 1024 + k] * wv; }
#pragma unroll
            for (int b = 0; b < 4; ++b) red[(c.wave * 4 + b) * 64 + c.lane] = acc[b];
            __syncthreads();
            if (c.tid < 256) { const int b = c.tid >> 6, ln = c.tid & 63; float s = 0.f;
#pragma unroll
                for (int wv = 0; wv < 8; ++wv) s += red[(wv * 4 + b) * 64 + ln];
                const int cc = (item % 96) * 64 + ln;
                c.mod(l)[b * 6144 + cc] = s + c.a.in[I_BADA][l * 6144 + cc]; }
        }
        __syncthreads();
    }
    {
        LAS float* scr = (LAS float*)c.lds + c.wave * (64 * 65 + 64);
        const int gw = c.bid * NWAVES + c.wave, NGW = c.G * NWAVES;
        constexpr int I_IN = 16 * 68, I_BRM = 8 * 16, I_BRA = 8 * 16, I_OUT = 16 * 16, I_GU1 = 16 * 8, I_DN1 = 8 * 16;
        constexpr int PER_LAYER = I_IN + I_BRM + I_BRA + I_OUT + NE * 2 * I_GU1 + NE * I_DN1;
        for (int it = gw; it < 2 * PER_LAYER; it += NGW) {
            const int l = it / PER_LAYER; int r = it % PER_LAYER; unsigned char* wl = c.wl(l);
            if (r < I_IN) { const int kb = r / 68, nb = r % 68; const int n0 = nb * 64; const int ns = n0 < 1536 ? n0 : n0 + 8;
                conv_tile(c.a.in[I_WIN] + (size_t)l * D * D_IN, D_IN, kb * 64, ns, (bf16*)(wl + W_IN), D, n0, scr, c.lane); continue; } r -= I_IN;
            if (r < I_BRM) { const int kb = r / 16, nb = r % 16;
                conv_tile(c.a.in[I_WBRM] + (size_t)l * 512 * D, D, kb * 64, nb * 64, (bf16*)(wl + W_BR), D, nb * 64, scr, c.lane); continue; } r -= I_BRM;
            if (r < I_BRA) { const int kb = r / 16, nb = r % 16;
                conv_tile(c.a.in[I_WBRA] + (size_t)l * 512 * D, D, kb * 64, nb * 64, (bf16*)(wl + W_BR) + 512, D, nb * 64, scr, c.lane); continue; } r -= I_BRA;
            if (r < I_OUT) { const int kb = r / 16, nb = r % 16;
                conv_tile(c.a.in[I_WOUT] + (size_t)l * D * D, D, kb * 64, nb * 64, (bf16*)(wl + W_OUT), D, nb * 64, scr, c.lane); continue; } r -= I_OUT;
            if (r < NE * 2 * I_GU1) { const int e = r / (2 * I_GU1); int q = r % (2 * I_GU1); const int up = q / I_GU1; q %= I_GU1; const int kb = q / 8, nb = q % 8;
                const float* src = (up ? c.a.in[I_WU] : c.a.in[I_WG]) + ((size_t)l * NE + e) * D * DE;
                const int j0 = nb * 64; const int drow = (j0 / 128) * 256 + up * 128 + (j0 % 128);
                conv_tile(src, DE, kb * 64, j0, (bf16*)(wl + W_GU) + (size_t)e * 1024 * D, D, drow, scr, c.lane); continue; } r -= NE * 2 * I_GU1;
            { const int e = r / I_DN1; const int q = r % I_DN1; const int kb = q / 16, nb = q % 16;
                conv_tile(c.a.in[I_WD] + ((size_t)l * NE + e) * DE * D, D, kb * 64, nb * 64, (bf16*)(wl + W_DN) + (size_t)e * D * DE, DE, nb * 64, scr, c.lane); }
        }
    }
}

__device__ __forceinline__ void phase_xn(const Ctx& c, int l) {
    LAS float* w8 = (LAS float*)c.lds;
    const float* win = c.a.in[I_WIN] + (size_t)l * D * D_IN;
    for (int i = c.tid; i < 8192; i += NT) { const int k = i >> 3, j = i & 7; w8[j * 1024 + k] = win[(size_t)k * D_IN + 1536 + j]; }
    __syncthreads();
    const float* xs = (l == 0) ? c.a.in[I_X] : c.a.out;
    const float* wn = c.a.in[I_WN1] + l * D; const float* mod = c.mod(l);
    bf16* XN = (bf16*)(c.a.ws + WS_XA); float* IFG = (float*)(c.a.ws + WS_IFG);
    const int gw = c.bid * NWAVES + c.wave, NGW = c.G * NWAVES;
    for (int m = gw; m < T; m += NGW) {
        const int b = m / SEQ; const f32x4* xr = (const f32x4*)(xs + (size_t)m * D) + c.lane;
        f32x4 v[4]; float s = 0.f;
#pragma unroll
        for (int j = 0; j < 4; ++j) { v[j] = xr[64 * j]; s += (v[j].x * v[j].x + v[j].y * v[j].y) + (v[j].z * v[j].z + v[j].w * v[j].w); }
        const float rstd = rsqrtf(wave_sum(s) * (1.f / D) + EPS);
        float g[8] = {0.f, 0.f, 0.f, 0.f, 0.f, 0.f, 0.f, 0.f};
        u32x2* o8 = (u32x2*)(XN + (size_t)m * D) + c.lane;
#pragma unroll
        for (int j = 0; j < 4; ++j) { const int col = 256 * j + 4 * c.lane;
            const f32x4 w = *(const f32x4*)(wn + col), sh = *(const f32x4*)(mod + b * 6144 + col), sc = *(const f32x4*)(mod + b * 6144 + 1024 + col);
            v[j] = (v[j] * rstd * w) * (sc + 1.f) + sh;
            u32x2 o; o.x = pk2(v[j].x, v[j].y); o.y = pk2(v[j].z, v[j].w); o8[64 * j] = o; }
#pragma unroll
        for (int q = 0; q < 8; ++q) {
#pragma unroll
            for (int j = 0; j < 4; ++j) { const f32x4 ww = *(const LAS f32x4*)(w8 + q * 1024 + 256 * j + 4 * c.lane); g[q] += (v[j].x * ww.x + v[j].y * ww.y) + (v[j].z * ww.z + v[j].w * ww.w); }
            asm volatile("" ::: "memory"); }
#pragma unroll
        for (int q = 0; q < 8; ++q) g[q] = wave_sum(g[q]);
        if (c.lane < 8) { float val = 0.f;
#pragma unroll
            for (int q = 0; q < 8; ++q) val = (c.lane == q) ? g[q] : val;
            const float bias = (c.lane < 4) ? c.a.in[I_BIG][l * 4 + c.lane] : c.a.in[I_BFG][l * 4 + c.lane - 4];
            IFG[(size_t)m * 8 + c.lane] = val + bias; }
    }
}

template <class RowA, class RowB0, class RowB1, class Epi>
__device__ __forceinline__ void naive_gemm_tile(const Ctx& c, int m0, int n0, int K0, int K1, const RowA& ra, const RowA& ra1, const RowB0& rb0, const RowB1& rb1, const Epi& epi) {
    LAS float* As = (LAS float*)c.lds;
    LAS float* Bs = As + 32 * 132;
    const int ty = c.tid >> 4, tx = c.tid & 15;
    f32x4 acc[2][4];
#pragma unroll
    for (int p = 0; p < 2; ++p)
#pragma unroll
        for (int i = 0; i < 4; ++i) acc[p][i] = (f32x4){0.f, 0.f, 0.f, 0.f};
#pragma unroll
    for (int p = 0; p < 2; ++p) {
        const int K = p ? K1 : K0;
        const int ar = c.tid >> 2, akc = c.tid & 3;
        const bf16* arow = p ? ra1(m0 + ar) : ra(m0 + ar);
        const int br = (c.tid & 255) >> 2, bkc = c.tid & 3;
        const bf16* brow = p ? rb1(n0 + br) : rb0(n0 + br);
        for (int k0 = 0; k0 < K; k0 += 32) {
            __syncthreads();
            { const u32x4 v = *(const u32x4*)(arow + k0 + 8 * akc); LAS float* d = As + (8 * akc) * 132 + ar;
              d[0] = bflo(v.x); d[132] = bfhi(v.x); d[2 * 132] = bflo(v.y); d[3 * 132] = bfhi(v.y); d[4 * 132] = bflo(v.z); d[5 * 132] = bfhi(v.z); d[6 * 132] = bflo(v.w); d[7 * 132] = bfhi(v.w); }
            if (c.tid < 256) { const u32x4 v = *(const u32x4*)(brow + k0 + 8 * bkc); LAS float* d = Bs + (8 * bkc) * 68 + br;
              d[0] = bflo(v.x); d[68] = bfhi(v.x); d[2 * 68] = bflo(v.y); d[3 * 68] = bfhi(v.y); d[4 * 68] = bflo(v.z); d[5 * 68] = bfhi(v.z); d[6 * 68] = bflo(v.w); d[7 * 68] = bfhi(v.w); }
            __syncthreads();
#pragma unroll 8
            for (int k = 0; k < 32; ++k) { const f32x4 av = *(const LAS f32x4*)(As + k * 132 + 4 * ty), bv = *(const LAS f32x4*)(Bs + k * 68 + 4 * tx);
                acc[p][0] += av.x * bv; acc[p][1] += av.y * bv; acc[p][2] += av.z * bv; acc[p][3] += av.w * bv; }
        }
    }
#pragma unroll
    for (int i = 0; i < 4; ++i) epi(m0 + 4 * ty + i, n0 + 4 * tx, acc[0][i], acc[1][i]);
}

struct RowPlain { const bf16* p; int ld; __device__ __forceinline__ const bf16* operator()(int r) const { return p + (size_t)r * ld; } };
struct RowGather { const bf16* p; int ld; const int* map; __device__ __forceinline__ const bf16* operator()(int r) const { return p + (size_t)map[r] * ld; } };
struct RowGU { const bf16* p; int up; __device__ __forceinline__ const bf16* operator()(int j) const { return p + (size_t)((j >> 7) * 256 + up * 128 + (j & 127)) * D; } };

struct EpiZ { bf16* z; __device__ __forceinline__ void operator()(int r, int cc, f32x4 a, f32x4) const { u32x2 o; o.x = pk2(a.x, a.y); o.y = pk2(a.z, a.w); *(u32x2*)(z + (size_t)r * ZW + cc) = o; } };
struct EpiBR { const bf16* z; bf16* mg; __device__ __forceinline__ void operator()(int r, int cc, f32x4 a, f32x4 b) const {
    const u32x2 gm = *(const u32x2*)(z + (size_t)r * ZW + Z_GM + cc), ga = *(const u32x2*)(z + (size_t)r * ZW + Z_GA + cc);
    const float m0 = sigmoidf_(bflo(gm.x)) * a.x + sigmoidf_(bflo(ga.x)) * b.x, m1 = sigmoidf_(bfhi(gm.x)) * a.y + sigmoidf_(bfhi(ga.x)) * b.y;
    const float m2 = sigmoidf_(bflo(gm.y)) * a.z + sigmoidf_(bflo(ga.y)) * b.z, m3 = sigmoidf_(bfhi(gm.y)) * a.w + sigmoidf_(bfhi(ga.y)) * b.w;
    u32x2 o; o.x = pk2(m0, m1); o.y = pk2(m2, m3); *(u32x2*)(mg + (size_t)r * D + cc) = o; } };
struct EpiOut { const float* xin; float* xout; const float* g1; __device__ __forceinline__ void operator()(int r, int cc, f32x4 a, f32x4) const {
    const int b = r / SEQ; const f32x4 g = *(const f32x4*)(g1 + b * 6144 + cc), xo = *(const f32x4*)(xin + (size_t)r * D + cc);
    *(f32x4*)(xout + (size_t)r * D + cc) = xo + g * a; } };
struct EpiAct { bf16* act; __device__ __forceinline__ void operator()(int r, int cc, f32x4 a, f32x4 b) const {
    u32x2 o; o.x = pk2(siluf_(a.x) * b.x, siluf_(a.y) * b.y); o.y = pk2(siluf_(a.z) * b.z, siluf_(a.w) * b.w); *(u32x2*)(act + (size_t)r * DE + cc) = o; } };
struct EpiY { bf16* y; __device__ __forceinline__ void operator()(int r, int cc, f32x4 a, f32x4) const { u32x2 o; o.x = pk2(a.x, a.y); o.y = pk2(a.z, a.w); *(u32x2*)(y + (size_t)r * D + cc) = o; } };

__device__ __forceinline__ void phase_inproj(const Ctx& c, int l) {
    const RowPlain ra{(const bf16*)(c.a.ws + WS_XA), D}, rb{(const bf16*)(c.wl(l) + W_IN), D}; const EpiZ e{(bf16*)(c.a.ws + WS_Z)};
    constexpr int NTN = ZW / 64, NTM = T / 128;
    for (int u = c.bid; u < NTN * NTM; u += c.G) naive_gemm_tile(c, (u / NTN) * 128, (u % NTN) * 64, D, 0, ra, ra, rb, rb, e);
}
__device__ __forceinline__ void phase_br(const Ctx& c, int l) {
    const bf16* hc = (const bf16*)(c.a.ws + WS_HCAT); const bf16* w = (const bf16*)(c.wl(l) + W_BR);
    const RowPlain ra{hc, D}, ra1{hc + 512, D}, rb0{w, D}, rb1{w + 512, D}; const EpiBR e{(const bf16*)(c.a.ws + WS_Z), (bf16*)(c.a.ws + WS_XA)};
    constexpr int NTN = D / 64, NTM = T / 128;
    for (int u = c.bid; u < NTN * NTM; u += c.G) naive_gemm_tile(c, (u / NTN) * 128, (u % NTN) * 64, 512, 512, ra, ra1, rb0, rb1, e);
}
__device__ __forceinline__ void phase_out(const Ctx& c, int l) {
    const RowPlain ra{(const bf16*)(c.a.ws + WS_XA), D}, rb{(const bf16*)(c.wl(l) + W_OUT), D};
    const EpiOut e{l == 0 ? c.a.in[I_X] : c.a.out, c.a.out, c.mod(l) + 2048};
    constexpr int NTN = D / 64, NTM = T / 128;
    for (int u = c.bid; u < NTN * NTM; u += c.G) naive_gemm_tile(c, (u / NTN) * 128, (u % NTN) * 64, D, 0, ra, ra, rb, rb, e);
}

__device__ __forceinline__ void naive_mlstm(const Ctx& c, int l, int bh) {
    const int b = bh >> 2, h = bh & 3, d = c.tid >> 2, eq = c.tid & 3, e0 = eq * 16;
    const bf16* z = (const bf16*)(c.a.ws + WS_Z); const float* IFG = (const float*)(c.a.ws + WS_IFG); float* HR = (float*)(c.a.ws + WS_XA);
    const float* cw = c.a.in[I_CONVW] + (size_t)l * 4 * 512; const float* cb = c.a.in[I_CONVB] + l * 512;
    float C[16], n[16], m = 0.f;
#pragma unroll
    for (int i = 0; i < 16; ++i) { C[i] = 0.f; n[i] = 0.f; }
    LAS float* cwl = (LAS float*)c.lds;
    for (int i = c.tid; i < 640; i += NT) { if (i < 512) { const int j = i >> 7, ch = i & 127; cwl[i] = cw[j * 512 + (ch < 64 ? h * 64 + ch : 256 + h * 64 + ch - 64)]; } else { const int ch = i - 512; cwl[i] = cb[ch < 64 ? h * 64 + ch : 256 + h * 64 + ch - 64]; } }
    __syncthreads();
    for (int s = 0; s < SEQ; ++s) {
        const size_t t = (size_t)b * SEQ + s;
        float q[16], k[16];
#pragma unroll
        for (int i = 0; i < 16; ++i) { q[i] = cwl[512 + e0 + i]; k[i] = cwl[512 + 64 + e0 + i]; }
#pragma unroll
        for (int j = 0; j < 4; ++j) { const int sj = s - 3 + j; if (sj >= 0) { const bf16* zr = z + ((size_t)b * SEQ + sj) * ZW;
            const u32x4 q0 = *(const u32x4*)(zr + Z_QM + h * 64 + e0), q1 = *(const u32x4*)(zr + Z_QM + h * 64 + e0 + 8);
            const u32x4 k0 = *(const u32x4*)(zr + Z_KM + h * 64 + e0), k1 = *(const u32x4*)(zr + Z_KM + h * 64 + e0 + 8);
            const unsigned qa[8] = {q0.x, q0.y, q0.z, q0.w, q1.x, q1.y, q1.z, q1.w}, ka[8] = {k0.x, k0.y, k0.z, k0.w, k1.x, k1.y, k1.z, k1.w};
#pragma unroll
            for (int i = 0; i < 8; ++i) { q[2 * i] += cwl[j * 128 + e0 + 2 * i] * bflo(qa[i]); q[2 * i + 1] += cwl[j * 128 + e0 + 2 * i + 1] * bfhi(qa[i]); k[2 * i] += cwl[j * 128 + 64 + e0 + 2 * i] * bflo(ka[i]); k[2 * i + 1] += cwl[j * 128 + 64 + e0 + 2 * i + 1] * bfhi(ka[i]); } }
            asm volatile("" ::: "memory"); }
#pragma unroll
        for (int i = 0; i < 16; ++i) { q[i] = siluf_(q[i]) * 0.125f; k[i] = siluf_(k[i]); }
        const float v = bf2f(z[t * ZW + Z_VM + h * 128 + d]);
        const float ig = IFG[t * 8 + h], fp = IFG[t * 8 + 4 + h];
        const float logf = fminf(fp, 0.f) - log1pf(__expf(-fabsf(fp)));
        const float mn = fmaxf(logf + m, ig), dec = __expf(logf + m - mn), fr = __expf(ig - mn);
        float num = 0.f, den = 0.f;
#pragma unroll
        for (int i = 0; i < 16; ++i) { C[i] = dec * C[i] + fr * v * k[i]; n[i] = dec * n[i] + fr * k[i]; num += C[i] * q[i]; den += n[i] * q[i]; }
        num += __shfl_xor(num, 1); num += __shfl_xor(num, 2); den += __shfl_xor(den, 1); den += __shfl_xor(den, 2);
        m = mn;
        if (eq == 0) HR[t * 512 + h * 128 + d] = num / fmaxf(fabsf(den), __expf(-mn));
    }
}
__device__ __forceinline__ void naive_swa(const Ctx& c, int l, int first_blk) {
    const bf16* z = (const bf16*)(c.a.ws + WS_Z); bf16* hc = (bf16*)(c.a.ws + WS_HCAT);
    const float* relb = c.a.in[I_RELB]; const float* sinks = c.a.in[I_SINK] + l * AH;
    const int nblk = c.G - first_blk;
    for (int idx = (c.bid - first_blk) * NT + c.tid; idx < T * AH * 4; idx += nblk * NT) {
        const int part = idx & 3, hd = (idx >> 2) & 7, t = idx >> 5, kh = hd >> 2, s = t % SEQ, d0 = part * 16;
        float q[16], o[16];
        { const bf16* qp = z + (size_t)t * ZW + Z_QA + hd * 64 + d0;
#pragma unroll
          for (int i = 0; i < 2; ++i) { const u32x4 v = *(const u32x4*)(qp + 8 * i); q[8 * i] = bflo(v.x); q[8 * i + 1] = bfhi(v.x); q[8 * i + 2] = bflo(v.y); q[8 * i + 3] = bfhi(v.y); q[8 * i + 4] = bflo(v.z); q[8 * i + 5] = bfhi(v.z); q[8 * i + 6] = bflo(v.w); q[8 * i + 7] = bfhi(v.w); } }
#pragma unroll
        for (int i = 0; i < 16; ++i) o[i] = 0.f;
        float mx = sinks[hd], lsum = 1.f;
        const int j0 = s - 127 < 0 ? 0 : s - 127;
        for (int j = j0; j <= s; ++j) {
            const bf16* kp = z + (size_t)(t - s + j) * ZW + Z_KA + kh * 64 + d0; const bf16* vp = z + (size_t)(t - s + j) * ZW + Z_VA + kh * 64 + d0;
            float sc = 0.f;
#pragma unroll
            for (int i = 0; i < 2; ++i) { const u32x4 v = *(const u32x4*)(kp + 8 * i);
                sc += q[8 * i] * bflo(v.x) + q[8 * i + 1] * bfhi(v.x) + q[8 * i + 2] * bflo(v.y) + q[8 * i + 3] * bfhi(v.y) + q[8 * i + 4] * bflo(v.z) + q[8 * i + 5] * bfhi(v.z) + q[8 * i + 6] * bflo(v.w) + q[8 * i + 7] * bfhi(v.w); }
            sc += __shfl_xor(sc, 1); sc += __shfl_xor(sc, 2);
            sc = sc * 0.125f + relb[T5_BUCKET[s - j] * AH + hd];
            const float mn = fmaxf(mx, sc), corr = __expf(mx - mn), p = __expf(sc - mn);
            lsum = lsum * corr + p; mx = mn;
#pragma unroll
            for (int i = 0; i < 2; ++i) { const u32x4 v = *(const u32x4*)(vp + 8 * i);
                o[8 * i] = o[8 * i] * corr + p * bflo(v.x); o[8 * i + 1] = o[8 * i + 1] * corr + p * bfhi(v.x); o[8 * i + 2] = o[8 * i + 2] * corr + p * bflo(v.y); o[8 * i + 3] = o[8 * i + 3] * corr + p * bfhi(v.y);
                o[8 * i + 4] = o[8 * i + 4] * corr + p * bflo(v.z); o[8 * i + 5] = o[8 * i + 5] * corr + p * bfhi(v.z); o[8 * i + 6] = o[8 * i + 6] * corr + p * bflo(v.w); o[8 * i + 7] = o[8 * i + 7] * corr + p * bfhi(v.w); }
        }
        const float inv = 1.f / lsum; bf16* op = hc + (size_t)t * D + 512 + hd * 64 + d0;
#pragma unroll
        for (int i = 0; i < 2; ++i) { u32x4 w; w.x = pk2(o[8 * i] * inv, o[8 * i + 1] * inv); w.y = pk2(o[8 * i + 2] * inv, o[8 * i + 3] * inv); w.z = pk2(o[8 * i + 4] * inv, o[8 * i + 5] * inv); w.w = pk2(o[8 * i + 6] * inv, o[8 * i + 7] * inv); *(u32x4*)(op + 8 * i) = w; }
    }
}
__device__ __forceinline__ void phase_mix1(const Ctx& c, int l) {
    if (c.bid < 16) naive_mlstm(c, l, c.bid); else naive_swa(c, l, 16);
}
__device__ __forceinline__ void phase_mix2(const Ctx& c, int l) {
    const float* HR = (const float*)(c.a.ws + WS_XA); const bf16* z = (const bf16*)(c.a.ws + WS_Z); bf16* hc = (bf16*)(c.a.ws + WS_HCAT);
    const float* wm = c.a.in[I_WMN] + l * 512;
    const int gw = c.bid * NWAVES + c.wave, NGW = c.G * NWAVES;
    for (int it = gw; it < T * MH; it += NGW) { const int t = it >> 2, h = it & 3; const int col = h * 128 + 2 * c.lane;
        const float a0 = HR[(size_t)t * 512 + col], a1 = HR[(size_t)t * 512 + col + 1];
        const float rstd = rsqrtf(wave_sum(a0 * a0 + a1 * a1) * (1.f / 128.f) + EPS);
        const unsigned og = *(const unsigned*)(z + (size_t)t * ZW + Z_OM + col);
        *(unsigned*)(hc + (size_t)t * D + col) = pk2(a0 * rstd * wm[col] * sigmoidf_(bflo(og)), a1 * rstd * wm[col + 1] * sigmoidf_(bfhi(og))); }
}

__device__ __forceinline__ void phase_route(const Ctx& c, int l) {
    LAS float* wr = (LAS float*)c.lds;
    for (int i = c.tid; i < 16384; i += NT) { const int k = i >> 4, e = i & 15; wr[e * 1024 + k] = c.a.in[I_WR][i]; }
    __syncthreads();
    int* ROWTOK = (int*)(c.a.ws + WS_ROWTOK);
    for (int i = c.bid * NT + c.tid; i < MOE_ROWS; i += c.G * NT) ROWTOK[i] = 0;
    const float* wn = c.a.in[I_WN2] + l * D; const float* mod = c.mod(l); const float* rbias = c.a.in[I_RB];
    bf16* XN = (bf16*)(c.a.ws + WS_XA); int* RIDX = (int*)(c.a.ws + WS_RIDX); float* RW = (float*)(c.a.ws + WS_RW);
    unsigned* cnt = c.ctl() + CW_CNT + 64 * l;
    const int gw = c.bid * NWAVES + c.wave, NGW = c.G * NWAVES;
    for (int m = gw; m < T; m += NGW) {
        const int b = m / SEQ; const f32x4* xr = (const f32x4*)(c.a.out + (size_t)m * D) + c.lane;
        f32x4 v[4]; float s = 0.f;
#pragma unroll
        for (int j = 0; j < 4; ++j) { v[j] = xr[64 * j]; s += (v[j].x * v[j].x + v[j].y * v[j].y) + (v[j].z * v[j].z + v[j].w * v[j].w); }
        const float rstd = rsqrtf(wave_sum(s) * (1.f / D) + EPS);
        float lg[16];
#pragma unroll
        for (int e = 0; e < 16; ++e) lg[e] = 0.f;
        u32x2* o8 = (u32x2*)(XN + (size_t)m * D) + c.lane;
#pragma unroll
        for (int j = 0; j < 4; ++j) { const int col = 256 * j + 4 * c.lane;
            const f32x4 w = *(const f32x4*)(wn + col), sh = *(const f32x4*)(mod + b * 6144 + 3072 + col), sc = *(const f32x4*)(mod + b * 6144 + 4096 + col);
            v[j] = (v[j] * rstd * w) * (sc + 1.f) + sh;
            u32x2 o; o.x = pk2(v[j].x, v[j].y); o.y = pk2(v[j].z, v[j].w); o8[64 * j] = o; }
#pragma unroll
        for (int e = 0; e < 16; ++e) {
#pragma unroll
            for (int j = 0; j < 4; ++j) { const f32x4 ww = *(const LAS f32x4*)(wr + e * 1024 + 256 * j + 4 * c.lane); lg[e] += (v[j].x * ww.x + v[j].y * ww.y) + (v[j].z * ww.z + v[j].w * ww.w); }
            asm volatile("" ::: "memory"); }
#pragma unroll
        for (int e = 0; e < 16; ++e) lg[e] = wave_sum(lg[e]);
        float sc[16], sel[16];
#pragma unroll
        for (int e = 0; e < 16; ++e) { sc[e] = 1.f / (1.f + expf(-lg[e])); sel[e] = sc[e] + rbias[e]; }
        int bg = 0; float bgs = -INFINITY;
#pragma unroll
        for (int g = 0; g < 4; ++g) { float m1 = -INFINITY, m2 = -INFINITY;
#pragma unroll
            for (int i = 0; i < 4; ++i) { const float x = sel[4 * g + i]; if (x > m1) { m2 = m1; m1 = x; } else if (x > m2) m2 = x; }
            const float gs = m1 + m2; if (gs > bgs) { bgs = gs; bg = g; } }
        int i1 = -1, i2 = -1; float v1 = -INFINITY, v2 = -INFINITY;
#pragma unroll
        for (int e = 0; e < 16; ++e) { if ((e >> 2) == bg) { const float x = sel[e]; if (x > v1) { v2 = v1; i2 = i1; v1 = x; i1 = e; } else if (x > v2) { v2 = x; i2 = e; } } }
        float s1 = 0.f, s2 = 0.f;
#pragma unroll
        for (int e = 0; e < 16; ++e) { s1 = (e == i1) ? sc[e] : s1; s2 = (e == i2) ? sc[e] : s2; }
        if (c.lane == 0) { const float inv = 1.f / (s1 + s2); RIDX[2 * m] = i1; RIDX[2 * m + 1] = i2; RW[2 * m] = s1 * inv; RW[2 * m + 1] = s2 * inv;
            atomicAdd(cnt + i1, 1u); atomicAdd(cnt + i2, 1u); }
    }
}
__device__ __forceinline__ void phase_fill(const Ctx& c, int l) {
    LAS int* offs = (LAS int*)c.lds;
    const unsigned* cnt = c.ctl() + CW_CNT + 64 * l; unsigned* cur = c.ctl() + CW_CUR + 64 * l;
    if (c.tid == 0) { int o = 0; for (int e = 0; e < NE; ++e) { offs[e] = o; o += (int)((__hip_atomic_load(cnt + e, __ATOMIC_RELAXED, __HIP_MEMORY_SCOPE_AGENT) + 255u) & ~255u); } offs[NE] = o; }
    __syncthreads();
    const int* RIDX = (const int*)(c.a.ws + WS_RIDX); int* SLOT = (int*)(c.a.ws + WS_SLOT); int* ROWTOK = (int*)(c.a.ws + WS_ROWTOK);
    for (int i = c.bid * NT + c.tid; i < 2 * T; i += c.G * NT) { const int e = RIDX[i]; const int pos = (int)atomicAdd(cur + e, 1u); const int row = offs[e] + pos; ROWTOK[row] = i >> 1; SLOT[i] = row; }
    __syncthreads();
}
__device__ __forceinline__ void phase_g1(const Ctx& c, int l) {
    LAS int* offs = (LAS int*)(c.lds + 65536);
    const unsigned* cnt = c.ctl() + CW_CNT + 64 * l;
    if (c.tid == 0) { int o = 0; for (int e = 0; e < NE; ++e) { offs[e] = o; o += (int)((__hip_atomic_load(cnt + e, __ATOMIC_RELAXED, __HIP_MEMORY_SCOPE_AGENT) + 255u) & ~255u); } offs[NE] = o; }
    __syncthreads();
    const int R = offs[NE]; const int NTM = R / 128; constexpr int NTN = DE / 64;
    const RowGather ra{(const bf16*)(c.a.ws + WS_XA), D, (const int*)(c.a.ws + WS_ROWTOK)}; const EpiAct ep{(bf16*)(c.a.ws + WS_ACT)};
    for (int u = c.bid; u < NTM * NTN; u += c.G) { const int m0 = (u / NTN) * 128, n0 = (u % NTN) * 64; int e = 0; for (int i = 1; i < NE; ++i) if (m0 >= offs[i]) e = i;
        const bf16* w = (const bf16*)(c.wl(l) + W_GU) + (size_t)e * 1024 * D; const RowGU rb0{w, 0}, rb1{w, 1};
        naive_gemm_tile(c, m0, n0, D, D, ra, ra, rb0, rb1, ep); }
    __syncthreads();
}
__device__ __forceinline__ void phase_g2(const Ctx& c, int l) {
    LAS int* offs = (LAS int*)(c.lds + 65536);
    const unsigned* cnt = c.ctl() + CW_CNT + 64 * l;
    if (c.tid == 0) { int o = 0; for (int e = 0; e < NE; ++e) { offs[e] = o; o += (int)((__hip_atomic_load(cnt + e, __ATOMIC_RELAXED, __HIP_MEMORY_SCOPE_AGENT) + 255u) & ~255u); } offs[NE] = o; }
    __syncthreads();
    const int R = offs[NE]; const int NTM = R / 128; constexpr int NTN = D / 64;
    const RowPlain ra{(const bf16*)(c.a.ws + WS_ACT), DE}; const EpiY ep{(bf16*)(c.a.ws + WS_Y)};
    for (int u = c.bid; u < NTM * NTN; u += c.G) { const int m0 = (u / NTN) * 128, n0 = (u % NTN) * 64; int e = 0; for (int i = 1; i < NE; ++i) if (m0 >= offs[i]) e = i;
        const RowPlain rb{(const bf16*)(c.wl(l) + W_DN) + (size_t)e * D * DE, DE};
        naive_gemm_tile(c, m0, n0, DE, 0, ra, ra, rb, rb, ep); }
    __syncthreads();
}
__device__ __forceinline__ void phase_combine(const Ctx& c, int l) {
    const float* mod = c.mod(l); const bf16* Y = (const bf16*)(c.a.ws + WS_Y); const int* SLOT = (const int*)(c.a.ws + WS_SLOT); const float* RW = (const float*)(c.a.ws + WS_RW);
    const float* wf = c.a.in[I_WF];
    const int gw = c.bid * NWAVES + c.wave, NGW = c.G * NWAVES;
    for (int m = gw; m < T; m += NGW) {
        const int b = m / SEQ; f32x4* xr = (f32x4*)(c.a.out + (size_t)m * D) + c.lane;
        const int s0 = SLOT[2 * m], s1 = SLOT[2 * m + 1]; const float w0 = RW[2 * m], w1 = RW[2 * m + 1];
        const u32x2* y0 = (const u32x2*)(Y + (size_t)s0 * D) + c.lane; const u32x2* y1 = (const u32x2*)(Y + (size_t)s1 * D) + c.lane;
        f32x4 v[4]; float s = 0.f;
#pragma unroll
        for (int j = 0; j < 4; ++j) { const int col = 256 * j + 4 * c.lane; const f32x4 g = *(const f32x4*)(mod + b * 6144 + 5120 + col);
            const u32x2 a = y0[64 * j], bb = y1[64 * j];
            const f32x4 ya = {bflo(a.x), bfhi(a.x), bflo(a.y), bfhi(a.y)}, yb = {bflo(bb.x), bfhi(bb.x), bflo(bb.y), bfhi(bb.y)};
            v[j] = xr[64 * j] + g * (ya * w0 + yb * w1);
            s += (v[j].x * v[j].x + v[j].y * v[j].y) + (v[j].z * v[j].z + v[j].w * v[j].w); }
        if (l == DEPTH - 1) { const float rstd = rsqrtf(wave_sum(s) * (1.f / D) + EPS);
#pragma unroll
            for (int j = 0; j < 4; ++j) xr[64 * j] = v[j] * rstd * *(const f32x4*)(wf + 256 * j + 4 * c.lane); }
        else {
#pragma unroll
            for (int j = 0; j < 4; ++j) xr[64 * j] = v[j]; }
    }
}

namespace pg8 {
typedef short bf16x8 __attribute__((ext_vector_type(8)));
constexpr int BM = 256, BK = 64, HALF = 128, HTB = HALF * BK * 2, STAGE_BYTES = 8 * HTB, NXCD = 8, WGM = 8;
__host__ __device__ __forceinline__ int lds_byte(int r, int c) { const int st = (r >> 4) * 2 + (c >> 5), rr = r & 15, cc = c & 31, ob = rr * 64 + cc * 2; return st * 1024 + (ob ^ (((ob >> 9) & 1) << 5)); }
__host__ __device__ __forceinline__ void stage_rc(int b, int& R, int& C) { const int st = b / 1024, sb = b % 1024, swz = sb ^ (((sb >> 9) & 1) << 5); R = (st >> 1) * 16 + swz / 64; C = (st & 1) * 32 + (swz % 64) / 2; }
__host__ __device__ __forceinline__ int perm32(int rho) { const int n = rho >> 4, i = rho & 15; return 8 * (i >> 2) + 4 * n + (i & 3); }
struct Unit { int pm, pn; };
struct StaticOrder {
    int nM, nN, nwg, G, c;
    __device__ void init(int M, int N, int G_, int c_) { nM = M / BM; nN = N / BM; nwg = nM * nN; G = G_; c = c_; }
    __device__ bool next(int i, Unit& u) const {
        const long L = (long)i * G + c; if (L >= nwg) return false;
        int wgid = (int)L; { const int q = nwg / NXCD, r = nwg % NXCD, xcd = wgid % NXCD, off = wgid / NXCD; wgid = (xcd < r ? xcd * (q + 1) : r * (q + 1) + (xcd - r) * q) + off; }
        const int nig = WGM * nN, gid = wgid / nig, fm = gid * WGM, gsz = (nM - fm) < WGM ? (nM - fm) : WGM;
        u.pm = fm + ((wgid % nig) % gsz); u.pn = (wgid % nig) / gsz; return true;
    }
};
__device__ __forceinline__ unsigned cvt_pk_bf16(float lo, float hi) { unsigned r; asm volatile("v_cvt_pk_bf16_f32 %0, %1, %2" : "=v"(r) : "v"(lo), "v"(hi)); return r; }

template <class Epi, class Sched, class Prob, bool ALIGN_EPI, bool SP2>
__device__ __forceinline__ void gemm_phase(LAS unsigned char* lds, const Prob& P, const Sched& S, const Epi& E) {
    int tid_ = threadIdx.x; asm volatile("" : "+v"(tid_));
    const int tid = tid_, wid = __builtin_amdgcn_readfirstlane(tid >> 6), lane = tid & 63, wr = wid >> 2, wc = wid & 3, fr = lane & 15, fq = lane >> 4;
    const int K = P.K, nt = K / BK;
    unsigned voffA[2], voffB[2]; int RA[2], CA[2];
#pragma unroll
    for (int i = 0; i < 2; ++i) { int R, C; stage_rc(tid * 16 + i * 8192, R, C); const int Rb = Epi::PERM ? ((R & ~31) + perm32(R & 31)) : R;
        RA[i] = R; CA[i] = C; voffA[i] = (unsigned)(R * K + C) * 2u; voffB[i] = (unsigned)(Rb * K + C) * 2u; }
    const size_t kstep = (size_t)(BK * 2);
    const size_t hstep = (size_t)HALF * K * 2;
    const unsigned ldsw = (unsigned)wid * 1024u;
    const int aoff = lds_byte(wr * 64 + fr, fq * 8), boff = lds_byte(wc * 32 + fr, fq * 8);
    unsigned vac[2][2], van[2][2];
#define PG8_SA(b, h) (((b) * 2 + (h)) * HTB)
#define PG8_SB(b, h) ((4 + (b) * 2 + (h)) * HTB)
#define PG8_GLDS(src, dstoff) __builtin_amdgcn_global_load_lds((const unsigned*)(src), (LAS unsigned*)(lds + (dstoff)), 16, 0, 0)
#define PG8_STAGE(bufoff, gbase, voff) do { _Pragma("unroll") for (int _i = 0; _i < 2; ++_i) PG8_GLDS((const char*)(gbase) + (voff)[_i], (bufoff) + ldsw + _i * 8192); } while (0)
#define PG8_STAGEA(bufoff, gbase, h, VG) do { if constexpr (Prob::GATHER) { _Pragma("unroll") for (int _i = 0; _i < 2; ++_i) PG8_GLDS((const char*)(gbase) + (VG)[h][_i], (bufoff) + ldsw + _i * 8192); } \
        else { _Pragma("unroll") for (int _i = 0; _i < 2; ++_i) PG8_GLDS((const char*)(gbase) + (h) * hstep + voffA[_i], (bufoff) + ldsw + _i * 8192); } } while (0)
#define PG8_LDA(dst, b, h) do { _Pragma("unroll") for (int m = 0; m < 4; ++m) _Pragma("unroll") for (int k = 0; k < 2; ++k) dst[m][k] = *(const LAS bf16x8*)(lds + PG8_SA(b, h) + aoff + m * 2048 + k * 1024); } while (0)
#define PG8_LDB(dst, b, h) do { _Pragma("unroll") for (int n = 0; n < 2; ++n) _Pragma("unroll") for (int k = 0; k < 2; ++k) dst[n][k] = *(const LAS bf16x8*)(lds + PG8_SB(b, h) + boff + n * 2048 + k * 1024); } while (0)
#define PG8_MMA(ai, bj, At, Bt) do { __builtin_amdgcn_s_setprio(1); _Pragma("unroll") for (int m = 0; m < 4; ++m) _Pragma("unroll") for (int n = 0; n < 2; ++n) _Pragma("unroll") for (int k = 0; k < 2; ++k) \
        acc[ai][bj][m][n] = __builtin_amdgcn_mfma_f32_16x16x32_bf16(Bt[n][k], At[m][k], acc[ai][bj][m][n], 0, 0, 0); __builtin_amdgcn_s_setprio(0); } while (0)
#define PG8_WAIT_V(n) asm volatile("s_waitcnt vmcnt(" #n ")" ::: "memory")
#define PG8_WAIT_L(n) asm volatile("s_waitcnt lgkmcnt(" #n ")" ::: "memory")
#define PG8_BAR __builtin_amdgcn_s_barrier()
#define PG8_SCHED __builtin_amdgcn_sched_barrier(0)
    Unit cur, nxt; int ui = 0;
    if (!S.next(0, cur)) return;
    f32x4 acc[2][2][4][2];
#pragma unroll
    for (int a = 0; a < 2; ++a)
#pragma unroll
        for (int b = 0; b < 2; ++b)
#pragma unroll
            for (int m = 0; m < 4; ++m)
#pragma unroll
                for (int n = 0; n < 2; ++n) acc[a][b][m][n] = (f32x4){0.f, 0.f, 0.f, 0.f};
    bf16x8 At[4][2], B0[2][2], B1[2][2];
    const char* cA = P.a_tile(cur); const char* cB = P.b_tile(cur);
    if constexpr (Prob::GATHER) { P.a_voff(cur, RA, CA, vac); }
    if constexpr (SP2) {
        PG8_STAGE(PG8_SB(0, 0), cB, voffB); PG8_STAGE(PG8_SB(0, 1), cB + hstep, voffB); PG8_STAGEA(PG8_SA(0, 0), cA, 0, vac); PG8_STAGEA(PG8_SA(0, 1), cA, 1, vac);
        if (wr == 1) PG8_BAR;
        PG8_WAIT_V(2); PG8_BAR;
        PG8_STAGE(PG8_SB(1, 0), cB + kstep, voffB); PG8_STAGEA(PG8_SA(1, 0), cA + kstep, 0, vac); PG8_STAGE(PG8_SB(1, 1), cB + hstep + kstep, voffB);
        PG8_WAIT_V(6); PG8_BAR;
    } else {
        PG8_STAGE(PG8_SB(0, 0), cB, voffB); PG8_STAGEA(PG8_SA(0, 0), cA, 0, vac); PG8_STAGE(PG8_SB(0, 1), cB + hstep, voffB); PG8_STAGEA(PG8_SA(0, 1), cA, 1, vac);
        if (wr == 1) PG8_BAR;
        PG8_WAIT_V(4); PG8_BAR;
        PG8_STAGE(PG8_SB(1, 0), cB + kstep, voffB); PG8_STAGEA(PG8_SA(1, 0), cA + kstep, 0, vac); PG8_STAGE(PG8_SB(1, 1), cB + hstep + kstep, voffB);
        PG8_WAIT_V(6); PG8_BAR;
    }
    for (;;) {
        const bool has_next = S.next(ui + 1, nxt);
        const char* nA = has_next ? P.a_tile(nxt) : cA; const char* nB = has_next ? P.b_tile(nxt) : cB;
        if constexpr (Prob::GATHER) { if (has_next) P.a_voff(nxt, RA, CA, van); else {
#pragma unroll
            for (int h = 0; h < 2; ++h)
#pragma unroll
                for (int i = 0; i < 2; ++i) van[h][i] = vac[h][i]; } }
        for (int t = 0; t < nt; t += 2) {
            const bool last = (t == nt - 2);
            const char* a1 = cA + (size_t)(t + 1) * kstep;
            const char* a2 = last ? nA : cA + (size_t)(t + 2) * kstep; const char* b2 = last ? nB : cB + (size_t)(t + 2) * kstep;
            const char* a3 = a2 + kstep; const char* b3 = b2 + kstep;
            unsigned v2[2][2];
            if constexpr (Prob::GATHER) {
#pragma unroll
                for (int h = 0; h < 2; ++h)
#pragma unroll
                    for (int i = 0; i < 2; ++i) v2[h][i] = last ? van[h][i] : vac[h][i]; }
            if constexpr (SP2) {
            PG8_LDB(B0, 0, 0); PG8_LDB(B1, 0, 1); PG8_SCHED; PG8_LDA(At, 0, 0); PG8_STAGEA(PG8_SA(1, 1), a1, 1, vac);
            PG8_WAIT_V(8); PG8_WAIT_L(0); PG8_BAR; PG8_MMA(0, 0, At, B0); PG8_MMA(0, 1, At, B1); PG8_BAR; PG8_SCHED;
            PG8_LDA(At, 0, 1); PG8_STAGE(PG8_SB(0, 0), b2, voffB); PG8_STAGE(PG8_SB(0, 1), b2 + hstep, voffB); PG8_STAGEA(PG8_SA(0, 0), a2, 0, v2);
            PG8_WAIT_V(8); PG8_WAIT_L(0); PG8_BAR; PG8_MMA(1, 0, At, B0); PG8_MMA(1, 1, At, B1); PG8_BAR; PG8_SCHED;
            PG8_LDB(B0, 1, 0); PG8_LDB(B1, 1, 1); PG8_SCHED; PG8_LDA(At, 1, 0); PG8_STAGEA(PG8_SA(0, 1), a2, 1, v2);
            PG8_WAIT_V(8); PG8_WAIT_L(0); PG8_BAR; PG8_MMA(0, 0, At, B0); PG8_MMA(0, 1, At, B1); PG8_BAR; PG8_SCHED;
            PG8_LDA(At, 1, 1); PG8_STAGE(PG8_SB(1, 0), b3, voffB); PG8_STAGE(PG8_SB(1, 1), b3 + hstep, voffB); PG8_STAGEA(PG8_SA(1, 0), a3, 0, v2);
            PG8_WAIT_V(8); PG8_WAIT_L(0); PG8_BAR; PG8_MMA(1, 0, At, B0); PG8_MMA(1, 1, At, B1); PG8_BAR; PG8_SCHED;
            } else {
            PG8_LDB(B0, 0, 0); PG8_SCHED; PG8_LDA(At, 0, 0); PG8_STAGEA(PG8_SA(1, 1), a1, 1, vac);
            PG8_WAIT_L(8); PG8_BAR; PG8_WAIT_L(0); PG8_MMA(0, 0, At, B0); PG8_BAR; PG8_SCHED;
            PG8_LDB(B1, 0, 1); PG8_STAGE(PG8_SB(0, 0), b2, voffB);
            PG8_BAR; PG8_WAIT_L(0); PG8_MMA(0, 1, At, B1); PG8_BAR;
            PG8_LDA(At, 0, 1); PG8_STAGEA(PG8_SA(0, 0), a2, 0, v2);
            PG8_BAR; PG8_WAIT_L(0); PG8_MMA(1, 0, At, B0); PG8_BAR; PG8_SCHED;
            PG8_STAGE(PG8_SB(0, 1), b2 + hstep, voffB);
            PG8_WAIT_V(6); PG8_BAR; PG8_MMA(1, 1, At, B1); PG8_BAR;
            PG8_LDB(B0, 1, 0); PG8_SCHED; PG8_LDA(At, 1, 0); PG8_STAGEA(PG8_SA(0, 1), a2, 1, v2);
            PG8_WAIT_L(8); PG8_BAR; PG8_WAIT_L(0); PG8_MMA(0, 0, At, B0); PG8_BAR; PG8_SCHED;
            PG8_LDB(B1, 1, 1); PG8_STAGE(PG8_SB(1, 0), b3, voffB);
            PG8_BAR; PG8_WAIT_L(0); PG8_MMA(0, 1, At, B1); PG8_BAR;
            PG8_LDA(At, 1, 1); PG8_STAGEA(PG8_SA(1, 0), a3, 0, v2);
            PG8_BAR; PG8_WAIT_L(0); PG8_MMA(1, 0, At, B0); PG8_BAR; PG8_SCHED;
            PG8_STAGE(PG8_SB(1, 1), b3 + hstep, voffB);
            PG8_WAIT_V(6); PG8_BAR; PG8_MMA(1, 1, At, B1); PG8_BAR;
            }
            if constexpr (Epi::HAS_MID) { if (t == nt / 2 - 2) E.mid(acc, cur, wr, wc, fr, fq); }
        }
        if constexpr (ALIGN_EPI) { if (wr == 0) PG8_BAR; }
        E(acc, cur, wr, wc, fr, fq);
        if (!has_next) break;
#pragma unroll
        for (int a = 0; a < 2; ++a)
#pragma unroll
            for (int b = 0; b < 2; ++b)
#pragma unroll
                for (int m = 0; m < 4; ++m)
#pragma unroll
                    for (int n = 0; n < 2; ++n) acc[a][b][m][n] = (f32x4){0.f, 0.f, 0.f, 0.f};
        cur = nxt; cA = nA; cB = nB; ++ui;
        if constexpr (Prob::GATHER) {
#pragma unroll
            for (int h = 0; h < 2; ++h)
#pragma unroll
                for (int i = 0; i < 2; ++i) vac[h][i] = van[h][i]; }
        if constexpr (ALIGN_EPI) { if (wr == 1) PG8_BAR; }
    }
    PG8_WAIT_V(0);
    if constexpr (!ALIGN_EPI) { if (wr == 0) PG8_BAR; }
    PG8_BAR;
#undef PG8_SA
#undef PG8_SB
#undef PG8_GLDS
#undef PG8_STAGE
#undef PG8_STAGEA
#undef PG8_LDA
#undef PG8_LDB
#undef PG8_MMA
#undef PG8_WAIT_V
#undef PG8_WAIT_L
#undef PG8_BAR
#undef PG8_SCHED
}

struct ProbPlain { static constexpr bool GATHER = false; const bf16* A; const bf16* Bt; int K;
    __device__ __forceinline__ const char* a_tile(const Unit& u) const { return (const char*)A + (size_t)u.pm * BM * K * 2; }
    __device__ __forceinline__ const char* b_tile(const Unit& u) const { return (const char*)Bt + (size_t)u.pn * BM * K * 2; }
    __device__ __forceinline__ void a_voff(const Unit&, const int (&)[2], const int (&)[2], unsigned (&)[2][2]) const {} };
__device__ __forceinline__ int moe_expert(const LAS int* offs, int row) { int e = 0;
#pragma unroll
    for (int i = 1; i < NE; ++i) e = (row >= offs[i]) ? i : e;
    return e; }
struct ProbMoeGather { static constexpr bool GATHER = true; const bf16* A; const bf16* Bt; int K; const int* rowtok; const LAS int* offs; size_t estride;
    __device__ __forceinline__ const char* a_tile(const Unit&) const { return (const char*)A; }
    __device__ __forceinline__ const char* b_tile(const Unit& u) const { const int e = __builtin_amdgcn_readfirstlane(moe_expert(offs, u.pm * BM)); return (const char*)(Bt + (size_t)e * estride) + (size_t)u.pn * BM * K * 2; }
    __device__ __forceinline__ void a_voff(const Unit& u, const int (&R)[2], const int (&C)[2], unsigned (&v)[2][2]) const {
#pragma unroll
        for (int h = 0; h < 2; ++h)
#pragma unroll
            for (int i = 0; i < 2; ++i) { const int tok = rowtok[u.pm * BM + h * HALF + R[i]]; v[h][i] = (unsigned)(tok * K + C[i]) * 2u; }
#pragma unroll
        for (int h = 0; h < 2; ++h)
#pragma unroll
            for (int i = 0; i < 2; ++i) asm volatile("" : "+v"(v[h][i]));
    } };
struct ProbMoePlain { static constexpr bool GATHER = false; const bf16* A; const bf16* Bt; int K; const LAS int* offs; size_t estride;
    __device__ __forceinline__ const char* a_tile(const Unit& u) const { return (const char*)A + (size_t)u.pm * BM * K * 2; }
    __device__ __forceinline__ const char* b_tile(const Unit& u) const { const int e = __builtin_amdgcn_readfirstlane(moe_expert(offs, u.pm * BM)); return (const char*)(Bt + (size_t)e * estride) + (size_t)u.pn * BM * K * 2; }
    __device__ __forceinline__ void a_voff(const Unit&, const int (&)[2], const int (&)[2], unsigned (&)[2][2]) const {} };

struct EpiStoreBf16 {
    static constexpr bool PERM = true, HAS_MID = false; bf16* O; int ldc;
    __device__ __forceinline__ void operator()(const f32x4 (&acc)[2][2][4][2], const Unit& u, int wr, int wc, int fr, int fq) const {
        int row0 = u.pm * BM + wr * 64 + fr, col0 = u.pn * BM + wc * 32 + 8 * fq; asm volatile("" : "+v"(row0), "+v"(col0));
#pragma unroll
        for (int ai = 0; ai < 2; ++ai)
#pragma unroll
            for (int m = 0; m < 4; ++m) { bf16* rowp = O + (size_t)(row0 + ai * HALF + m * 16) * ldc + col0;
#pragma unroll
                for (int bj = 0; bj < 2; ++bj) { const f32x4 v0 = acc[ai][bj][m][0], v1 = acc[ai][bj][m][1];
                    u32x4 w; w.x = cvt_pk_bf16(v0[0], v0[1]); w.y = cvt_pk_bf16(v0[2], v0[3]); w.z = cvt_pk_bf16(v1[0], v1[1]); w.w = cvt_pk_bf16(v1[2], v1[3]);
                    *(u32x4*)(rowp + bj * HALF) = w; } }
    }
};
__device__ __forceinline__ void unpack8(const u32x4 w, float (&f)[8]) { f[0] = bflo(w.x); f[1] = bfhi(w.x); f[2] = bflo(w.y); f[3] = bfhi(w.y); f[4] = bflo(w.z); f[5] = bfhi(w.z); f[6] = bflo(w.w); f[7] = bfhi(w.w); }
struct EpiMerge {
    static constexpr bool PERM = true, HAS_MID = true; const bf16* z; bf16* O;
    __device__ __forceinline__ void mid(f32x4 (&acc)[2][2][4][2], const Unit& u, int wr, int wc, int fr, int fq) const {
        int row0 = u.pm * BM + wr * 64 + fr, col0 = u.pn * BM + wc * 32 + 8 * fq; asm volatile("" : "+v"(row0), "+v"(col0));
        const bf16* zr0 = z + (size_t)row0 * ZW + col0;
#pragma unroll
        for (int ai = 0; ai < 2; ++ai)
#pragma unroll
            for (int m = 0; m < 4; ++m)
#pragma unroll
                for (int bj = 0; bj < 2; ++bj) { const bf16* zr = zr0 + (size_t)(ai * HALF + m * 16) * ZW + bj * HALF;
                    const u32x4 gmw = *(const u32x4*)(zr + Z_GM), gaw = *(const u32x4*)(zr + Z_GA);
                    f32x4 r0, r1;
                    r0[0] = (1.f + __expf(-bflo(gaw.x))) * __builtin_amdgcn_rcpf(1.f + __expf(-bflo(gmw.x))); r0[1] = (1.f + __expf(-bfhi(gaw.x))) * __builtin_amdgcn_rcpf(1.f + __expf(-bfhi(gmw.x)));
                    r0[2] = (1.f + __expf(-bflo(gaw.y))) * __builtin_amdgcn_rcpf(1.f + __expf(-bflo(gmw.y))); r0[3] = (1.f + __expf(-bfhi(gaw.y))) * __builtin_amdgcn_rcpf(1.f + __expf(-bfhi(gmw.y)));
                    r1[0] = (1.f + __expf(-bflo(gaw.z))) * __builtin_amdgcn_rcpf(1.f + __expf(-bflo(gmw.z))); r1[1] = (1.f + __expf(-bfhi(gaw.z))) * __builtin_amdgcn_rcpf(1.f + __expf(-bfhi(gmw.z)));
                    r1[2] = (1.f + __expf(-bflo(gaw.w))) * __builtin_amdgcn_rcpf(1.f + __expf(-bflo(gmw.w))); r1[3] = (1.f + __expf(-bfhi(gaw.w))) * __builtin_amdgcn_rcpf(1.f + __expf(-bfhi(gmw.w)));
                    acc[ai][bj][m][0] *= r0; acc[ai][bj][m][1] *= r1;
                    asm volatile("" ::: "memory"); }
    }
    __device__ __forceinline__ void operator()(const f32x4 (&acc)[2][2][4][2], const Unit& u, int wr, int wc, int fr, int fq) const {
        int row0 = u.pm * BM + wr * 64 + fr, col0 = u.pn * BM + wc * 32 + 8 * fq; asm volatile("" : "+v"(row0), "+v"(col0));
#pragma unroll
        for (int ai = 0; ai < 2; ++ai)
#pragma unroll
            for (int m = 0; m < 4; ++m) { const size_t row = (size_t)(row0 + ai * HALF + m * 16); const bf16* zr = z + row * ZW + col0; bf16* rowp = O + row * D + col0;
#pragma unroll
                for (int bj = 0; bj < 2; ++bj) { float ga[8]; unpack8(*(const u32x4*)(zr + Z_GA + bj * HALF), ga);
                    float s[8];
#pragma unroll
                    for (int i = 0; i < 8; ++i) s[i] = __builtin_amdgcn_rcpf(1.f + __expf(-ga[i]));
                    const f32x4 v0 = acc[ai][bj][m][0] * (f32x4){s[0], s[1], s[2], s[3]}, v1 = acc[ai][bj][m][1] * (f32x4){s[4], s[5], s[6], s[7]};
                    u32x4 w; w.x = cvt_pk_bf16(v0[0], v0[1]); w.y = cvt_pk_bf16(v0[2], v0[3]); w.z = cvt_pk_bf16(v1[0], v1[1]); w.w = cvt_pk_bf16(v1[2], v1[3]);
                    *(u32x4*)(rowp + bj * HALF) = w; }
                asm volatile("" ::: "memory"); }
    }
};
struct EpiResidual {
    static constexpr bool PERM = false, HAS_MID = false; const float* xin; float* xout; const float* gmod;
    __device__ __forceinline__ void operator()(const f32x4 (&acc)[2][2][4][2], const Unit& u, int wr, int wc, int fr, int fq) const {
        int row0 = u.pm * BM + wr * 64 + fr, col0 = u.pn * BM + wc * 32 + 4 * fq; asm volatile("" : "+v"(row0), "+v"(col0)); const int b = (u.pm * BM) / SEQ;
        f32x4 gv[2][2];
#pragma unroll
        for (int bj = 0; bj < 2; ++bj)
#pragma unroll
            for (int n = 0; n < 2; ++n) gv[bj][n] = *(const f32x4*)(gmod + b * 6144 + col0 + bj * HALF + n * 16);
#pragma unroll
        for (int ai = 0; ai < 2; ++ai)
#pragma unroll
            for (int m = 0; m < 4; ++m) { const size_t off = (size_t)(row0 + ai * HALF + m * 16) * D + col0;
#pragma unroll
                for (int bj = 0; bj < 2; ++bj)
#pragma unroll
                    for (int n = 0; n < 2; ++n) { const f32x4 xo = *(const f32x4*)(xin + off + bj * HALF + n * 16); *(f32x4*)(xout + off + bj * HALF + n * 16) = xo + gv[bj][n] * acc[ai][bj][m][n]; }
                if (m & 1) asm volatile("" ::: "memory"); }
    }
};
struct EpiAct {
    static constexpr bool PERM = true, HAS_MID = false; bf16* O;
    __device__ __forceinline__ void operator()(const f32x4 (&acc)[2][2][4][2], const Unit& u, int wr, int wc, int fr, int fq) const {
        int row0 = u.pm * BM + wr * 64 + fr, col0 = u.pn * HALF + wc * 32 + 8 * fq; asm volatile("" : "+v"(row0), "+v"(col0));
#pragma unroll
        for (int ai = 0; ai < 2; ++ai)
#pragma unroll
            for (int m = 0; m < 4; ++m) { bf16* rowp = O + (size_t)(row0 + ai * HALF + m * 16) * DE + col0; float a[8];
#pragma unroll
                for (int n = 0; n < 2; ++n)
#pragma unroll
                    for (int i = 0; i < 4; ++i) { const float g = acc[ai][0][m][n][i], up = acc[ai][1][m][n][i]; a[4 * n + i] = g * __builtin_amdgcn_rcpf(1.f + __expf(-g)) * up; }
                u32x4 w; w.x = cvt_pk_bf16(a[0], a[1]); w.y = cvt_pk_bf16(a[2], a[3]); w.z = cvt_pk_bf16(a[4], a[5]); w.w = cvt_pk_bf16(a[6], a[7]);
                *(u32x4*)rowp = w; }
    }
};
}

#ifndef OPT_GEMM
#define OPT_GEMM 1
#endif
constexpr int OFFS_LDS = 131072;
__device__ __forceinline__ void moe_offsets_lds(const Ctx& c, int l) {
    LAS int* offs = (LAS int*)(c.lds + OFFS_LDS);
    const unsigned* cnt = c.ctl() + CW_CNT + 64 * l;
    if (c.tid == 0) { int o = 0; for (int e = 0; e < NE; ++e) { offs[e] = o; o += (int)((__hip_atomic_load(cnt + e, __ATOMIC_RELAXED, __HIP_MEMORY_SCOPE_AGENT) + 255u) & ~255u); } offs[NE] = o; }
    __syncthreads();
}
__device__ __forceinline__ void phase_inproj_opt(const Ctx& c, int l) {
    const pg8::ProbPlain P{(const bf16*)(c.a.ws + WS_XA), (const bf16*)(c.wl(l) + W_IN), D}; pg8::StaticOrder S; S.init(T, ZW, c.G, c.bid);
    const pg8::EpiStoreBf16 E{(bf16*)(c.a.ws + WS_Z), ZW};
    pg8::gemm_phase<pg8::EpiStoreBf16, pg8::StaticOrder, pg8::ProbPlain, true, true>(c.lds, P, S, E);
}
__device__ __forceinline__ void phase_br_opt(const Ctx& c, int l) {
    const pg8::ProbPlain P{(const bf16*)(c.a.ws + WS_HCAT), (const bf16*)(c.wl(l) + W_BR), D}; pg8::StaticOrder S; S.init(T, D, c.G, c.bid);
    const pg8::EpiMerge E{(const bf16*)(c.a.ws + WS_Z), (bf16*)(c.a.ws + WS_XA)};
    pg8::gemm_phase<pg8::EpiMerge, pg8::StaticOrder, pg8::ProbPlain, true, true>(c.lds, P, S, E);
}
__device__ __forceinline__ void phase_out_opt(const Ctx& c, int l) {
    const pg8::ProbPlain P{(const bf16*)(c.a.ws + WS_XA), (const bf16*)(c.wl(l) + W_OUT), D}; pg8::StaticOrder S; S.init(T, D, c.G, c.bid);
    const pg8::EpiResidual E{l == 0 ? c.a.in[I_X] : c.a.out, c.a.out, c.mod(l) + 2048};
    pg8::gemm_phase<pg8::EpiResidual, pg8::StaticOrder, pg8::ProbPlain, true, true>(c.lds, P, S, E);
}
__device__ __forceinline__ void phase_g1_opt(const Ctx& c, int l) {
    moe_offsets_lds(c, l); const LAS int* offs = (const LAS int*)(c.lds + OFFS_LDS); const int R = offs[NE];
    const pg8::ProbMoeGather P{(const bf16*)(c.a.ws + WS_XA), (const bf16*)(c.wl(l) + W_GU), D, (const int*)(c.a.ws + WS_ROWTOK), offs, (size_t)1024 * D};
    pg8::StaticOrder S; S.init(R, 1024, c.G, c.bid);
    const pg8::EpiAct E{(bf16*)(c.a.ws + WS_ACT)};
    pg8::gemm_phase<pg8::EpiAct, pg8::StaticOrder, pg8::ProbMoeGather, true, true>(c.lds, P, S, E);
}
__device__ __forceinline__ void phase_g2_opt(const Ctx& c, int l) {
    moe_offsets_lds(c, l); const LAS int* offs = (const LAS int*)(c.lds + OFFS_LDS); const int R = offs[NE];
    const pg8::ProbMoePlain P{(const bf16*)(c.a.ws + WS_ACT), (const bf16*)(c.wl(l) + W_DN), DE, offs, (size_t)D * DE};
    pg8::StaticOrder S; S.init(R, D, c.G, c.bid);
    const pg8::EpiStoreBf16 E{(bf16*)(c.a.ws + WS_Y), D};
    pg8::gemm_phase<pg8::EpiStoreBf16, pg8::StaticOrder, pg8::ProbMoePlain, true, true>(c.lds, P, S, E);
}

#define XB_TMO      128
#define XB_XCNT(j)  (256  + 64 * (j))
#define XB_XSUB(j)  (1280 + 64 * (j))
#define XB_XGEN(j)  (2304 + 64 * (j))
#define XB_TOP      3328
#define XB_TOPGEN   3392
#define XCD_BAR_WORDS 3456
#define XB_SPIN_CAP (1u << 22)
constexpr int CW_BAR = 8192;
__device__ __forceinline__ unsigned xb_ld(unsigned* p)              { return __hip_atomic_load(p, __ATOMIC_RELAXED, __HIP_MEMORY_SCOPE_AGENT); }
__device__ __forceinline__ unsigned xb_add(unsigned* p, unsigned v) { return __hip_atomic_fetch_add(p, v, __ATOMIC_RELAXED, __HIP_MEMORY_SCOPE_AGENT); }
__device__ __forceinline__ unsigned xb_xcc_id() { return (unsigned)__builtin_amdgcn_s_getreg((3 << 11) | 20) & 0xFu; }
#define XB_SPIN(cond, bar) do { unsigned _sp = 0; while (cond) { __builtin_amdgcn_s_sleep(1); \
    if ((++_sp & 255u) == 0u) { if (xb_ld(&(bar)[XB_TMO])) break; if (_sp > XB_SPIN_CAP) { atomicAdd(&(bar)[XB_TMO], 1u); break; } } } } while (0)
struct XcdBarrier { unsigned* bar; unsigned x; volatile LAS unsigned* st; };
__device__ __forceinline__ XcdBarrier xcd_barrier_post(unsigned* bar, volatile LAS unsigned* st) {
    XcdBarrier b; b.bar = bar; b.x = xb_xcc_id(); b.st = st;
    if (threadIdx.x == 0) { (void)xb_add(&bar[XB_XCNT(b.x)], 1u); st[2] = b.x; }
    return b;
}
__device__ __forceinline__ void xcd_barrier_complete(unsigned* bar, unsigned x, unsigned& nloc, unsigned& nx) {
    const unsigned G = gridDim.x * gridDim.y * gridDim.z;
    unsigned sum, cnt, mine, sp = 0u;
    for (;;) {
        sum = 0u; cnt = 0u; mine = 0u;
#pragma unroll
        for (unsigned j = 0; j < 16; ++j) { const unsigned c = xb_ld(&bar[XB_XCNT(j)]); sum += c; cnt += (c > 0u) ? 1u : 0u; mine = (j == x) ? c : mine; }
        if (sum == G) break;
        __builtin_amdgcn_s_sleep(1);
        if ((++sp & 255u) == 0u) { if (xb_ld(&bar[XB_TMO])) break; if (sp > XB_SPIN_CAP) { atomicAdd(&bar[XB_TMO], 1u); break; } }
    }
    nloc = mine > 0u ? mine : 1u; nx = cnt > 0u ? cnt : 1u;
}
__device__ __forceinline__ void xcd_barrier(const XcdBarrier& b) {
    asm volatile("s_waitcnt vmcnt(0)" ::: "memory");
    __syncthreads();
    if (threadIdx.x == 0) {
        unsigned* bar = b.bar;
        __builtin_amdgcn_s_waitcnt(0);
        unsigned nloc = b.st[0], nx = b.st[1]; const unsigned bx = b.st[2];
        if (nloc == 0u) { xcd_barrier_complete(bar, bx, nloc, nx); b.st[0] = nloc; b.st[1] = nx; }
        const unsigned old = xb_add(&bar[XB_XSUB(bx)], 1u);
        const unsigned gen = old / nloc;
        if (old + 1u == (gen + 1u) * nloc) {
            __builtin_amdgcn_fence(__ATOMIC_RELEASE, "agent");
            asm volatile("s_waitcnt vmcnt(0)" ::: "memory");
            const unsigned og = xb_add(&bar[XB_TOP], 1u);
            const unsigned tg = og / nx;
            if (og + 1u == (tg + 1u) * nx) xb_add(&bar[XB_TOPGEN], 1u);
            else XB_SPIN(xb_ld(&bar[XB_TOPGEN]) == tg, bar);
            __builtin_amdgcn_fence(__ATOMIC_ACQUIRE, "agent");
            xb_add(&bar[XB_XGEN(bx)], 1u);
            asm volatile("s_waitcnt vmcnt(0)" ::: "memory");
        } else {
            XB_SPIN(xb_ld(&bar[XB_XGEN(bx)]) == gen, bar);
            __builtin_amdgcn_fence(__ATOMIC_ACQUIRE, "agent");
            asm volatile("s_waitcnt vmcnt(0)" ::: "memory");
        }
    }
    __syncthreads();
}

constexpr int MISC_OFF = 143360 + 320;
#ifndef MK_MULTI
#define MK_MULTI 0
#endif
constexpr int PH_PER_LAYER = 11, NPHASES = 1 + DEPTH * PH_PER_LAYER;
__device__ __forceinline__ void run_phase(const Ctx& c, int l, int p) {
    switch (p) {
        case 0: phase_xn(c, l); break;
        case 1: phase_inproj(c, l); break;
        case 2: phase_mix1(c, l); break;
        case 3: phase_mix2(c, l); break;
        case 4: phase_br(c, l); break;
        case 5: phase_out(c, l); break;
        case 6: phase_route(c, l); break;
        case 7: phase_fill(c, l); break;
        case 8: phase_g1(c, l); break;
        case 9: phase_g2(c, l); break;
        case 10: phase_combine(c, l); break;
    }
}
__global__ void __launch_bounds__(NT, 2) mega(Args a) {
    extern __shared__ __attribute__((aligned(16))) unsigned char lds_raw[];
    Ctx c; c.a = a; c.lds = (LAS unsigned char*)lds_raw; c.tid = threadIdx.x; c.lane = c.tid & 63; c.wave = __builtin_amdgcn_readfirstlane(c.tid >> 6); c.G = gridDim.x; c.bid = blockIdx.x;
#if MK_MULTI
    { const int ph = a.ph_lo; if (ph == 0) { phase_prologue(c); return; } run_phase(c, (ph - 1) / PH_PER_LAYER, (ph - 1) % PH_PER_LAYER); }
#else
    volatile LAS unsigned* MISC = (volatile LAS unsigned*)(c.lds + MISC_OFF);
    if (c.tid < 32) MISC[c.tid] = 0u;
    __syncthreads();
    const XcdBarrier bar = xcd_barrier_post(c.ctl() + CW_BAR, MISC + 8);
#define PH(call) do { Ctx f = c; asm volatile("" : "+v"(f.tid)); f.lane = f.tid & 63; f.wave = __builtin_amdgcn_readfirstlane(f.tid >> 6); { const Ctx& c = f; call; } } while (0)
    PH(phase_prologue(c)); xcd_barrier(bar);
#pragma unroll 1
    for (int l = 0; l < DEPTH; ++l) {
        PH(phase_xn(c, l)); xcd_barrier(bar);
        if (OPT_GEMM) PH(phase_inproj_opt(c, l)); else PH(phase_inproj(c, l)); xcd_barrier(bar);
        PH(phase_mix1(c, l)); xcd_barrier(bar);
        PH(phase_mix2(c, l)); xcd_barrier(bar);
        if (OPT_GEMM) PH(phase_br_opt(c, l)); else PH(phase_br(c, l)); xcd_barrier(bar);
        if (OPT_GEMM) PH(phase_out_opt(c, l)); else PH(phase_out(c, l)); xcd_barrier(bar);
        PH(phase_route(c, l)); xcd_barrier(bar);
        PH(phase_fill(c, l)); xcd_barrier(bar);
        if (OPT_GEMM) PH(phase_g1_opt(c, l)); else PH(phase_g1(c, l)); xcd_barrier(bar);
        if (OPT_GEMM) PH(phase_g2_opt(c, l)); else PH(phase_g2(c, l)); xcd_barrier(bar);
        PH(phase_combine(c, l)); if (l + 1 < DEPTH) xcd_barrier(bar);
    }
#undef PH
#endif
}

extern "C" void kernel_launch(void* const* d_in, const int* in_sizes, int n_in, void* d_out, int out_size, void* d_ws, size_t ws_size, hipStream_t stream) {
    static int grid = 0;
    if (grid == 0) {
        if (n_in != 23 || out_size != T * D || ws_size < WS_END) { fprintf(stderr, "kernel_launch: unexpected shapes (n_in %d out %d ws %zu need %zu)\n", n_in, out_size, ws_size, (size_t)WS_END); grid = -1; return; }
        int dev = 0, cus = 0, per_cu = 0;
        if (hipGetDevice(&dev) != hipSuccess || hipDeviceGetAttribute(&cus, hipDeviceAttributeMultiprocessorCount, dev) != hipSuccess) { grid = -1; return; }
        if (hipFuncSetAttribute((const void*)mega, hipFuncAttributeMaxDynamicSharedMemorySize, LDS_BYTES) != hipSuccess) { grid = -1; return; }
        if (hipOccupancyMaxActiveBlocksPerMultiprocessor(&per_cu, (const void*)mega, NT, LDS_BYTES) != hipSuccess || per_cu < 1) { fprintf(stderr, "kernel_launch: occupancy query says %d blocks per CU\n", per_cu); (void)hipGetLastError(); grid = -1; return; }
        grid = cus;
    }
    if (grid < 0) return;
    (void)hipMemsetAsync((char*)d_ws + WS_CTL, 0, CTL_BYTES, stream);
    Args a{};
    for (int i = 0; i < 23; ++i) a.in[i] = (const float*)d_in[i];
    a.out = (float*)d_out; a.ws = (unsigned char*)d_ws;
#if MK_MULTI
    for (int ph = 0; ph < NPHASES; ++ph) { a.ph_lo = ph; a.ph_hi = ph + 1; hipLaunchKernelGGL(mega, dim3(grid), dim3(NT), LDS_BYTES, stream, a); }
#else
    a.ph_lo = 0; a.ph_hi = NPHASES;
    hipLaunchKernelGGL(mega, dim3(grid), dim3(NT), LDS_BYTES, stream, a);
#endif
}
```

```cpp
#include <hip/hip_runtime.h>
#include <cstdio>
#include <cstdint>

constexpr int NB = 4, SEQ = 4096, T = NB * SEQ, D = 1024, DEPTH = 2;
constexpr int MH = 4, DQK = 64, DV = 128;
constexpr int AH = 8, AKV = 2, AD = 64;
constexpr int NE = 16, DE = 512;
constexpr int D_IN = 4360, ZW = 4352;
constexpr int Z_QM = 0, Z_KM = 256, Z_VM = 512, Z_OM = 1024, Z_QA = 1536, Z_KA = 2048, Z_VA = 2176, Z_GM = 2304, Z_GA = 3328;
constexpr float EPS = 1e-6f;
constexpr int MOE_ROWS = 2 * T + NE * 256;

constexpr size_t MiB = 1u << 20;
constexpr size_t WS_CTL = 0, CTL_BYTES = 1 * MiB;
constexpr size_t WS_MOD = 1 * MiB;
constexpr size_t WS_IFG = WS_MOD + 256 * 1024;
constexpr size_t WS_RIDX = WS_IFG + 512 * 1024;
constexpr size_t WS_RW = WS_RIDX + 128 * 1024;
constexpr size_t WS_SLOT = WS_RW + 128 * 1024;
constexpr size_t WS_ROWTOK = WS_SLOT + 128 * 1024;
constexpr size_t WS_SMALL_END = WS_ROWTOK + 256 * 1024;
static_assert(WS_SMALL_END <= 4 * MiB, "small region");
constexpr size_t WS_W = 4 * MiB;
constexpr size_t W_IN = 0;
constexpr size_t W_BR = W_IN + (size_t)ZW * D * 2;
constexpr size_t W_OUT = W_BR + (size_t)D * D * 2;
constexpr size_t W_GU = W_OUT + (size_t)D * D * 2;
constexpr size_t W_DN = W_GU + (size_t)NE * 1024 * D * 2;
constexpr size_t LAYER_W = W_DN + (size_t)NE * D * DE * 2;
constexpr size_t WS_Z = WS_W + 2 * LAYER_W;
constexpr size_t WS_ACT = WS_Z;
constexpr size_t WS_Y = WS_ACT + (size_t)MOE_ROWS * DE * 2;
constexpr size_t WS_XA = WS_Z + (size_t)T * ZW * 2;
constexpr size_t WS_HCAT = WS_XA + (size_t)T * D * 2;
constexpr size_t WS_END = WS_HCAT + (size_t)T * D * 2;
static_assert(WS_Y + (size_t)MOE_ROWS * D * 2 <= WS_XA, "MoE overlay fits in z");
constexpr int CW_CNT = 1024;
constexpr int CW_CUR = 2048;

typedef unsigned short bf16;
typedef float f32x4 __attribute__((ext_vector_type(4)));
typedef unsigned u32x4 __attribute__((ext_vector_type(4)));
typedef unsigned u32x2 __attribute__((ext_vector_type(2)));
#define LAS __attribute__((address_space(3)))

__device__ __forceinline__ unsigned f2bf(float f) { unsigned u = __builtin_bit_cast(unsigned, f); return (u + 0x7fffu + ((u >> 16) & 1u)) >> 16; }
__device__ __forceinline__ unsigned pk2(float lo, float hi) { return f2bf(lo) | (f2bf(hi) << 16); }
__device__ __forceinline__ float bf2f(unsigned b) { return __builtin_bit_cast(float, b << 16); }
__device__ __forceinline__ float bflo(unsigned w) { return __builtin_bit_cast(float, w << 16); }
__device__ __forceinline__ float bfhi(unsigned w) { return __builtin_bit_cast(float, w & 0xffff0000u); }
__device__ __forceinline__ float sigmoidf_(float x) { return 1.f / (1.f + __expf(-x)); }
__device__ __forceinline__ float siluf_(float x) { return x / (1.f + __expf(-x)); }
__device__ __forceinline__ float wave_sum(float v) {
#pragma unroll
    for (int o = 1; o < 64; o <<= 1) v += __shfl_xor(v, o);
    return v;
}

__device__ const unsigned char T5_BUCKET[128] = {0,1,2,3,4,5,6,7,8,9,10,11,12,13,14,15,16,16,16,17,17,18,18,18,19,19,19,20,20,20,20,21,21,21,21,22,22,22,22,22,23,23,23,23,23,23,24,24,24,24,24,24,25,25,25,25,25,25,25,26,26,26,26,26,26,26,26,27,27,27,27,27,27,27,27,27,27,28,28,28,28,28,28,28,28,28,28,29,29,29,29,29,29,29,29,29,29,29,29,30,30,30,30,30,30,30,30,30,30,30,30,30,30,31,31,31,31,31,31,31,31,31,31,31,31,31,31,31};

struct Args {
    const float* in[23];
    float* out; unsigned char* ws;
    int ph_lo, ph_hi;
};
enum { I_X = 0, I_C, I_WADA, I_BADA, I_WN1, I_WIN, I_CONVW, I_CONVB, I_BIG, I_BFG, I_WMN, I_SINK, I_RELB, I_WBRM, I_WBRA, I_WOUT, I_WN2, I_WR, I_RB, I_WG, I_WU, I_WD, I_WF };

constexpr int NT = 512, NWAVES = 8;
constexpr int LDS_BYTES = 147456;

struct Ctx {
    Args a; LAS unsigned char* lds; int tid, lane, wave, G, bid;
    __device__ __forceinline__ unsigned* ctl() const { return (unsigned*)(a.ws + WS_CTL); }
    __device__ __forceinline__ float* mod(int l) const { return (float*)(a.ws + WS_MOD) + (size_t)l * 4 * 6144; }
    __device__ __forceinline__ unsigned char* wl(int l) const { return a.ws + WS_W + (size_t)l * LAYER_W; }
};

__device__ __forceinline__ void conv_tile(const float* src, int ldsrc, int k0, int n_src0, bf16* dst, int ldd, int dst_row0, LAS float* scr, int lane) {
#pragma unroll 4
    for (int i = 0; i < 16; ++i) { const int kk = 4 * i + (lane >> 4); const f32x4 v = *(const f32x4*)(src + (size_t)(k0 + kk) * ldsrc + n_src0 + 4 * (lane & 15));
        LAS float* p = scr + kk * 65 + 4 * (lane & 15); p[0] = v.x; p[1] = v.y; p[2] = v.z; p[3] = v.w; }
    asm volatile("s_waitcnt lgkmcnt(0)" ::: "memory");
    const int c = lane & 7;
#pragma unroll
    for (int j = 0; j < 8; ++j) { const int n = (lane >> 3) + 8 * j; const LAS float* s = scr + (8 * c) * 65 + n;
        u32x4 o; o.x = pk2(s[0], s[65]); o.y = pk2(s[2 * 65], s[3 * 65]); o.z = pk2(s[4 * 65], s[5 * 65]); o.w = pk2(s[6 * 65], s[7 * 65]);
        *(u32x4*)(dst + (size_t)(dst_row0 + n) * ldd + k0 + 8 * c) = o; }
    asm volatile("s_waitcnt lgkmcnt(0)" ::: "memory");
}

__device__ __forceinline__ void phase_prologue(const Ctx& c) {
    {
        LAS float* cond = (LAS float*)c.lds;
        LAS float* red = cond + 4096;
        for (int item = c.bid; item < 192; item += c.G) {
            __syncthreads();
            for (int i = c.tid; i < 4096; i += NT) cond[i] = siluf_(c.a.in[I_C][i]);
            __syncthreads();
            const int l = item / 96, col = (item % 96) * 64 + c.lane;
            const float* w = c.a.in[I_WADA] + (size_t)l * D * 6144 + col;
            float acc[4] = {0.f, 0.f, 0.f, 0.f};
            for (int k = c.wave * 128; k < c.wave * 128 + 128; ++k) { const float wv = w[(size_t)k * 6144];
#pragma unroll
                for (int b = 0; b < 4; ++b) acc[b] += cond[b * 1024 + k] * wv; }
#pragma unroll
            for (int b = 0; b < 4; ++b) red[(c.wave * 4 + b) * 64 + c.lane] = acc[b];
            __syncthreads();
            if (c.tid < 256) { const int b = c.tid >> 6, ln = c.tid & 63; float s = 0.f;
#pragma unroll
                for (int wv = 0; wv < 8; ++wv) s += red[(wv * 4 + b) * 64 + ln];
                const int cc = (item % 96) * 64 + ln;
                c.mod(l)[b * 6144 + cc] = s + c.a.in[I_BADA][l * 6144 + cc]; }
        }
        __syncthreads();
    }
    {
        LAS float* scr = (LAS float*)c.lds + c.wave * (64 * 65 + 64);
        const int gw = c.bid * NWAVES + c.wave, NGW = c.G * NWAVES;
        constexpr int I_IN = 16 * 68, I_BRM = 8 * 16, I_BRA = 8 * 16, I_OUT = 16 * 16, I_GU1 = 16 * 8, I_DN1 = 8 * 16;
        constexpr int PER_LAYER = I_IN + I_BRM + I_BRA + I_OUT + NE * 2 * I_GU1 + NE * I_DN1;
        for (int it = gw; it < 2 * PER_LAYER; it += NGW) {
            const int l = it / PER_LAYER; int r = it % PER_LAYER; unsigned char* wl = c.wl(l);
            if (r < I_IN) { const int kb = r / 68, nb = r % 68; const int n0 = nb * 64; const int ns = n0 < 1536 ? n0 : n0 + 8;
                conv_tile(c.a.in[I_WIN] + (size_t)l * D * D_IN, D_IN, kb * 64, ns, (bf16*)(wl + W_IN), D, n0, scr, c.lane); continue; } r -= I_IN;
            if (r < I_BRM) { const int kb = r / 16, nb = r % 16;
                conv_tile(c.a.in[I_WBRM] + (size_t)l * 512 * D, D, kb * 64, nb * 64, (bf16*)(wl + W_BR), D, nb * 64, scr, c.lane); continue; } r -= I_BRM;
            if (r < I_BRA) { const int kb = r / 16, nb = r % 16;
                conv_tile(c.a.in[I_WBRA] + (size_t)l * 512 * D, D, kb * 64, nb * 64, (bf16*)(wl + W_BR) + 512, D, nb * 64, scr, c.lane); continue; } r -= I_BRA;
            if (r < I_OUT) { const int kb = r / 16, nb = r % 16;
                conv_tile(c.a.in[I_WOUT] + (size_t)l * D * D, D, kb * 64, nb * 64, (bf16*)(wl + W_OUT), D, nb * 64, scr, c.lane); continue; } r -= I_OUT;
            if (r < NE * 2 * I_GU1) { const int e = r / (2 * I_GU1); int q = r % (2 * I_GU1); const int up = q / I_GU1; q %= I_GU1; const int kb = q / 8, nb = q % 8;
                const float* src = (up ? c.a.in[I_WU] : c.a.in[I_WG]) + ((size_t)l * NE + e) * D * DE;
                const int j0 = nb * 64; const int drow = (j0 / 128) * 256 + up * 128 + (j0 % 128);
                conv_tile(src, DE, kb * 64, j0, (bf16*)(wl + W_GU) + (size_t)e * 1024 * D, D, drow, scr, c.lane); continue; } r -= NE * 2 * I_GU1;
            { const int e = r / I_DN1; const int q = r % I_DN1; const int kb = q / 16, nb = q % 16;
                conv_tile(c.a.in[I_WD] + ((size_t)l * NE + e) * DE * D, D, kb * 64, nb * 64, (bf16*)(wl + W_DN) + (size_t)e * D * DE, DE, nb * 64, scr, c.lane); }
        }
    }
}

__device__ __forceinline__ void phase_xn(const Ctx& c, int l) {
    LAS float* w8 = (LAS float*)c.lds;
    const float* win = c.a.in[I_WIN] + (size_t)l * D * D_IN;
    for (int i = c.tid; i < 8192; i += NT) { const int k = i >> 3, j = i & 7; w8[j * 1024 + k] = win[(size_t)k * D_IN + 1536 + j]; }
    __syncthreads();
    const float* xs = (l == 0) ? c.a.in[I_X] : c.a.out;
    const float* wn = c.a.in[I_WN1] + l * D; const float* mod = c.mod(l);
    bf16* XN = (bf16*)(c.a.ws + WS_XA); float* IFG = (float*)(c.a.ws + WS_IFG);
    const int gw = c.bid * NWAVES + c.wave, NGW = c.G * NWAVES;
    for (int m = gw; m < T; m += NGW) {
        const int b = m / SEQ; const f32x4* xr = (const f32x4*)(xs + (size_t)m * D) + c.lane;
        f32x4 v[4]; float s = 0.f;
#pragma unroll
        for (int j = 0; j < 4; ++j) { v[j] = xr[64 * j]; s += (v[j].x * v[j].x + v[j].y * v[j].y) + (v[j].z * v[j].z + v[j].w * v[j].w); }
        const float rstd = rsqrtf(wave_sum(s) * (1.f / D) + EPS);
        float g[8] = {0.f, 0.f, 0.f, 0.f, 0.f, 0.f, 0.f, 0.f};
        u32x2* o8 = (u32x2*)(XN + (size_t)m * D) + c.lane;
#pragma unroll
        for (int j = 0; j < 4; ++j) { const int col = 256 * j + 4 * c.lane;
            const f32x4 w = *(const f32x4*)(wn + col), sh = *(const f32x4*)(mod + b * 6144 + col), sc = *(const f32x4*)(mod + b * 6144 + 1024 + col);
            v[j] = (v[j] * rstd * w) * (sc + 1.f) + sh;
            u32x2 o; o.x = pk2(v[j].x, v[j].y); o.y = pk2(v[j].z, v[j].w); o8[64 * j] = o; }
#pragma unroll
        for (int q = 0; q < 8; ++q) {
#pragma unroll
            for (int j = 0; j < 4; ++j) { const f32x4 ww = *(const LAS f32x4*)(w8 + q * 1024 + 256 * j + 4 * c.lane); g[q] += (v[j].x * ww.x + v[j].y * ww.y) + (v[j].z * ww.z + v[j].w * ww.w); }
            asm volatile("" ::: "memory"); }
#pragma unroll
        for (int q = 0; q < 8; ++q) g[q] = wave_sum(g[q]);
        if (c.lane < 8) { float val = 0.f;
#pragma unroll
            for (int q = 0; q < 8; ++q) val = (c.lane == q) ? g[q] : val;
            const float bias = (c.lane < 4) ? c.a.in[I_BIG][l * 4 + c.lane] : c.a.in[I_BFG][l * 4 + c.lane - 4];
            IFG[(size_t)m * 8 + c.lane] = val + bias; }
    }
}

template <class RowA, class RowB0, class RowB1, class Epi>
__device__ __forceinline__ void naive_gemm_tile(const Ctx& c, int m0, int n0, int K0, int K1, const RowA& ra, const RowA& ra1, const RowB0& rb0, const RowB1& rb1, const Epi& epi) {
    LAS float* As = (LAS float*)c.lds;
    LAS float* Bs = As + 32 * 132;
    const int ty = c.tid >> 4, tx = c.tid & 15;
    f32x4 acc[2][4];
#pragma unroll
    for (int p = 0; p < 2; ++p)
#pragma unroll
        for (int i = 0; i < 4; ++i) acc[p][i] = (f32x4){0.f, 0.f, 0.f, 0.f};
#pragma unroll
    for (int p = 0; p < 2; ++p) {
        const int K = p ? K1 : K0;
        const int ar = c.tid >> 2, akc = c.tid & 3;
        const bf16* arow = p ? ra1(m0 + ar) : ra(m0 + ar);
        const int br = (c.tid & 255) >> 2, bkc = c.tid & 3;
        const bf16* brow = p ? rb1(n0 + br) : rb0(n0 + br);
        for (int k0 = 0; k0 < K; k0 += 32) {
            __syncthreads();
            { const u32x4 v = *(const u32x4*)(arow + k0 + 8 * akc); LAS float* d = As + (8 * akc) * 132 + ar;
              d[0] = bflo(v.x); d[132] = bfhi(v.x); d[2 * 132] = bflo(v.y); d[3 * 132] = bfhi(v.y); d[4 * 132] = bflo(v.z); d[5 * 132] = bfhi(v.z); d[6 * 132] = bflo(v.w); d[7 * 132] = bfhi(v.w); }
            if (c.tid < 256) { const u32x4 v = *(const u32x4*)(brow + k0 + 8 * bkc); LAS float* d = Bs + (8 * bkc) * 68 + br;
              d[0] = bflo(v.x); d[68] = bfhi(v.x); d[2 * 68] = bflo(v.y); d[3 * 68] = bfhi(v.y); d[4 * 68] = bflo(v.z); d[5 * 68] = bfhi(v.z); d[6 * 68] = bflo(v.w); d[7 * 68] = bfhi(v.w); }
            __syncthreads();
#pragma unroll 8
            for (int k = 0; k < 32; ++k) { const f32x4 av = *(const LAS f32x4*)(As + k * 132 + 4 * ty), bv = *(const LAS f32x4*)(Bs + k * 68 + 4 * tx);
                acc[p][0] += av.x * bv; acc[p][1] += av.y * bv; acc[p][2] += av.z * bv; acc[p][3] += av.w * bv; }
        }
    }
#pragma unroll
    for (int i = 0; i < 4; ++i) epi(m0 + 4 * ty + i, n0 + 4 * tx, acc[0][i], acc[1][i]);
}

struct RowPlain { const bf16* p; int ld; __device__ __forceinline__ const bf16* operator()(int r) const { return p + (size_t)r * ld; } };
struct RowGather { const bf16* p; int ld; const int* map; __device__ __forceinline__ const bf16* operator()(int r) const { return p + (size_t)map[r] * ld; } };
struct RowGU { const bf16* p; int up; __device__ __forceinline__ const bf16* operator()(int j) const { return p + (size_t)((j >> 7) * 256 + up * 128 + (j & 127)) * D; } };

struct EpiZ { bf16* z; __device__ __forceinline__ void operator()(int r, int cc, f32x4 a, f32x4) const { u32x2 o; o.x = pk2(a.x, a.y); o.y = pk2(a.z, a.w); *(u32x2*)(z + (size_t)r * ZW + cc) = o; } };
struct EpiBR { const bf16* z; bf16* mg; __device__ __forceinline__ void operator()(int r, int cc, f32x4 a, f32x4 b) const {
    const u32x2 gm = *(const u32x2*)(z + (size_t)r * ZW + Z_GM + cc), ga = *(const u32x2*)(z + (size_t)r * ZW + Z_GA + cc);
    const float m0 = sigmoidf_(bflo(gm.x)) * a.x + sigmoidf_(bflo(ga.x)) * b.x, m1 = sigmoidf_(bfhi(gm.x)) * a.y + sigmoidf_(bfhi(ga.x)) * b.y;
    const float m2 = sigmoidf_(bflo(gm.y)) * a.z + sigmoidf_(bflo(ga.y)) * b.z, m3 = sigmoidf_(bfhi(gm.y)) * a.w + sigmoidf_(bfhi(ga.y)) * b.w;
    u32x2 o; o.x = pk2(m0, m1); o.y = pk2(m2, m3); *(u32x2*)(mg + (size_t)r * D + cc) = o; } };
struct EpiOut { const float* xin; float* xout; const float* g1; __device__ __forceinline__ void operator()(int r, int cc, f32x4 a, f32x4) const {
    const int b = r / SEQ; const f32x4 g = *(const f32x4*)(g1 + b * 6144 + cc), xo = *(const f32x4*)(xin + (size_t)r * D + cc);
    *(f32x4*)(xout + (size_t)r * D + cc) = xo + g * a; } };
struct EpiAct { bf16* act; __device__ __forceinline__ void operator()(int r, int cc, f32x4 a, f32x4 b) const {
    u32x2 o; o.x = pk2(siluf_(a.x) * b.x, siluf_(a.y) * b.y); o.y = pk2(siluf_(a.z) * b.z, siluf_(a.w) * b.w); *(u32x2*)(act + (size_t)r * DE + cc) = o; } };
struct EpiY { bf16* y; __device__ __forceinline__ void operator()(int r, int cc, f32x4 a, f32x4) const { u32x2 o; o.x = pk2(a.x, a.y); o.y = pk2(a.z, a.w); *(u32x2*)(y + (size_t)r * D + cc) = o; } };

__device__ __forceinline__ void phase_inproj(const Ctx& c, int l) {
    const RowPlain ra{(const bf16*)(c.a.ws + WS_XA), D}, rb{(const bf16*)(c.wl(l) + W_IN), D}; const EpiZ e{(bf16*)(c.a.ws + WS_Z)};
    constexpr int NTN = ZW / 64, NTM = T / 128;
    for (int u = c.bid; u < NTN * NTM; u += c.G) naive_gemm_tile(c, (u / NTN) * 128, (u % NTN) * 64, D, 0, ra, ra, rb, rb, e);
}
__device__ __forceinline__ void phase_br(const Ctx& c, int l) {
    const bf16* hc = (const bf16*)(c.a.ws + WS_HCAT); const bf16* w = (const bf16*)(c.wl(l) + W_BR);
    const RowPlain ra{hc, D}, ra1{hc + 512, D}, rb0{w, D}, rb1{w + 512, D}; const EpiBR e{(const bf16*)(c.a.ws + WS_Z), (bf16*)(c.a.ws + WS_XA)};
    constexpr int NTN = D / 64, NTM = T / 128;
    for (int u = c.bid; u < NTN * NTM; u += c.G) naive_gemm_tile(c, (u / NTN) * 128, (u % NTN) * 64, 512, 512, ra, ra1, rb0, rb1, e);
}
__device__ __forceinline__ void phase_out(const Ctx& c, int l) {
    const RowPlain ra{(const bf16*)(c.a.ws + WS_XA), D}, rb{(const bf16*)(c.wl(l) + W_OUT), D};
    const EpiOut e{l == 0 ? c.a.in[I_X] : c.a.out, c.a.out, c.mod(l) + 2048};
    constexpr int NTN = D / 64, NTM = T / 128;
    for (int u = c.bid; u < NTN * NTM; u += c.G) naive_gemm_tile(c, (u / NTN) * 128, (u % NTN) * 64, D, 0, ra, ra, rb, rb, e);
}

__device__ __forceinline__ void naive_mlstm(const Ctx& c, int l, int bh) {
    const int b = bh >> 2, h = bh & 3, d = c.tid >> 2, eq = c.tid & 3, e0 = eq * 16;
    const bf16* z = (const bf16*)(c.a.ws + WS_Z); const float* IFG = (const float*)(c.a.ws + WS_IFG); float* HR = (float*)(c.a.ws + WS_XA);
    const float* cw = c.a.in[I_CONVW] + (size_t)l * 4 * 512; const float* cb = c.a.in[I_CONVB] + l * 512;
    float C[16], n[16], m = 0.f;
#pragma unroll
    for (int i = 0; i < 16; ++i) { C[i] = 0.f; n[i] = 0.f; }
    LAS float* cwl = (LAS float*)c.lds;
    for (int i = c.tid; i < 640; i += NT) { if (i < 512) { const int j = i >> 7, ch = i & 127; cwl[i] = cw[j * 512 + (ch < 64 ? h * 64 + ch : 256 + h * 64 + ch - 64)]; } else { const int ch = i - 512; cwl[i] = cb[ch < 64 ? h * 64 + ch : 256 + h * 64 + ch - 64]; } }
    __syncthreads();
    for (int s = 0; s < SEQ; ++s) {
        const size_t t = (size_t)b * SEQ + s;
        float q[16], k[16];
#pragma unroll
        for (int i = 0; i < 16; ++i) { q[i] = cwl[512 + e0 + i]; k[i] = cwl[512 + 64 + e0 + i]; }
#pragma unroll
        for (int j = 0; j < 4; ++j) { const int sj = s - 3 + j; if (sj >= 0) { const bf16* zr = z + ((size_t)b * SEQ + sj) * ZW;
            const u32x4 q0 = *(const u32x4*)(zr + Z_QM + h * 64 + e0), q1 = *(const u32x4*)(zr + Z_QM + h * 64 + e0 + 8);
            const u32x4 k0 = *(const u32x4*)(zr + Z_KM + h * 64 + e0), k1 = *(const u32x4*)(zr + Z_KM + h * 64 + e0 + 8);
            const unsigned qa[8] = {q0.x, q0.y, q0.z, q0.w, q1.x, q1.y, q1.z, q1.w}, ka[8] = {k0.x, k0.y, k0.z, k0.w, k1.x, k1.y, k1.z, k1.w};
#pragma unroll
            for (int i = 0; i < 8; ++i) { q[2 * i] += cwl[j * 128 + e0 + 2 * i] * bflo(qa[i]); q[2 * i + 1] += cwl[j * 128 + e0 + 2 * i + 1] * bfhi(qa[i]); k[2 * i] += cwl[j * 128 + 64 + e0 + 2 * i] * bflo(ka[i]); k[2 * i + 1] += cwl[j * 128 + 64 + e0 + 2 * i + 1] * bfhi(ka[i]); } }
            asm volatile("" ::: "memory"); }
#pragma unroll
        for (int i = 0; i < 16; ++i) { q[i] = siluf_(q[i]) * 0.125f; k[i] = siluf_(k[i]); }
        const float v = bf2f(z[t * ZW + Z_VM + h * 128 + d]);
        const float ig = IFG[t * 8 + h], fp = IFG[t * 8 + 4 + h];
        const float logf = fminf(fp, 0.f) - log1pf(__expf(-fabsf(fp)));
        const float mn = fmaxf(logf + m, ig), dec = __expf(logf + m - mn), fr = __expf(ig - mn);
        float num = 0.f, den = 0.f;
#pragma unroll
        for (int i = 0; i < 16; ++i) { C[i] = dec * C[i] + fr * v * k[i]; n[i] = dec * n[i] + fr * k[i]; num += C[i] * q[i]; den += n[i] * q[i]; }
        num += __shfl_xor(num, 1); num += __shfl_xor(num, 2); den += __shfl_xor(den, 1); den += __shfl_xor(den, 2);
        m = mn;
        if (eq == 0) HR[t * 512 + h * 128 + d] = num / fmaxf(fabsf(den), __expf(-mn));
    }
}
__device__ __forceinline__ void naive_swa(const Ctx& c, int l, int first_blk) {
    const bf16* z = (const bf16*)(c.a.ws + WS_Z); bf16* hc = (bf16*)(c.a.ws + WS_HCAT);
    const float* relb = c.a.in[I_RELB]; const float* sinks = c.a.in[I_SINK] + l * AH;
    const int nblk = c.G - first_blk;
    for (int idx = (c.bid - first_blk) * NT + c.tid; idx < T * AH * 4; idx += nblk * NT) {
        const int part = idx & 3, hd = (idx >> 2) & 7, t = idx >> 5, kh = hd >> 2, s = t % SEQ, d0 = part * 16;
        float q[16], o[16];
        { const bf16* qp = z + (size_t)t * ZW + Z_QA + hd * 64 + d0;
#pragma unroll
          for (int i = 0; i < 2; ++i) { const u32x4 v = *(const u32x4*)(qp + 8 * i); q[8 * i] = bflo(v.x); q[8 * i + 1] = bfhi(v.x); q[8 * i + 2] = bflo(v.y); q[8 * i + 3] = bfhi(v.y); q[8 * i + 4] = bflo(v.z); q[8 * i + 5] = bfhi(v.z); q[8 * i + 6] = bflo(v.w); q[8 * i + 7] = bfhi(v.w); } }
#pragma unroll
        for (int i = 0; i < 16; ++i) o[i] = 0.f;
        float mx = sinks[hd], lsum = 1.f;
        const int j0 = s - 127 < 0 ? 0 : s - 127;
        for (int j = j0; j <= s; ++j) {
            const bf16* kp = z + (size_t)(t - s + j) * ZW + Z_KA + kh * 64 + d0; const bf16* vp = z + (size_t)(t - s + j) * ZW + Z_VA + kh * 64 + d0;
            float sc = 0.f;
#pragma unroll
            for (int i = 0; i < 2; ++i) { const u32x4 v = *(const u32x4*)(kp + 8 * i);
                sc += q[8 * i] * bflo(v.x) + q[8 * i + 1] * bfhi(v.x) + q[8 * i + 2] * bflo(v.y) + q[8 * i + 3] * bfhi(v.y) + q[8 * i + 4] * bflo(v.z) + q[8 * i + 5] * bfhi(v.z) + q[8 * i + 6] * bflo(v.w) + q[8 * i + 7] * bfhi(v.w); }
            sc += __shfl_xor(sc, 1); sc += __shfl_xor(sc, 2);
            sc = sc * 0.125f + relb[T5_BUCKET[s - j] * AH + hd];
            const float mn = fmaxf(mx, sc), corr = __expf(mx - mn), p = __expf(sc - mn);
            lsum = lsum * corr + p; mx = mn;
#pragma unroll
            for (int i = 0; i < 2; ++i) { const u32x4 v = *(const u32x4*)(vp + 8 * i);
                o[8 * i] = o[8 * i] * corr + p * bflo(v.x); o[8 * i + 1] = o[8 * i + 1] * corr + p * bfhi(v.x); o[8 * i + 2] = o[8 * i + 2] * corr + p * bflo(v.y); o[8 * i + 3] = o[8 * i + 3] * corr + p * bfhi(v.y);
                o[8 * i + 4] = o[8 * i + 4] * corr + p * bflo(v.z); o[8 * i + 5] = o[8 * i + 5] * corr + p * bfhi(v.z); o[8 * i + 6] = o[8 * i + 6] * corr + p * bflo(v.w); o[8 * i + 7] = o[8 * i + 7] * corr + p * bfhi(v.w); }
        }
        const float inv = 1.f / lsum; bf16* op = hc + (size_t)t * D + 512 + hd * 64 + d0;
#pragma unroll
        for (int i = 0; i < 2; ++i) { u32x4 w; w.x = pk2(o[8 * i] * inv, o[8 * i + 1] * inv); w.y = pk2(o[8 * i + 2] * inv, o[8 * i + 3] * inv); w.z = pk2(o[8 * i + 4] * inv, o[8 * i + 5] * inv); w.w = pk2(o[8 * i + 6] * inv, o[8 * i + 7] * inv); *(u32x4*)(op + 8 * i) = w; }
    }
}
__device__ __forceinline__ void phase_mix1(const Ctx& c, int l) {
    if (c.bid < 16) naive_mlstm(c, l, c.bid); else naive_swa(c, l, 16);
}
__device__ __forceinline__ void phase_mix2(const Ctx& c, int l) {
    const float* HR = (const float*)(c.a.ws + WS_XA); const bf16* z = (const bf16*)(c.a.ws + WS_Z); bf16* hc = (bf16*)(c.a.ws + WS_HCAT);
    const float* wm = c.a.in[I_WMN] + l * 512;
    const int gw = c.bid * NWAVES + c.wave, NGW = c.G * NWAVES;
    for (int it = gw; it < T * MH; it += NGW) { const int t = it >> 2, h = it & 3; const int col = h * 128 + 2 * c.lane;
        const float a0 = HR[(size_t)t * 512 + col], a1 = HR[(size_t)t * 512 + col + 1];
        const float rstd = rsqrtf(wave_sum(a0 * a0 + a1 * a1) * (1.f / 128.f) + EPS);
        const unsigned og = *(const unsigned*)(z + (size_t)t * ZW + Z_OM + col);
        *(unsigned*)(hc + (size_t)t * D + col) = pk2(a0 * rstd * wm[col] * sigmoidf_(bflo(og)), a1 * rstd * wm[col + 1] * sigmoidf_(bfhi(og))); }
}

__device__ __forceinline__ void phase_route(const Ctx& c, int l) {
    LAS float* wr = (LAS float*)c.lds;
    for (int i = c.tid; i < 16384; i += NT) { const int k = i >> 4, e = i & 15; wr[e * 1024 + k] = c.a.in[I_WR][i]; }
    __syncthreads();
    int* ROWTOK = (int*)(c.a.ws + WS_ROWTOK);
    for (int i = c.bid * NT + c.tid; i < MOE_ROWS; i += c.G * NT) ROWTOK[i] = 0;
    const float* wn = c.a.in[I_WN2] + l * D; const float* mod = c.mod(l); const float* rbias = c.a.in[I_RB];
    bf16* XN = (bf16*)(c.a.ws + WS_XA); int* RIDX = (int*)(c.a.ws + WS_RIDX); float* RW = (float*)(c.a.ws + WS_RW);
    unsigned* cnt = c.ctl() + CW_CNT + 64 * l;
    const int gw = c.bid * NWAVES + c.wave, NGW = c.G * NWAVES;
    for (int m = gw; m < T; m += NGW) {
        const int b = m / SEQ; const f32x4* xr = (const f32x4*)(c.a.out + (size_t)m * D) + c.lane;
        f32x4 v[4]; float s = 0.f;
#pragma unroll
        for (int j = 0; j < 4; ++j) { v[j] = xr[64 * j]; s += (v[j].x * v[j].x + v[j].y * v[j].y) + (v[j].z * v[j].z + v[j].w * v[j].w); }
        const float rstd = rsqrtf(wave_sum(s) * (1.f / D) + EPS);
        float lg[16];
#pragma unroll
        for (int e = 0; e < 16; ++e) lg[e] = 0.f;
        u32x2* o8 = (u32x2*)(XN + (size_t)m * D) + c.lane;
#pragma unroll
        for (int j = 0; j < 4; ++j) { const int col = 256 * j + 4 * c.lane;
            const f32x4 w = *(const f32x4*)(wn + col), sh = *(const f32x4*)(mod + b * 6144 + 3072 + col), sc = *(const f32x4*)(mod + b * 6144 + 4096 + col);
            v[j] = (v[j] * rstd * w) * (sc + 1.f) + sh;
            u32x2 o; o.x = pk2(v[j].x, v[j].y); o.y = pk2(v[j].z, v[j].w); o8[64 * j] = o; }
#pragma unroll
        for (int e = 0; e < 16; ++e) {
#pragma unroll
            for (int j = 0; j < 4; ++j) { const f32x4 ww = *(const LAS f32x4*)(wr + e * 1024 + 256 * j + 4 * c.lane); lg[e] += (v[j].x * ww.x + v[j].y * ww.y) + (v[j].z * ww.z + v[j].w * ww.w); }
            asm volatile("" ::: "memory"); }
#pragma unroll
        for (int e = 0; e < 16; ++e) lg[e] = wave_sum(lg[e]);
        float sc[16], sel[16];
#pragma unroll
        for (int e = 0; e < 16; ++e) { sc[e] = 1.f / (1.f + expf(-lg[e])); sel[e] = sc[e] + rbias[e]; }
        int bg = 0; float bgs = -INFINITY;
#pragma unroll
        for (int g = 0; g < 4; ++g) { float m1 = -INFINITY, m2 = -INFINITY;
#pragma unroll
            for (int i = 0; i < 4; ++i) { const float x = sel[4 * g + i]; if (x > m1) { m2 = m1; m1 = x; } else if (x > m2) m2 = x; }
            const float gs = m1 + m2; if (gs > bgs) { bgs = gs; bg = g; } }
        int i1 = -1, i2 = -1; float v1 = -INFINITY, v2 = -INFINITY;
#pragma unroll
        for (int e = 0; e < 16; ++e) { if ((e >> 2) == bg) { const float x = sel[e]; if (x > v1) { v2 = v1; i2 = i1; v1 = x; i1 = e; } else if (x > v2) { v2 = x; i2 = e; } } }
        float s1 = 0.f, s2 = 0.f;
#pragma unroll
        for (int e = 0; e < 16; ++e) { s1 = (e == i1) ? sc[e] : s1; s2 = (e == i2) ? sc[e] : s2; }
        if (c.lane == 0) { const float inv = 1.f / (s1 + s2); RIDX[2 * m] = i1; RIDX[2 * m + 1] = i2; RW[2 * m] = s1 * inv; RW[2 * m + 1] = s2 * inv;
            atomicAdd(cnt + i1, 1u); atomicAdd(cnt + i2, 1u); }
    }
}
__device__ __forceinline__ void phase_fill(const Ctx& c, int l) {
    LAS int* offs = (LAS int*)c.lds;
    const unsigned* cnt = c.ctl() + CW_CNT + 64 * l; unsigned* cur = c.ctl() + CW_CUR + 64 * l;
    if (c.tid == 0) { int o = 0; for (int e = 0; e < NE; ++e) { offs[e] = o; o += (int)((__hip_atomic_load(cnt + e, __ATOMIC_RELAXED, __HIP_MEMORY_SCOPE_AGENT) + 255u) & ~255u); } offs[NE] = o; }
    __syncthreads();
    const int* RIDX = (const int*)(c.a.ws + WS_RIDX); int* SLOT = (int*)(c.a.ws + WS_SLOT); int* ROWTOK = (int*)(c.a.ws + WS_ROWTOK);
    for (int i = c.bid * NT + c.tid; i < 2 * T; i += c.G * NT) { const int e = RIDX[i]; const int pos = (int)atomicAdd(cur + e, 1u); const int row = offs[e] + pos; ROWTOK[row] = i >> 1; SLOT[i] = row; }
    __syncthreads();
}
__device__ __forceinline__ void phase_g1(const Ctx& c, int l) {
    LAS int* offs = (LAS int*)(c.lds + 65536);
    const unsigned* cnt = c.ctl() + CW_CNT + 64 * l;
    if (c.tid == 0) { int o = 0; for (int e = 0; e < NE; ++e) { offs[e] = o; o += (int)((__hip_atomic_load(cnt + e, __ATOMIC_RELAXED, __HIP_MEMORY_SCOPE_AGENT) + 255u) & ~255u); } offs[NE] = o; }
    __syncthreads();
    const int R = offs[NE]; const int NTM = R / 128; constexpr int NTN = DE / 64;
    const RowGather ra{(const bf16*)(c.a.ws + WS_XA), D, (const int*)(c.a.ws + WS_ROWTOK)}; const EpiAct ep{(bf16*)(c.a.ws + WS_ACT)};
    for (int u = c.bid; u < NTM * NTN; u += c.G) { const int m0 = (u / NTN) * 128, n0 = (u % NTN) * 64; int e = 0; for (int i = 1; i < NE; ++i) if (m0 >= offs[i]) e = i;
        const bf16* w = (const bf16*)(c.wl(l) + W_GU) + (size_t)e * 1024 * D; const RowGU rb0{w, 0}, rb1{w, 1};
        naive_gemm_tile(c, m0, n0, D, D, ra, ra, rb0, rb1, ep); }
    __syncthreads();
}
__device__ __forceinline__ void phase_g2(const Ctx& c, int l) {
    LAS int* offs = (LAS int*)(c.lds + 65536);
    const unsigned* cnt = c.ctl() + CW_CNT + 64 * l;
    if (c.tid == 0) { int o = 0; for (int e = 0; e < NE; ++e) { offs[e] = o; o += (int)((__hip_atomic_load(cnt + e, __ATOMIC_RELAXED, __HIP_MEMORY_SCOPE_AGENT) + 255u) & ~255u); } offs[NE] = o; }
    __syncthreads();
    const int R = offs[NE]; const int NTM = R / 128; constexpr int NTN = D / 64;
    const RowPlain ra{(const bf16*)(c.a.ws + WS_ACT), DE}; const EpiY ep{(bf16*)(c.a.ws + WS_Y)};
    for (int u = c.bid; u < NTM * NTN; u += c.G) { const int m0 = (u / NTN) * 128, n0 = (u % NTN) * 64; int e = 0; for (int i = 1; i < NE; ++i) if (m0 >= offs[i]) e = i;
        const RowPlain rb{(const bf16*)(c.wl(l) + W_DN) + (size_t)e * D * DE, DE};
        naive_gemm_tile(c, m0, n0, DE, 0, ra, ra, rb, rb, ep); }
    __syncthreads();
}
__device__ __forceinline__ void phase_combine(const Ctx& c, int l) {
    const float* mod = c.mod(l); const bf16* Y = (const bf16*)(c.a.ws + WS_Y); const int* SLOT = (const int*)(c.a.ws + WS_SLOT); const float* RW = (const float*)(c.a.ws + WS_RW);
    const float* wf = c.a.in[I_WF];
    const int gw = c.bid * NWAVES + c.wave, NGW = c.G * NWAVES;
    for (int m = gw; m < T; m += NGW) {
        const int b = m / SEQ; f32x4* xr = (f32x4*)(c.a.out + (size_t)m * D) + c.lane;
        const int s0 = SLOT[2 * m], s1 = SLOT[2 * m + 1]; const float w0 = RW[2 * m], w1 = RW[2 * m + 1];
        const u32x2* y0 = (const u32x2*)(Y + (size_t)s0 * D) + c.lane; const u32x2* y1 = (const u32x2*)(Y + (size_t)s1 * D) + c.lane;
        f32x4 v[4]; float s = 0.f;
#pragma unroll
        for (int j = 0; j < 4; ++j) { const int col = 256 * j + 4 * c.lane; const f32x4 g = *(const f32x4*)(mod + b * 6144 + 5120 + col);
            const u32x2 a = y0[64 * j], bb = y1[64 * j];
            const f32x4 ya = {bflo(a.x), bfhi(a.x), bflo(a.y), bfhi(a.y)}, yb = {bflo(bb.x), bfhi(bb.x), bflo(bb.y), bfhi(bb.y)};
            v[j] = xr[64 * j] + g * (ya * w0 + yb * w1);
            s += (v[j].x * v[j].x + v[j].y * v[j].y) + (v[j].z * v[j].z + v[j].w * v[j].w); }
        if (l == DEPTH - 1) { const float rstd = rsqrtf(wave_sum(s) * (1.f / D) + EPS);
#pragma unroll
            for (int j = 0; j < 4; ++j) xr[64 * j] = v[j] * rstd * *(const f32x4*)(wf + 256 * j + 4 * c.lane); }
        else {
#pragma unroll
            for (int j = 0; j < 4; ++j) xr[64 * j] = v[j]; }
    }
}

namespace pg8 {
typedef short bf16x8 __attribute__((ext_vector_type(8)));
constexpr int BM = 256, BK = 64, HALF = 128, HTB = HALF * BK * 2, STAGE_BYTES = 8 * HTB, NXCD = 8, WGM = 8;
__host__ __device__ __forceinline__ int lds_byte(int r, int c) { const int st = (r >> 4) * 2 + (c >> 5), rr = r & 15, cc = c & 31, ob = rr * 64 + cc * 2; return st * 1024 + (ob ^ (((ob >> 9) & 1) << 5)); }
__host__ __device__ __forceinline__ void stage_rc(int b, int& R, int& C) { const int st = b / 1024, sb = b % 1024, swz = sb ^ (((sb >> 9) & 1) << 5); R = (st >> 1) * 16 + swz / 64; C = (st & 1) * 32 + (swz % 64) / 2; }
__host__ __device__ __forceinline__ int perm32(int rho) { const int n = rho >> 4, i = rho & 15; return 8 * (i >> 2) + 4 * n + (i & 3); }
struct Unit { int pm, pn; };
struct StaticOrder {
    int nM, nN, nwg, G, c;
    __device__ void init(int M, int N, int G_, int c_) { nM = M / BM; nN = N / BM; nwg = nM * nN; G = G_; c = c_; }
    __device__ bool next(int i, Unit& u) const {
        const long L = (long)i * G + c; if (L >= nwg) return false;
        int wgid = (int)L; { const int q = nwg / NXCD, r = nwg % NXCD, xcd = wgid % NXCD, off = wgid / NXCD; wgid = (xcd < r ? xcd * (q + 1) : r * (q + 1) + (xcd - r) * q) + off; }
        const int nig = WGM * nN, gid = wgid / nig, fm = gid * WGM, gsz = (nM - fm) < WGM ? (nM - fm) : WGM;
        u.pm = fm + ((wgid % nig) % gsz); u.pn = (wgid % nig) / gsz; return true;
    }
};
__device__ __forceinline__ unsigned cvt_pk_bf16(float lo, float hi) { unsigned r; asm volatile("v_cvt_pk_bf16_f32 %0, %1, %2" : "=v"(r) : "v"(lo), "v"(hi)); return r; }

template <class Epi, class Sched, class Prob, bool ALIGN_EPI, bool SP2>
__device__ __forceinline__ void gemm_phase(LAS unsigned char* lds, const Prob& P, const Sched& S, const Epi& E) {
    int tid_ = threadIdx.x; asm volatile("" : "+v"(tid_));
    const int tid = tid_, wid = __builtin_amdgcn_readfirstlane(tid >> 6), lane = tid & 63, wr = wid >> 2, wc = wid & 3, fr = lane & 15, fq = lane >> 4;
    const int K = P.K, nt = K / BK;
    unsigned voffA[2], voffB[2]; int RA[2], CA[2];
#pragma unroll
    for (int i = 0; i < 2; ++i) { int R, C; stage_rc(tid * 16 + i * 8192, R, C); const int Rb = Epi::PERM ? ((R & ~31) + perm32(R & 31)) : R;
        RA[i] = R; CA[i] = C; voffA[i] = (unsigned)(R * K + C) * 2u; voffB[i] = (unsigned)(Rb * K + C) * 2u; }
    const size_t kstep = (size_t)(BK * 2);
    const size_t hstep = (size_t)HALF * K * 2;
    const unsigned ldsw = (unsigned)wid * 1024u;
    const int aoff = lds_byte(wr * 64 + fr, fq * 8), boff = lds_byte(wc * 32 + fr, fq * 8);
    unsigned vac[2][2], van[2][2];
#define PG8_SA(b, h) (((b) * 2 + (h)) * HTB)
#define PG8_SB(b, h) ((4 + (b) * 2 + (h)) * HTB)
#define PG8_GLDS(src, dstoff) __builtin_amdgcn_global_load_lds((const unsigned*)(src), (LAS unsigned*)(lds + (dstoff)), 16, 0, 0)
#define PG8_STAGE(bufoff, gbase, voff) do { _Pragma("unroll") for (int _i = 0; _i < 2; ++_i) PG8_GLDS((const char*)(gbase) + (voff)[_i], (bufoff) + ldsw + _i * 8192); } while (0)
#define PG8_STAGEA(bufoff, gbase, h, VG) do { if constexpr (Prob::GATHER) { _Pragma("unroll") for (int _i = 0; _i < 2; ++_i) PG8_GLDS((const char*)(gbase) + (VG)[h][_i], (bufoff) + ldsw + _i * 8192); } \
        else { _Pragma("unroll") for (int _i = 0; _i < 2; ++_i) PG8_GLDS((const char*)(gbase) + (h) * hstep + voffA[_i], (bufoff) + ldsw + _i * 8192); } } while (0)
#define PG8_LDA(dst, b, h) do { _Pragma("unroll") for (int m = 0; m < 4; ++m) _Pragma("unroll") for (int k = 0; k < 2; ++k) dst[m][k] = *(const LAS bf16x8*)(lds + PG8_SA(b, h) + aoff + m * 2048 + k * 1024); } while (0)
#define PG8_LDB(dst, b, h) do { _Pragma("unroll") for (int n = 0; n < 2; ++n) _Pragma("unroll") for (int k = 0; k < 2; ++k) dst[n][k] = *(const LAS bf16x8*)(lds + PG8_SB(b, h) + boff + n * 2048 + k * 1024); } while (0)
#define PG8_MMA(ai, bj, At, Bt) do { __builtin_amdgcn_s_setprio(1); _Pragma("unroll") for (int m = 0; m < 4; ++m) _Pragma("unroll") for (int n = 0; n < 2; ++n) _Pragma("unroll") for (int k = 0; k < 2; ++k) \
        acc[ai][bj][m][n] = __builtin_amdgcn_mfma_f32_16x16x32_bf16(Bt[n][k], At[m][k], acc[ai][bj][m][n], 0, 0, 0); __builtin_amdgcn_s_setprio(0); } while (0)
#define PG8_WAIT_V(n) asm volatile("s_waitcnt vmcnt(" #n ")" ::: "memory")
#define PG8_WAIT_L(n) asm volatile("s_waitcnt lgkmcnt(" #n ")" ::: "memory")
#define PG8_BAR __builtin_amdgcn_s_barrier()
#define PG8_SCHED __builtin_amdgcn_sched_barrier(0)
    Unit cur, nxt; int ui = 0;
    if (!S.next(0, cur)) return;
    f32x4 acc[2][2][4][2];
#pragma unroll
    for (int a = 0; a < 2; ++a)
#pragma unroll
        for (int b = 0; b < 2; ++b)
#pragma unroll
            for (int m = 0; m < 4; ++m)
#pragma unroll
                for (int n = 0; n < 2; ++n) acc[a][b][m][n] = (f32x4){0.f, 0.f, 0.f, 0.f};
    bf16x8 At[4][2], B0[2][2], B1[2][2];
    const char* cA = P.a_tile(cur); const char* cB = P.b_tile(cur);
    if constexpr (Prob::GATHER) { P.a_voff(cur, RA, CA, vac); }
    if constexpr (SP2) {
        PG8_STAGE(PG8_SB(0, 0), cB, voffB); PG8_STAGE(PG8_SB(0, 1), cB + hstep, voffB); PG8_STAGEA(PG8_SA(0, 0), cA, 0, vac); PG8_STAGEA(PG8_SA(0, 1), cA, 1, vac);
        if (wr == 1) PG8_BAR;
        PG8_WAIT_V(2); PG8_BAR;
        PG8_STAGE(PG8_SB(1, 0), cB + kstep, voffB); PG8_STAGEA(PG8_SA(1, 0), cA + kstep, 0, vac); PG8_STAGE(PG8_SB(1, 1), cB + hstep + kstep, voffB);
        PG8_WAIT_V(6); PG8_BAR;
    } else {
        PG8_STAGE(PG8_SB(0, 0), cB, voffB); PG8_STAGEA(PG8_SA(0, 0), cA, 0, vac); PG8_STAGE(PG8_SB(0, 1), cB + hstep, voffB); PG8_STAGEA(PG8_SA(0, 1), cA, 1, vac);
        if (wr == 1) PG8_BAR;
        PG8_WAIT_V(4); PG8_BAR;
        PG8_STAGE(PG8_SB(1, 0), cB + kstep, voffB); PG8_STAGEA(PG8_SA(1, 0), cA + kstep, 0, vac); PG8_STAGE(PG8_SB(1, 1), cB + hstep + kstep, voffB);
        PG8_WAIT_V(6); PG8_BAR;
    }
    for (;;) {
        const bool has_next = S.next(ui + 1, nxt);
        const char* nA = has_next ? P.a_tile(nxt) : cA; const char* nB = has_next ? P.b_tile(nxt) : cB;
        if constexpr (Prob::GATHER) { if (has_next) P.a_voff(nxt, RA, CA, van); else {
#pragma unroll
            for (int h = 0; h < 2; ++h)
#pragma unroll
                for (int i = 0; i < 2; ++i) van[h][i] = vac[h][i]; } }
        for (int t = 0; t < nt; t += 2) {
            const bool last = (t == nt - 2);
            const char* a1 = cA + (size_t)(t + 1) * kstep;
            const char* a2 = last ? nA : cA + (size_t)(t + 2) * kstep; const char* b2 = last ? nB : cB + (size_t)(t + 2) * kstep;
            const char* a3 = a2 + kstep; const char* b3 = b2 + kstep;
            unsigned v2[2][2];
            if constexpr (Prob::GATHER) {
#pragma unroll
                for (int h = 0; h < 2; ++h)
#pragma unroll
                    for (int i = 0; i < 2; ++i) v2[h][i] = last ? van[h][i] : vac[h][i]; }
            if constexpr (SP2) {
            PG8_LDB(B0, 0, 0); PG8_LDB(B1, 0, 1); PG8_SCHED; PG8_LDA(At, 0, 0); PG8_STAGEA(PG8_SA(1, 1), a1, 1, vac);
            PG8_WAIT_V(8); PG8_WAIT_L(0); PG8_BAR; PG8_MMA(0, 0, At, B0); PG8_MMA(0, 1, At, B1); PG8_BAR; PG8_SCHED;
            PG8_LDA(At, 0, 1); PG8_STAGE(PG8_SB(0, 0), b2, voffB); PG8_STAGE(PG8_SB(0, 1), b2 + hstep, voffB); PG8_STAGEA(PG8_SA(0, 0), a2, 0, v2);
            PG8_WAIT_V(8); PG8_WAIT_L(0); PG8_BAR; PG8_MMA(1, 0, At, B0); PG8_MMA(1, 1, At, B1); PG8_BAR; PG8_SCHED;
            PG8_LDB(B0, 1, 0); PG8_LDB(B1, 1, 1); PG8_SCHED; PG8_LDA(At, 1, 0); PG8_STAGEA(PG8_SA(0, 1), a2, 1, v2);
            PG8_WAIT_V(8); PG8_WAIT_L(0); PG8_BAR; PG8_MMA(0, 0, At, B0); PG8_MMA(0, 1, At, B1); PG8_BAR; PG8_SCHED;
            PG8_LDA(At, 1, 1); PG8_STAGE(PG8_SB(1, 0), b3, voffB); PG8_STAGE(PG8_SB(1, 1), b3 + hstep, voffB); PG8_STAGEA(PG8_SA(1, 0), a3, 0, v2);
            PG8_WAIT_V(8); PG8_WAIT_L(0); PG8_BAR; PG8_MMA(1, 0, At, B0); PG8_MMA(1, 1, At, B1); PG8_BAR; PG8_SCHED;
            } else {
            PG8_LDB(B0, 0, 0); PG8_SCHED; PG8_LDA(At, 0, 0); PG8_STAGEA(PG8_SA(1, 1), a1, 1, vac);
            PG8_WAIT_L(8); PG8_BAR; PG8_WAIT_L(0); PG8_MMA(0, 0, At, B0); PG8_BAR; PG8_SCHED;
            PG8_LDB(B1, 0, 1); PG8_STAGE(PG8_SB(0, 0), b2, voffB);
            PG8_BAR; PG8_WAIT_L(0); PG8_MMA(0, 1, At, B1); PG8_BAR;
            PG8_LDA(At, 0, 1); PG8_STAGEA(PG8_SA(0, 0), a2, 0, v2);
            PG8_BAR; PG8_WAIT_L(0); PG8_MMA(1, 0, At, B0); PG8_BAR; PG8_SCHED;
            PG8_STAGE(PG8_SB(0, 1), b2 + hstep, voffB);
            PG8_WAIT_V(6); PG8_BAR; PG8_MMA(1, 1, At, B1); PG8_BAR;
            PG8_LDB(B0, 1, 0); PG8_SCHED; PG8_LDA(At, 1, 0); PG8_STAGEA(PG8_SA(0, 1), a2, 1, v2);
            PG8_WAIT_L(8); PG8_BAR; PG8_WAIT_L(0); PG8_MMA(0, 0, At, B0); PG8_BAR; PG8_SCHED;
            PG8_LDB(B1, 1, 1); PG8_STAGE(PG8_SB(1, 0), b3, voffB);
            PG8_BAR; PG8_WAIT_L(0); PG8_MMA(0, 1, At, B1); PG8_BAR;
            PG8_LDA(At, 1, 1); PG8_STAGEA(PG8_SA(1, 0), a3, 0, v2);
            PG8_BAR; PG8_WAIT_L(0); PG8_MMA(1, 0, At, B0); PG8_BAR; PG8_SCHED;
            PG8_STAGE(PG8_SB(1, 1), b3 + hstep, voffB);
            PG8_WAIT_V(6); PG8_BAR; PG8_MMA(1, 1, At, B1); PG8_BAR;
            }
            if constexpr (Epi::HAS_MID) { if (t == nt / 2 - 2) E.mid(acc, cur, wr, wc, fr, fq); }
        }
        if constexpr (ALIGN_EPI) { if (wr == 0) PG8_BAR; }
        E(acc, cur, wr, wc, fr, fq);
        if (!has_next) break;
#pragma unroll
        for (int a = 0; a < 2; ++a)
#pragma unroll
            for (int b = 0; b < 2; ++b)
#pragma unroll
                for (int m = 0; m < 4; ++m)
#pragma unroll
                    for (int n = 0; n < 2; ++n) acc[a][b][m][n] = (f32x4){0.f, 0.f, 0.f, 0.f};
        cur = nxt; cA = nA; cB = nB; ++ui;
        if constexpr (Prob::GATHER) {
#pragma unroll
            for (int h = 0; h < 2; ++h)
#pragma unroll
                for (int i = 0; i < 2; ++i) vac[h][i] = van[h][i]; }
        if constexpr (ALIGN_EPI) { if (wr == 1) PG8_BAR; }
    }
    PG8_WAIT_V(0);
    if constexpr (!ALIGN_EPI) { if (wr == 0) PG8_BAR; }
    PG8_BAR;
#undef PG8_SA
#undef PG8_SB
#undef PG8_GLDS
#undef PG8_STAGE
#undef PG8_STAGEA
#undef PG8_LDA
#undef PG8_LDB
#undef PG8_MMA
#undef PG8_WAIT_V
#undef PG8_WAIT_L
#undef PG8_BAR
#undef PG8_SCHED
}

struct ProbPlain { static constexpr bool GATHER = false; const bf16* A; const bf16* Bt; int K;
    __device__ __forceinline__ const char* a_tile(const Unit& u) const { return (const char*)A + (size_t)u.pm * BM * K * 2; }
    __device__ __forceinline__ const char* b_tile(const Unit& u) const { return (const char*)Bt + (size_t)u.pn * BM * K * 2; }
    __device__ __forceinline__ void a_voff(const Unit&, const int (&)[2], const int (&)[2], unsigned (&)[2][2]) const {} };
__device__ __forceinline__ int moe_expert(const LAS int* offs, int row) { int e = 0;
#pragma unroll
    for (int i = 1; i < NE; ++i) e = (row >= offs[i]) ? i : e;
    return e; }
struct ProbMoeGather { static constexpr bool GATHER = true; const bf16* A; const bf16* Bt; int K; const int* rowtok; const LAS int* offs; size_t estride;
    __device__ __forceinline__ const char* a_tile(const Unit&) const { return (const char*)A; }
    __device__ __forceinline__ const char* b_tile(const Unit& u) const { const int e = __builtin_amdgcn_readfirstlane(moe_expert(offs, u.pm * BM)); return (const char*)(Bt + (size_t)e * estride) + (size_t)u.pn * BM * K * 2; }
    __device__ __forceinline__ void a_voff(const Unit& u, const int (&R)[2], const int (&C)[2], unsigned (&v)[2][2]) const {
#pragma unroll
        for (int h = 0; h < 2; ++h)
#pragma unroll
            for (int i = 0; i < 2; ++i) { const int tok = rowtok[u.pm * BM + h * HALF + R[i]]; v[h][i] = (unsigned)(tok * K + C[i]) * 2u; }
#pragma unroll
        for (int h = 0; h < 2; ++h)
#pragma unroll
            for (int i = 0; i < 2; ++i) asm volatile("" : "+v"(v[h][i]));
    } };
struct ProbMoePlain { static constexpr bool GATHER = false; const bf16* A; const bf16* Bt; int K; const LAS int* offs; size_t estride;
    __device__ __forceinline__ const char* a_tile(const Unit& u) const { return (const char*)A + (size_t)u.pm * BM * K * 2; }
    __device__ __forceinline__ const char* b_tile(const Unit& u) const { const int e = __builtin_amdgcn_readfirstlane(moe_expert(offs, u.pm * BM)); return (const char*)(Bt + (size_t)e * estride) + (size_t)u.pn * BM * K * 2; }
    __device__ __forceinline__ void a_voff(const Unit&, const int (&)[2], const int (&)[2], unsigned (&)[2][2]) const {} };

struct EpiStoreBf16 {
    static constexpr bool PERM = true, HAS_MID = false; bf16* O; int ldc;
    __device__ __forceinline__ void operator()(const f32x4 (&acc)[2][2][4][2], const Unit& u, int wr, int wc, int fr, int fq) const {
        int row0 = u.pm * BM + wr * 64 + fr, col0 = u.pn * BM + wc * 32 + 8 * fq; asm volatile("" : "+v"(row0), "+v"(col0));
#pragma unroll
        for (int ai = 0; ai < 2; ++ai)
#pragma unroll
            for (int m = 0; m < 4; ++m) { bf16* rowp = O + (size_t)(row0 + ai * HALF + m * 16) * ldc + col0;
#pragma unroll
                for (int bj = 0; bj < 2; ++bj) { const f32x4 v0 = acc[ai][bj][m][0], v1 = acc[ai][bj][m][1];
                    u32x4 w; w.x = cvt_pk_bf16(v0[0], v0[1]); w.y = cvt_pk_bf16(v0[2], v0[3]); w.z = cvt_pk_bf16(v1[0], v1[1]); w.w = cvt_pk_bf16(v1[2], v1[3]);
                    *(u32x4*)(rowp + bj * HALF) = w; } }
    }
};
__device__ __forceinline__ void unpack8(const u32x4 w, float (&f)[8]) { f[0] = bflo(w.x); f[1] = bfhi(w.x); f[2] = bflo(w.y); f[3] = bfhi(w.y); f[4] = bflo(w.z); f[5] = bfhi(w.z); f[6] = bflo(w.w); f[7] = bfhi(w.w); }
struct EpiMerge {
    static constexpr bool PERM = true, HAS_MID = true; const bf16* z; bf16* O;
    __device__ __forceinline__ void mid(f32x4 (&acc)[2][2][4][2], const Unit& u, int wr, int wc, int fr, int fq) const {
        int row0 = u.pm * BM + wr * 64 + fr, col0 = u.pn * BM + wc * 32 + 8 * fq; asm volatile("" : "+v"(row0), "+v"(col0));
        const bf16* zr0 = z + (size_t)row0 * ZW + col0;
#pragma unroll
        for (int ai = 0; ai < 2; ++ai)
#pragma unroll
            for (int m = 0; m < 4; ++m)
#pragma unroll
                for (int bj = 0; bj < 2; ++bj) { const bf16* zr = zr0 + (size_t)(ai * HALF + m * 16) * ZW + bj * HALF;
                    const u32x4 gmw = *(const u32x4*)(zr + Z_GM), gaw = *(const u32x4*)(zr + Z_GA);
                    f32x4 r0, r1;
                    r0[0] = (1.f + __expf(-bflo(gaw.x))) * __builtin_amdgcn_rcpf(1.f + __expf(-bflo(gmw.x))); r0[1] = (1.f + __expf(-bfhi(gaw.x))) * __builtin_amdgcn_rcpf(1.f + __expf(-bfhi(gmw.x)));
                    r0[2] = (1.f + __expf(-bflo(gaw.y))) * __builtin_amdgcn_rcpf(1.f + __expf(-bflo(gmw.y))); r0[3] = (1.f + __expf(-bfhi(gaw.y))) * __builtin_amdgcn_rcpf(1.f + __expf(-bfhi(gmw.y)));
                    r1[0] = (1.f + __expf(-bflo(gaw.z))) * __builtin_amdgcn_rcpf(1.f + __expf(-bflo(gmw.z))); r1[1] = (1.f + __expf(-bfhi(gaw.z))) * __builtin_amdgcn_rcpf(1.f + __expf(-bfhi(gmw.z)));
                    r1[2] = (1.f + __expf(-bflo(gaw.w))) * __builtin_amdgcn_rcpf(1.f + __expf(-bflo(gmw.w))); r1[3] = (1.f + __expf(-bfhi(gaw.w))) * __builtin_amdgcn_rcpf(1.f + __expf(-bfhi(gmw.w)));
                    acc[ai][bj][m][0] *= r0; acc[ai][bj][m][1] *= r1;
                    asm volatile("" ::: "memory"); }
    }
    __device__ __forceinline__ void operator()(const f32x4 (&acc)[2][2][4][2], const Unit& u, int wr, int wc, int fr, int fq) const {
        int row0 = u.pm * BM + wr * 64 + fr, col0 = u.pn * BM + wc * 32 + 8 * fq; asm volatile("" : "+v"(row0), "+v"(col0));
#pragma unroll
        for (int ai = 0; ai < 2; ++ai)
#pragma unroll
            for (int m = 0; m < 4; ++m) { const size_t row = (size_t)(row0 + ai * HALF + m * 16); const bf16* zr = z + row * ZW + col0; bf16* rowp = O + row * D + col0;
#pragma unroll
                for (int bj = 0; bj < 2; ++bj) { float ga[8]; unpack8(*(const u32x4*)(zr + Z_GA + bj * HALF), ga);
                    float s[8];
#pragma unroll
                    for (int i = 0; i < 8; ++i) s[i] = __builtin_amdgcn_rcpf(1.f + __expf(-ga[i]));
                    const f32x4 v0 = acc[ai][bj][m][0] * (f32x4){s[0], s[1], s[2], s[3]}, v1 = acc[ai][bj][m][1] * (f32x4){s[4], s[5], s[6], s[7]};
                    u32x4 w; w.x = cvt_pk_bf16(v0[0], v0[1]); w.y = cvt_pk_bf16(v0[2], v0[3]); w.z = cvt_pk_bf16(v1[0], v1[1]); w.w = cvt_pk_bf16(v1[2], v1[3]);
                    *(u32x4*)(rowp + bj * HALF) = w; }
                asm volatile("" ::: "memory"); }
    }
};
struct EpiResidual {
    static constexpr bool PERM = false, HAS_MID = false; const float* xin; float* xout; const float* gmod;
    __device__ __forceinline__ void operator()(const f32x4 (&acc)[2][2][4][2], const Unit& u, int wr, int wc, int fr, int fq) const {
        int row0 = u.pm * BM + wr * 64 + fr, col0 = u.pn * BM + wc * 32 + 4 * fq; asm volatile("" : "+v"(row0), "+v"(col0)); const int b = (u.pm * BM) / SEQ;
        f32x4 gv[2][2];
#pragma unroll
        for (int bj = 0; bj < 2; ++bj)
#pragma unroll
            for (int n = 0; n < 2; ++n) gv[bj][n] = *(const f32x4*)(gmod + b * 6144 + col0 + bj * HALF + n * 16);
#pragma unroll
        for (int ai = 0; ai < 2; ++ai)
#pragma unroll
            for (int m = 0; m < 4; ++m) { const size_t off = (size_t)(row0 + ai * HALF + m * 16) * D + col0;
#pragma unroll
                for (int bj = 0; bj < 2; ++bj)
#pragma unroll
                    for (int n = 0; n < 2; ++n) { const f32x4 xo = *(const f32x4*)(xin + off + bj * HALF + n * 16); *(f32x4*)(xout + off + bj * HALF + n * 16) = xo + gv[bj][n] * acc[ai][bj][m][n]; }
                if (m & 1) asm volatile("" ::: "memory"); }
    }
};
struct EpiAct {
    static constexpr bool PERM = true, HAS_MID = false; bf16* O;
    __device__ __forceinline__ void operator()(const f32x4 (&acc)[2][2][4][2], const Unit& u, int wr, int wc, int fr, int fq) const {
        int row0 = u.pm * BM + wr * 64 + fr, col0 = u.pn * HALF + wc * 32 + 8 * fq; asm volatile("" : "+v"(row0), "+v"(col0));
#pragma unroll
        for (int ai = 0; ai < 2; ++ai)
#pragma unroll
            for (int m = 0; m < 4; ++m) { bf16* rowp = O + (size_t)(row0 + ai * HALF + m * 16) * DE + col0; float a[8];
#pragma unroll
                for (int n = 0; n < 2; ++n)
#pragma unroll
                    for (int i = 0; i < 4; ++i) { const float g = acc[ai][0][m][n][i], up = acc[ai][1][m][n][i]; a[4 * n + i] = g * __builtin_amdgcn_rcpf(1.f + __expf(-g)) * up; }
                u32x4 w; w.x = cvt_pk_bf16(a[0], a[1]); w.y = cvt_pk_bf16(a[2], a[3]); w.z = cvt_pk_bf16(a[4], a[5]); w.w = cvt_pk_bf16(a[6], a[7]);
                *(u32x4*)rowp = w; }
    }
};
}

#ifndef OPT_GEMM
#define OPT_GEMM 1
#endif
#ifndef OPT_MIX
#define OPT_MIX 1
#endif
constexpr int OFFS_LDS = 131072;
__device__ __forceinline__ void moe_offsets_lds(const Ctx& c, int l) {
    LAS int* offs = (LAS int*)(c.lds + OFFS_LDS);
    const unsigned* cnt = c.ctl() + CW_CNT + 64 * l;
    if (c.tid == 0) { int o = 0; for (int e = 0; e < NE; ++e) { offs[e] = o; o += (int)((__hip_atomic_load(cnt + e, __ATOMIC_RELAXED, __HIP_MEMORY_SCOPE_AGENT) + 255u) & ~255u); } offs[NE] = o; }
    __syncthreads();
}
__device__ __forceinline__ void phase_inproj_opt(const Ctx& c, int l) {
    const pg8::ProbPlain P{(const bf16*)(c.a.ws + WS_XA), (const bf16*)(c.wl(l) + W_IN), D}; pg8::StaticOrder S; S.init(T, ZW, c.G, c.bid);
    const pg8::EpiStoreBf16 E{(bf16*)(c.a.ws + WS_Z), ZW};
    pg8::gemm_phase<pg8::EpiStoreBf16, pg8::StaticOrder, pg8::ProbPlain, true, true>(c.lds, P, S, E);
}
__device__ __forceinline__ void phase_br_opt(const Ctx& c, int l) {
    const pg8::ProbPlain P{(const bf16*)(c.a.ws + WS_HCAT), (const bf16*)(c.wl(l) + W_BR), D}; pg8::StaticOrder S; S.init(T, D, c.G, c.bid);
    const pg8::EpiMerge E{(const bf16*)(c.a.ws + WS_Z), (bf16*)(c.a.ws + WS_XA)};
    pg8::gemm_phase<pg8::EpiMerge, pg8::StaticOrder, pg8::ProbPlain, true, true>(c.lds, P, S, E);
}
__device__ __forceinline__ void phase_out_opt(const Ctx& c, int l) {
    const pg8::ProbPlain P{(const bf16*)(c.a.ws + WS_XA), (const bf16*)(c.wl(l) + W_OUT), D}; pg8::StaticOrder S; S.init(T, D, c.G, c.bid);
    const pg8::EpiResidual E{l == 0 ? c.a.in[I_X] : c.a.out, c.a.out, c.mod(l) + 2048};
    pg8::gemm_phase<pg8::EpiResidual, pg8::StaticOrder, pg8::ProbPlain, true, true>(c.lds, P, S, E);
}
__device__ __forceinline__ void phase_g1_opt(const Ctx& c, int l) {
    moe_offsets_lds(c, l); const LAS int* offs = (const LAS int*)(c.lds + OFFS_LDS); const int R = offs[NE];
    const pg8::ProbMoeGather P{(const bf16*)(c.a.ws + WS_XA), (const bf16*)(c.wl(l) + W_GU), D, (const int*)(c.a.ws + WS_ROWTOK), offs, (size_t)1024 * D};
    pg8::StaticOrder S; S.init(R, 1024, c.G, c.bid);
    const pg8::EpiAct E{(bf16*)(c.a.ws + WS_ACT)};
    pg8::gemm_phase<pg8::EpiAct, pg8::StaticOrder, pg8::ProbMoeGather, true, true>(c.lds, P, S, E);
}
__device__ __forceinline__ void phase_g2_opt(const Ctx& c, int l) {
    moe_offsets_lds(c, l); const LAS int* offs = (const LAS int*)(c.lds + OFFS_LDS); const int R = offs[NE];
    const pg8::ProbMoePlain P{(const bf16*)(c.a.ws + WS_ACT), (const bf16*)(c.wl(l) + W_DN), DE, offs, (size_t)D * DE};
    pg8::StaticOrder S; S.init(R, D, c.G, c.bid);
    const pg8::EpiStoreBf16 E{(bf16*)(c.a.ws + WS_Y), D};
    pg8::gemm_phase<pg8::EpiStoreBf16, pg8::StaticOrder, pg8::ProbMoePlain, true, true>(c.lds, P, S, E);
}

__device__ __forceinline__ void unpack8_(const u32x4 w, float (&f)[8]) { f[0] = bflo(w.x); f[1] = bfhi(w.x); f[2] = bflo(w.y); f[3] = bfhi(w.y); f[4] = bflo(w.z); f[5] = bfhi(w.z); f[6] = bflo(w.w); f[7] = bfhi(w.w); }
typedef short bf16x8 __attribute__((ext_vector_type(8)));
typedef float f32x16 __attribute__((ext_vector_type(16)));
typedef float f32x2_t __attribute__((ext_vector_type(2)));
typedef __bf16 bf16x2_t __attribute__((ext_vector_type(2)));
#define MFMA32(a, b, c) __builtin_amdgcn_mfma_f32_32x32x16_bf16((a), (b), (c), 0, 0, 0)
__device__ __forceinline__ unsigned cvtpk(float lo, float hi) { f32x2_t v = {lo, hi}; bf16x2_t b = __builtin_convertvector(v, bf16x2_t); return __builtin_bit_cast(unsigned, b); }
__device__ __forceinline__ int crow(int i, int h) { return (i & 3) + 8 * (i >> 2) + 4 * h; }
template <int S> __device__ __forceinline__ bf16x8 pack_step(const f32x16& x) {
    u32x4 p; p.x = cvtpk(x[8 * S], x[8 * S + 1]); p.y = cvtpk(x[8 * S + 2], x[8 * S + 3]); p.z = cvtpk(x[8 * S + 4], x[8 * S + 5]); p.w = cvtpk(x[8 * S + 6], x[8 * S + 7]);
    return __builtin_bit_cast(bf16x8, p);
}
__device__ __forceinline__ float logsigmoidf_(float x) { return fminf(x, 0.f) - log1pf(__expf(-fabsf(x))); }
__device__ __forceinline__ float wave_incl_sum(float x, int lane) {
#pragma unroll
    for (int o = 1; o < 64; o <<= 1) { const float y = __shfl_up(x, o); x = (lane >= o) ? x + y : x; }
    return x;
}
__device__ __forceinline__ float wave_incl_max(float x, int lane) {
#pragma unroll
    for (int o = 1; o < 64; o <<= 1) { const float y = __shfl_up(x, o); x = (lane >= o) ? fmaxf(x, y) : x; }
    return x;
}
__device__ __forceinline__ float wave_max(float v) {
#pragma unroll
    for (int o = 1; o < 64; o <<= 1) v = fmaxf(v, __shfl_xor(v, o));
    return v;
}
constexpr size_t WS_NLOC = 2 * MiB;
constexpr size_t WS_MLOC = WS_NLOC + 256 * 1024;
constexpr size_t WS_BLAST = WS_MLOC + 4096;
constexpr size_t WS_MPREV = WS_BLAST + 4096;
static_assert(WS_MPREV + 4096 <= 4 * MiB, "mlstm small state");

__device__ __forceinline__ void swa_unit(const Ctx& c, int l, int u) {
    const int b = u >> 6, kh = (u >> 5) & 1, n = u & 31;
    LAS unsigned char* Ks = c.lds;
    LAS unsigned char* VT = c.lds + 36864;
    LAS float* BT = (LAS float*)(c.lds + 70144);
    const bf16* z = (const bf16*)(c.a.ws + WS_Z); bf16* hc = (bf16*)(c.a.ws + WS_HCAT);
    const size_t tblk = (size_t)b * SEQ + (size_t)n * 128;
#pragma unroll
    for (int it = 0; it < 4; ++it) { const int idx = c.tid + NT * it, row = idx >> 3, ch = idx & 7; const int srel = n * 128 - 128 + row;
        u32x4 kv = {0u, 0u, 0u, 0u}, vv = {0u, 0u, 0u, 0u};
        if (srel >= 0) { const bf16* zr = z + ((size_t)b * SEQ + srel) * ZW; kv = *(const u32x4*)(zr + Z_KA + kh * 64 + ch * 8); vv = *(const u32x4*)(zr + Z_VA + kh * 64 + ch * 8); }
        *(LAS u32x4*)(Ks + row * 144 + ch * 16) = kv;
        LAS unsigned short* vt = (LAS unsigned short*)(VT + (ch * 8) * 520 + row * 2);
        vt[0] = (unsigned short)(vv.x & 0xffffu); vt[260] = (unsigned short)(vv.x >> 16); vt[2 * 260] = (unsigned short)(vv.y & 0xffffu); vt[3 * 260] = (unsigned short)(vv.y >> 16);
        vt[4 * 260] = (unsigned short)(vv.z & 0xffffu); vt[5 * 260] = (unsigned short)(vv.z >> 16); vt[6 * 260] = (unsigned short)(vv.w & 0xffffu); vt[7 * 260] = (unsigned short)(vv.w >> 16); }
    { const int g = c.tid >> 7, dist = c.tid & 127; BT[c.tid] = c.a.in[I_RELB][T5_BUCKET[dist] * AH + kh * 4 + g]; }
    __syncthreads();
    const int r = c.lane & 31, hh = c.lane >> 5, g = c.wave >> 1, head = kh * 4 + g;
    const float sink = c.a.in[I_SINK][l * AH + head];
#pragma unroll 1
    for (int jj = 0; jj < 2; ++jj) {
        const int j = (c.wave & 1) * 2 + jj;
        const size_t tq = tblk + 32 * j + r;
        bf16x8 qf[4];
#pragma unroll
        for (int kk = 0; kk < 4; ++kk) qf[kk] = *(const bf16x8*)(z + tq * ZW + Z_QA + head * 64 + 16 * kk + 8 * hh);
        f32x16 X[5];
#pragma unroll
        for (int kt = 0; kt < 5; ++kt) { const int kb0 = 32 * (j + kt);
            f32x16 x = {0.f, 0.f, 0.f, 0.f, 0.f, 0.f, 0.f, 0.f, 0.f, 0.f, 0.f, 0.f, 0.f, 0.f, 0.f, 0.f};
#pragma unroll
            for (int kk = 0; kk < 4; ++kk) { const bf16x8 a = *(const LAS bf16x8*)(Ks + (kb0 + r) * 144 + 32 * kk + 16 * hh); x = MFMA32(a, qf[kk], x); }
            X[kt] = x; asm volatile("" ::: "memory"); }
        float mx = sink;
#pragma unroll
        for (int kt = 0; kt < 5; ++kt) {
#pragma unroll
            for (int i = 0; i < 16; ++i) { const int cr = crow(i, hh), dist = r + 128 - 32 * kt - cr, kb = 32 * (j + kt) + cr;
                const bool valid = (dist >= 0) && (dist < 128) && (n > 0 || kb >= 128);
                const float s = X[kt][i] * 0.125f + BT[g * 128 + (dist & 127)];
                X[kt][i] = valid ? s : -1e30f; mx = fmaxf(mx, X[kt][i]); }
            asm volatile("" ::: "memory"); }
        mx = fmaxf(mx, __shfl_xor(mx, 32));
        float ls = 0.f;
#pragma unroll
        for (int kt = 0; kt < 5; ++kt)
#pragma unroll
            for (int i = 0; i < 16; ++i) { const float p = __expf(X[kt][i] - mx); X[kt][i] = p; ls += p; }
        ls += __shfl_xor(ls, 32);
        const float inv = 1.f / (ls + __expf(sink - mx));
        f32x16 O0 = {0.f, 0.f, 0.f, 0.f, 0.f, 0.f, 0.f, 0.f, 0.f, 0.f, 0.f, 0.f, 0.f, 0.f, 0.f, 0.f}, O1 = O0;
#pragma unroll
        for (int kt = 0; kt < 5; ++kt) { const int kb0 = 32 * (j + kt);
            X[kt] = X[kt] * inv;
            const bf16x8 p0 = pack_step<0>(X[kt]), p1 = pack_step<1>(X[kt]);
            const LAS unsigned char* v0 = VT + r * 520 + (kb0 + 4 * hh) * 2; const LAS unsigned char* v1 = VT + (32 + r) * 520 + (kb0 + 4 * hh) * 2;
            { const u32x2 lo = *(const LAS u32x2*)(v0), hi = *(const LAS u32x2*)(v0 + 16); const u32x4 w = {lo.x, lo.y, hi.x, hi.y}; O0 = MFMA32(p0, __builtin_bit_cast(bf16x8, w), O0); }
            { const u32x2 lo = *(const LAS u32x2*)(v0 + 32), hi = *(const LAS u32x2*)(v0 + 48); const u32x4 w = {lo.x, lo.y, hi.x, hi.y}; O0 = MFMA32(p1, __builtin_bit_cast(bf16x8, w), O0); }
            { const u32x2 lo = *(const LAS u32x2*)(v1), hi = *(const LAS u32x2*)(v1 + 16); const u32x4 w = {lo.x, lo.y, hi.x, hi.y}; O1 = MFMA32(p0, __builtin_bit_cast(bf16x8, w), O1); }
            { const u32x2 lo = *(const LAS u32x2*)(v1 + 32), hi = *(const LAS u32x2*)(v1 + 48); const u32x4 w = {lo.x, lo.y, hi.x, hi.y}; O1 = MFMA32(p1, __builtin_bit_cast(bf16x8, w), O1); }
            asm volatile("" ::: "memory"); }
        bf16* ob = hc + (tblk + 32 * j) * D + 512 + head * 64 + r;
#pragma unroll
        for (int i = 0; i < 16; ++i) { const int q = crow(i, hh); ob[(size_t)q * D] = (bf16)f2bf(O0[i]); ob[(size_t)q * D + 32] = (bf16)f2bf(O1[i]); }
    }
    __syncthreads();
}

struct ChunkGates { float ig, bcum, blast; };
__device__ __forceinline__ ChunkGates chunk_gates(const Ctx& c, size_t t0, int h) {
    const float* IFG = (const float*)(c.a.ws + WS_IFG);
    ChunkGates g; g.ig = IFG[(t0 + c.lane) * 8 + h]; const float fp = IFG[(t0 + c.lane) * 8 + 4 + h];
    g.bcum = wave_incl_sum(logsigmoidf_(fp), c.lane); g.blast = __shfl(g.bcum, 63); return g;
}
__device__ __forceinline__ void conv8(const Ctx& c, int l, const bf16* zrow, int spos, int zc0, int cc0, float scale, float (&out)[8]) {
    const float* cw = c.a.in[I_CONVW] + (size_t)l * 4 * 512 + cc0; const float* cb = c.a.in[I_CONVB] + l * 512 + cc0;
    { const f32x4 b0 = *(const f32x4*)cb, b1 = *(const f32x4*)(cb + 4); out[0] = b0.x; out[1] = b0.y; out[2] = b0.z; out[3] = b0.w; out[4] = b1.x; out[5] = b1.y; out[6] = b1.z; out[7] = b1.w; }
#pragma unroll
    for (int j = 0; j < 4; ++j) { const int sj = spos - 3 + j;
        if (sj >= 0) { float zv[8]; unpack8_(*(const u32x4*)(zrow + (ptrdiff_t)(j - 3) * ZW + zc0), zv);
            const f32x4 w0 = *(const f32x4*)(cw + j * 512), w1 = *(const f32x4*)(cw + j * 512 + 4);
            out[0] += w0.x * zv[0]; out[1] += w0.y * zv[1]; out[2] += w0.z * zv[2]; out[3] += w0.w * zv[3]; out[4] += w1.x * zv[4]; out[5] += w1.y * zv[5]; out[6] += w1.z * zv[6]; out[7] += w1.w * zv[7]; } }
#pragma unroll
    for (int i = 0; i < 8; ++i) out[i] = siluf_(out[i]) * scale;
}

__device__ __forceinline__ void mlstm_local_unit(const Ctx& c, int l, int u) {
    const int b = u >> 8, h = (u >> 6) & 3, ch = u & 63;
    const size_t t0 = (size_t)b * SEQ + (size_t)ch * 64;
    LAS unsigned char* kT = c.lds;
    LAS unsigned char* avT = c.lds + 9216;
    LAS float* a_l = (LAS float*)(c.lds + 27648);
    const bf16* z = (const bf16*)(c.a.ws + WS_Z);
    const ChunkGates g = chunk_gates(c, t0, h);
    const float w = g.blast - g.bcum + g.ig; const float mloc = wave_max(w); const float a = __expf(w - mloc);
    if (c.wave == 0) a_l[c.lane] = a;
    { const int lp = c.tid >> 3, c8 = c.tid & 7; float kc[8];
      conv8(c, l, z + (t0 + lp) * ZW, ch * 64 + lp, Z_KM + h * 64 + c8 * 8, 256 + h * 64 + c8 * 8, 1.f, kc);
      LAS unsigned short* d = (LAS unsigned short*)(kT + (c8 * 8) * 144 + lp * 2);
#pragma unroll
      for (int i = 0; i < 8; ++i) d[i * 72] = (unsigned short)f2bf(kc[i]); }
    __syncthreads();
#pragma unroll
    for (int it = 0; it < 2; ++it) { const int idx = c.tid + NT * it, lp = idx >> 4, c16 = idx & 15; float vv[8]; unpack8_(*(const u32x4*)(z + (t0 + lp) * ZW + Z_VM + h * 128 + c16 * 8), vv);
        const float al = a_l[lp]; LAS unsigned short* d = (LAS unsigned short*)(avT + (c16 * 8) * 144 + lp * 2);
#pragma unroll
        for (int i = 0; i < 8; ++i) d[i * 72] = (unsigned short)f2bf(vv[i] * al); }
    __syncthreads();
    const int r = c.lane & 31, hh = c.lane >> 5, dt = c.wave >> 1, et = c.wave & 1;
    f32x16 acc = {0.f, 0.f, 0.f, 0.f, 0.f, 0.f, 0.f, 0.f, 0.f, 0.f, 0.f, 0.f, 0.f, 0.f, 0.f, 0.f};
#pragma unroll
    for (int kk = 0; kk < 4; ++kk) { const bf16x8 af = *(const LAS bf16x8*)(avT + (32 * dt + r) * 144 + 32 * kk + 16 * hh), bfr = *(const LAS bf16x8*)(kT + (32 * et + r) * 144 + 32 * kk + 16 * hh); acc = MFMA32(af, bfr, acc); }
    float* CL = (float*)(c.a.ws + WS_XA) + (size_t)u * 8192;
#pragma unroll
    for (int i = 0; i < 16; ++i) CL[(32 * dt + crow(i, hh)) * 64 + 32 * et + r] = acc[i];
    if (c.tid < 64) { float s = 0.f; const LAS unsigned short* kr = (const LAS unsigned short*)(kT + c.tid * 144);
#pragma unroll 8
        for (int lp = 0; lp < 64; ++lp) s += a_l[lp] * bf2f(kr[lp]);
        ((float*)(c.a.ws + WS_NLOC))[(size_t)u * 64 + c.tid] = s;
        if (c.tid == 0) { ((float*)(c.a.ws + WS_MLOC))[u] = mloc; ((float*)(c.a.ws + WS_BLAST))[u] = g.blast; } }
    __syncthreads();
}

__device__ __forceinline__ void phase_scan(const Ctx& c) {
    LAS float* ml = (LAS float*)c.lds; LAS float* bl = ml + 64;
    for (int w = c.bid; w < 256; w += c.G) {
        const int bh = w >> 4, slice = w & 15;
        __syncthreads();
        if (c.tid < 64) { ml[c.tid] = ((const float*)(c.a.ws + WS_MLOC))[bh * 64 + c.tid]; bl[c.tid] = ((const float*)(c.a.ws + WS_BLAST))[bh * 64 + c.tid]; }
        __syncthreads();
        float* CL = (float*)(c.a.ws + WS_XA) + (size_t)bh * 64 * 8192 + slice * 512 + c.tid;
        float x[64];
#pragma unroll
        for (int ch = 0; ch < 64; ++ch) x[ch] = CL[(size_t)ch * 8192];
        float m = 0.f, C = 0.f;
#pragma unroll
        for (int ch = 0; ch < 64; ++ch) { CL[(size_t)ch * 8192] = C;
            const float mn = fmaxf(bl[ch] + m, ml[ch]); const float dec = __expf(bl[ch] + m - mn), fr = __expf(ml[ch] - mn);
            C = dec * C + fr * x[ch]; m = mn; }
        if (slice == 0 && c.tid < 64) { float* NL = (float*)(c.a.ws + WS_NLOC) + (size_t)bh * 64 * 64 + c.tid; float* MP = (float*)(c.a.ws + WS_MPREV) + bh * 64;
            float mm = 0.f, nn = 0.f;
#pragma unroll 4
            for (int ch = 0; ch < 64; ++ch) { const float xv = NL[ch * 64]; NL[ch * 64] = nn; if (c.tid == 0) MP[ch] = mm;
                const float mn = fmaxf(bl[ch] + mm, ml[ch]); const float dec = __expf(bl[ch] + mm - mn), fr = __expf(ml[ch] - mn);
                nn = dec * nn + fr * xv; mm = mn; } }
    }
    __syncthreads();
}

__device__ __forceinline__ void mlstm_out_unit(const Ctx& c, int l, int u) {
    const int b = u >> 8, h = (u >> 6) & 3, ch = u & 63;
    const size_t t0 = (size_t)b * SEQ + (size_t)ch * 64;
    LAS unsigned char* qs = c.lds;
    LAS unsigned char* qis = c.lds + 9216;
    LAS unsigned char* ks = c.lds + 18432;
    LAS unsigned char* vT = c.lds + 27648;
    LAS float* T_bm = (LAS float*)(c.lds + 46080);
    LAS float* T_g = T_bm + 64;
    LAS float* T_em = T_bm + 128;
    LAS float* T_np = T_bm + 192;
    LAS float* T_ri = T_bm + 256;
    LAS float* hbuf = (LAS float*)(c.lds + 47616);
    const bf16* z = (const bf16*)(c.a.ws + WS_Z); bf16* hc = (bf16*)(c.a.ws + WS_HCAT);
    const ChunkGates g = chunk_gates(c, t0, h);
    const float mprev = ((const float*)(c.a.ws + WS_MPREV))[u];
    const float gg = g.ig - g.bcum; const float pm = wave_incl_max(gg, c.lane);
    const float mrow = g.bcum + fmaxf(mprev, pm); const float inter = __expf(g.bcum + mprev - mrow);
    if (c.wave == 0) { T_bm[c.lane] = g.bcum - mrow; T_g[c.lane] = gg; T_em[c.lane] = __expf(-mrow); T_np[c.lane] = ((const float*)(c.a.ws + WS_NLOC))[(size_t)u * 64 + c.lane]; }
    { const int lp = c.tid >> 3, c8 = c.tid & 7; float qc[8], kc[8]; const bf16* zr = z + (t0 + lp) * ZW;
      conv8(c, l, zr, ch * 64 + lp, Z_QM + h * 64 + c8 * 8, h * 64 + c8 * 8, 0.125f, qc);
      conv8(c, l, zr, ch * 64 + lp, Z_KM + h * 64 + c8 * 8, 256 + h * 64 + c8 * 8, 1.f, kc);
      const float il = __shfl(inter, lp);
      u32x4 w; w.x = cvtpk(qc[0], qc[1]); w.y = cvtpk(qc[2], qc[3]); w.z = cvtpk(qc[4], qc[5]); w.w = cvtpk(qc[6], qc[7]); *(LAS u32x4*)(qs + lp * 144 + c8 * 16) = w;
      w.x = cvtpk(qc[0] * il, qc[1] * il); w.y = cvtpk(qc[2] * il, qc[3] * il); w.z = cvtpk(qc[4] * il, qc[5] * il); w.w = cvtpk(qc[6] * il, qc[7] * il); *(LAS u32x4*)(qis + lp * 144 + c8 * 16) = w;
      w.x = cvtpk(kc[0], kc[1]); w.y = cvtpk(kc[2], kc[3]); w.z = cvtpk(kc[4], kc[5]); w.w = cvtpk(kc[6], kc[7]); *(LAS u32x4*)(ks + lp * 144 + c8 * 16) = w; }
#pragma unroll
    for (int it = 0; it < 2; ++it) { const int idx = c.tid + NT * it, lp = idx >> 4, c16 = idx & 15; const u32x4 vv = *(const u32x4*)(z + (t0 + lp) * ZW + Z_VM + h * 128 + c16 * 8);
        LAS unsigned short* d = (LAS unsigned short*)(vT + (c16 * 8) * 144 + lp * 2);
        d[0] = (unsigned short)(vv.x & 0xffffu); d[72] = (unsigned short)(vv.x >> 16); d[2 * 72] = (unsigned short)(vv.y & 0xffffu); d[3 * 72] = (unsigned short)(vv.y >> 16);
        d[4 * 72] = (unsigned short)(vv.z & 0xffffu); d[5 * 72] = (unsigned short)(vv.z >> 16); d[6 * 72] = (unsigned short)(vv.w & 0xffffu); d[7 * 72] = (unsigned short)(vv.w >> 16); }
    __syncthreads();
    const int r = c.lane & 31, hh = c.lane >> 5, lt = c.wave >> 2, dt = c.wave & 3;
    f32x16 acc = {0.f, 0.f, 0.f, 0.f, 0.f, 0.f, 0.f, 0.f, 0.f, 0.f, 0.f, 0.f, 0.f, 0.f, 0.f, 0.f};
    float den = 0.f;
    const float bm = T_bm[32 * lt + r];
#pragma unroll
    for (int st = 0; st < 2; ++st) { if (st <= lt) {
        f32x16 X = {0.f, 0.f, 0.f, 0.f, 0.f, 0.f, 0.f, 0.f, 0.f, 0.f, 0.f, 0.f, 0.f, 0.f, 0.f, 0.f};
#pragma unroll
        for (int kk = 0; kk < 4; ++kk) { const bf16x8 af = *(const LAS bf16x8*)(ks + (32 * st + r) * 144 + 32 * kk + 16 * hh), bfr = *(const LAS bf16x8*)(qs + (32 * lt + r) * 144 + 32 * kk + 16 * hh); X = MFMA32(af, bfr, X); }
#pragma unroll
        for (int i = 0; i < 16; ++i) { const int s = 32 * st + crow(i, hh); const float wgt = (s <= 32 * lt + r) ? __expf(bm + T_g[s]) : 0.f; X[i] *= wgt; den += X[i]; }
        const bf16x8 p0 = pack_step<0>(X), p1 = pack_step<1>(X);
        const LAS unsigned char* v0 = vT + (32 * dt + r) * 144 + (32 * st + 4 * hh) * 2;
        { const u32x2 lo = *(const LAS u32x2*)(v0), hi = *(const LAS u32x2*)(v0 + 16); const u32x4 w = {lo.x, lo.y, hi.x, hi.y}; acc = MFMA32(p0, __builtin_bit_cast(bf16x8, w), acc); }
        { const u32x2 lo = *(const LAS u32x2*)(v0 + 32), hi = *(const LAS u32x2*)(v0 + 48); const u32x4 w = {lo.x, lo.y, hi.x, hi.y}; acc = MFMA32(p1, __builtin_bit_cast(bf16x8, w), acc); } } }
    { const float* CP = (const float*)(c.a.ws + WS_XA) + (size_t)u * 8192 + (size_t)(32 * dt + r) * 64 + 8 * hh;
#pragma unroll
      for (int kk = 0; kk < 4; ++kk) { const f32x4 c0 = *(const f32x4*)(CP + 16 * kk), c1 = *(const f32x4*)(CP + 16 * kk + 4);
          u32x4 w; w.x = cvtpk(c0.x, c0.y); w.y = cvtpk(c0.z, c0.w); w.z = cvtpk(c1.x, c1.y); w.w = cvtpk(c1.z, c1.w);
          const bf16x8 af = *(const LAS bf16x8*)(qis + (32 * lt + r) * 144 + 32 * kk + 16 * hh); acc = MFMA32(af, __builtin_bit_cast(bf16x8, w), acc); } }
    { const LAS unsigned char* qr = qis + (32 * lt + r) * 144 + 64 * hh;
#pragma unroll
      for (int q4 = 0; q4 < 4; ++q4) { float qv[8]; unpack8_(*(const LAS u32x4*)(qr + 16 * q4), qv);
#pragma unroll
          for (int i = 0; i < 8; ++i) den += qv[i] * T_np[32 * hh + 8 * q4 + i]; } }
    den += __shfl_xor(den, 32);
    if (hh == 0) T_ri[32 * lt + r] = 1.f / fmaxf(fabsf(den), T_em[32 * lt + r]);
    asm volatile("s_waitcnt lgkmcnt(0)" ::: "memory");
#pragma unroll
    for (int i = 0; i < 16; ++i) { const int lr = 32 * lt + crow(i, hh); hbuf[lr * 132 + 32 * dt + r] = acc[i] * T_ri[lr]; }
    __syncthreads();
    { const int lp = c.tid >> 3, part = c.tid & 7; const LAS float* hr = hbuf + lp * 132 + part * 16; float hv[16]; float ss = 0.f;
#pragma unroll
      for (int q4 = 0; q4 < 4; ++q4) { const f32x4 v = *(const LAS f32x4*)(hr + 4 * q4); hv[4 * q4] = v.x; hv[4 * q4 + 1] = v.y; hv[4 * q4 + 2] = v.z; hv[4 * q4 + 3] = v.w; ss += (v.x * v.x + v.y * v.y) + (v.z * v.z + v.w * v.w); }
      ss += __shfl_xor(ss, 1); ss += __shfl_xor(ss, 2); ss += __shfl_xor(ss, 4);
      const float rstd = rsqrtf(ss * (1.f / 128.f) + EPS);
      const int col = h * 128 + part * 16; const float* wm = c.a.in[I_WMN] + l * 512 + col;
      const bf16* og = z + (t0 + lp) * ZW + Z_OM + col; bf16* op = hc + (t0 + lp) * D + col;
#pragma unroll
      for (int q8 = 0; q8 < 2; ++q8) { float o8[8]; unpack8_(*(const u32x4*)(og + 8 * q8), o8); const f32x4 w0 = *(const f32x4*)(wm + 8 * q8), w1 = *(const f32x4*)(wm + 8 * q8 + 4);
          const float wv[8] = {w0.x, w0.y, w0.z, w0.w, w1.x, w1.y, w1.z, w1.w}; float ov[8];
#pragma unroll
          for (int i = 0; i < 8; ++i) ov[i] = hv[8 * q8 + i] * rstd * wv[i] * sigmoidf_(o8[i]);
          u32x4 w; w.x = cvtpk(ov[0], ov[1]); w.y = cvtpk(ov[2], ov[3]); w.z = cvtpk(ov[4], ov[5]); w.w = cvtpk(ov[6], ov[7]); *(u32x4*)(op + 8 * q8) = w; } }
    __syncthreads();
}

#ifndef OPT_SWA
#define OPT_SWA 1
#endif
#ifndef OPT_MLSTM
#define OPT_MLSTM 1
#endif
__device__ __forceinline__ void phase_mix1_opt(const Ctx& c, int l) {
    if (OPT_SWA) { for (int u = c.bid; u < NB * AKV * 32; u += c.G) swa_unit(c, l, u); } else naive_swa(c, l, 0);
    if (OPT_MLSTM) { for (int u = c.bid * 4; u < NB * MH * 64; u += c.G * 4) for (int k = 0; k < 4; ++k) mlstm_local_unit(c, l, u + k); }
    else if (c.bid < 16) naive_mlstm(c, l, c.bid);
}
__device__ __forceinline__ void phase_mix2_opt(const Ctx& c, int l) {
    if (OPT_MLSTM) { for (int u = c.bid * 4; u < NB * MH * 64; u += c.G * 4) for (int k = 0; k < 4; ++k) mlstm_out_unit(c, l, u + k); }
    else phase_mix2(c, l);
}

#define XB_TMO      128
#define XB_XCNT(j)  (256  + 64 * (j))
#define XB_XSUB(j)  (1280 + 64 * (j))
#define XB_XGEN(j)  (2304 + 64 * (j))
#define XB_TOP      3328
#define XB_TOPGEN   3392
#define XCD_BAR_WORDS 3456
#define XB_SPIN_CAP (1u << 22)
constexpr int CW_BAR = 8192;
__device__ __forceinline__ unsigned xb_ld(unsigned* p)              { return __hip_atomic_load(p, __ATOMIC_RELAXED, __HIP_MEMORY_SCOPE_AGENT); }
__device__ __forceinline__ unsigned xb_add(unsigned* p, unsigned v) { return __hip_atomic_fetch_add(p, v, __ATOMIC_RELAXED, __HIP_MEMORY_SCOPE_AGENT); }
__device__ __forceinline__ unsigned xb_xcc_id() { return (unsigned)__builtin_amdgcn_s_getreg((3 << 11) | 20) & 0xFu; }
#define XB_SPIN(cond, bar) do { unsigned _sp = 0; while (cond) { __builtin_amdgcn_s_sleep(1); \
    if ((++_sp & 255u) == 0u) { if (xb_ld(&(bar)[XB_TMO])) break; if (_sp > XB_SPIN_CAP) { atomicAdd(&(bar)[XB_TMO], 1u); break; } } } } while (0)
struct XcdBarrier { unsigned* bar; unsigned x; volatile LAS unsigned* st; };
__device__ __forceinline__ XcdBarrier xcd_barrier_post(unsigned* bar, volatile LAS unsigned* st) {
    XcdBarrier b; b.bar = bar; b.x = xb_xcc_id(); b.st = st;
    if (threadIdx.x == 0) { (void)xb_add(&bar[XB_XCNT(b.x)], 1u); st[2] = b.x; }
    return b;
}
__device__ __forceinline__ void xcd_barrier_complete(unsigned* bar, unsigned x, unsigned& nloc, unsigned& nx) {
    const unsigned G = gridDim.x * gridDim.y * gridDim.z;
    unsigned sum, cnt, mine, sp = 0u;
    for (;;) {
        sum = 0u; cnt = 0u; mine = 0u;
#pragma unroll
        for (unsigned j = 0; j < 16; ++j) { const unsigned c = xb_ld(&bar[XB_XCNT(j)]); sum += c; cnt += (c > 0u) ? 1u : 0u; mine = (j == x) ? c : mine; }
        if (sum == G) break;
        __builtin_amdgcn_s_sleep(1);
        if ((++sp & 255u) == 0u) { if (xb_ld(&bar[XB_TMO])) break; if (sp > XB_SPIN_CAP) { atomicAdd(&bar[XB_TMO], 1u); break; } }
    }
    nloc = mine > 0u ? mine : 1u; nx = cnt > 0u ? cnt : 1u;
}
__device__ __forceinline__ void xcd_barrier(const XcdBarrier& b) {
    asm volatile("s_waitcnt vmcnt(0)" ::: "memory");
    __syncthreads();
    if (threadIdx.x == 0) {
        unsigned* bar = b.bar;
        __builtin_amdgcn_s_waitcnt(0);
        unsigned nloc = b.st[0], nx = b.st[1]; const unsigned bx = b.st[2];
        if (nloc == 0u) { xcd_barrier_complete(bar, bx, nloc, nx); b.st[0] = nloc; b.st[1] = nx; }
        const unsigned old = xb_add(&bar[XB_XSUB(bx)], 1u);
        const unsigned gen = old / nloc;
        if (old + 1u == (gen + 1u) * nloc) {
            __builtin_amdgcn_fence(__ATOMIC_RELEASE, "agent");
            asm volatile("s_waitcnt vmcnt(0)" ::: "memory");
            const unsigned og = xb_add(&bar[XB_TOP], 1u);
            const unsigned tg = og / nx;
            if (og + 1u == (tg + 1u) * nx) xb_add(&bar[XB_TOPGEN], 1u);
            else XB_SPIN(xb_ld(&bar[XB_TOPGEN]) == tg, bar);
            __builtin_amdgcn_fence(__ATOMIC_ACQUIRE, "agent");
            xb_add(&bar[XB_XGEN(bx)], 1u);
            asm volatile("s_waitcnt vmcnt(0)" ::: "memory");
        } else {
            XB_SPIN(xb_ld(&bar[XB_XGEN(bx)]) == gen, bar);
            __builtin_amdgcn_fence(__ATOMIC_ACQUIRE, "agent");
            asm volatile("s_waitcnt vmcnt(0)" ::: "memory");
        }
    }
    __syncthreads();
}

constexpr int MISC_OFF = 143360 + 320;
#ifndef MK_MULTI
#define MK_MULTI 0
#endif
constexpr int PH_PER_LAYER = 11, NPHASES = 1 + DEPTH * PH_PER_LAYER;
__device__ __forceinline__ void run_phase(const Ctx& c, int l, int p) {
    switch (p) {
        case 0: phase_xn(c, l); break;
        case 1: phase_inproj(c, l); break;
        case 2: phase_mix1(c, l); break;
        case 3: phase_mix2(c, l); break;
        case 4: phase_br(c, l); break;
        case 5: phase_out(c, l); break;
        case 6: phase_route(c, l); break;
        case 7: phase_fill(c, l); break;
        case 8: phase_g1(c, l); break;
        case 9: phase_g2(c, l); break;
        case 10: phase_combine(c, l); break;
    }
}
__global__ void __launch_bounds__(NT, 2) mega(Args a) {
    extern __shared__ __attribute__((aligned(16))) unsigned char lds_raw[];
    Ctx c; c.a = a; c.lds = (LAS unsigned char*)lds_raw; c.tid = threadIdx.x; c.lane = c.tid & 63; c.wave = __builtin_amdgcn_readfirstlane(c.tid >> 6); c.G = gridDim.x; c.bid = blockIdx.x;
#if MK_MULTI
    { const int ph = a.ph_lo; if (ph == 0) { phase_prologue(c); return; } run_phase(c, (ph - 1) / PH_PER_LAYER, (ph - 1) % PH_PER_LAYER); }
#else
    volatile LAS unsigned* MISC = (volatile LAS unsigned*)(c.lds + MISC_OFF);
    if (c.tid < 32) MISC[c.tid] = 0u;
    __syncthreads();
    const XcdBarrier bar = xcd_barrier_post(c.ctl() + CW_BAR, MISC + 8);
#define PH(call) do { Ctx f = c; asm volatile("" : "+v"(f.tid)); f.lane = f.tid & 63; f.wave = __builtin_amdgcn_readfirstlane(f.tid >> 6); { const Ctx& c = f; call; } } while (0)
    PH(phase_prologue(c)); xcd_barrier(bar);
#pragma unroll 1
    for (int l = 0; l < DEPTH; ++l) {
        PH(phase_xn(c, l)); xcd_barrier(bar);
        if (OPT_GEMM) PH(phase_inproj_opt(c, l)); else PH(phase_inproj(c, l)); xcd_barrier(bar);
        if (OPT_MIX) { PH(phase_mix1_opt(c, l)); xcd_barrier(bar); if (OPT_MLSTM) { PH(phase_scan(c)); xcd_barrier(bar); } PH(phase_mix2_opt(c, l)); xcd_barrier(bar); }
        else { PH(phase_mix1(c, l)); xcd_barrier(bar); PH(phase_mix2(c, l)); xcd_barrier(bar); }
        if (OPT_GEMM) PH(phase_br_opt(c, l)); else PH(phase_br(c, l)); xcd_barrier(bar);
        if (OPT_GEMM) PH(phase_out_opt(c, l)); else PH(phase_out(c, l)); xcd_barrier(bar);
        PH(phase_route(c, l)); xcd_barrier(bar);
        PH(phase_fill(c, l)); xcd_barrier(bar);
        if (OPT_GEMM) PH(phase_g1_opt(c, l)); else PH(phase_g1(c, l)); xcd_barrier(bar);
        if (OPT_GEMM) PH(phase_g2_opt(c, l)); else PH(phase_g2(c, l)); xcd_barrier(bar);
        PH(phase_combine(c, l)); if (l + 1 < DEPTH) xcd_barrier(bar);
    }
#undef PH
#endif
}

extern "C" void kernel_launch(void* const* d_in, const int* in_sizes, int n_in, void* d_out, int out_size, void* d_ws, size_t ws_size, hipStream_t stream) {
    static int grid = 0;
    if (grid == 0) {
        if (n_in != 23 || out_size != T * D || ws_size < WS_END) { fprintf(stderr, "kernel_launch: unexpected shapes (n_in %d out %d ws %zu need %zu)\n", n_in, out_size, ws_size, (size_t)WS_END); grid = -1; return; }
        int dev = 0, cus = 0, per_cu = 0;
        if (hipGetDevice(&dev) != hipSuccess || hipDeviceGetAttribute(&cus, hipDeviceAttributeMultiprocessorCount, dev) != hipSuccess) { grid = -1; return; }
        if (hipFuncSetAttribute((const void*)mega, hipFuncAttributeMaxDynamicSharedMemorySize, LDS_BYTES) != hipSuccess) { grid = -1; return; }
        if (hipOccupancyMaxActiveBlocksPerMultiprocessor(&per_cu, (const void*)mega, NT, LDS_BYTES) != hipSuccess || per_cu < 1) { fprintf(stderr, "kernel_launch: occupancy query says %d blocks per CU\n", per_cu); (void)hipGetLastError(); grid = -1; return; }
        grid = cus;
    }
    if (grid < 0) return;
    (void)hipMemsetAsync((char*)d_ws + WS_CTL, 0, CTL_BYTES, stream);
    Args a{};
    for (int i = 0; i < 23; ++i) a.in[i] = (const float*)d_in[i];
    a.out = (float*)d_out; a.ws = (unsigned char*)d_ws;
#if MK_MULTI
    for (int ph = 0; ph < NPHASES; ++ph) { a.ph_lo = ph; a.ph_hi = ph + 1; hipLaunchKernelGGL(mega, dim3(grid), dim3(NT), LDS_BYTES, stream, a); }
#else
    a.ph_lo = 0; a.ph_hi = NPHASES;
    hipLaunchKernelGGL(mega, dim3(grid), dim3(NT), LDS_BYTES, stream, a);
#endif
}
```

```cpp
#include <hip/hip_runtime.h>
#include <cstdio>
#include <cstdint>

constexpr int NB = 4, SEQ = 4096, T = NB * SEQ, D = 1024, DEPTH = 2;
constexpr int MH = 4, DQK = 64, DV = 128;
constexpr int AH = 8, AKV = 2, AD = 64;
constexpr int NE = 16, DE = 512;
constexpr int D_IN = 4360, ZW = 4352;
constexpr int Z_QM = 0, Z_KM = 256, Z_VM = 512, Z_OM = 1024, Z_QA = 1536, Z_KA = 2048, Z_VA = 2176, Z_GM = 2304, Z_GA = 3328;
constexpr float EPS = 1e-6f;
constexpr int MOE_ROWS = 2 * T + NE * 256;

constexpr size_t MiB = 1u << 20;
constexpr size_t WS_CTL = 0, CTL_BYTES = 1 * MiB;
constexpr size_t WS_MOD = 1 * MiB;
constexpr size_t WS_IFG = WS_MOD + 256 * 1024;
constexpr size_t WS_RIDX = WS_IFG + 512 * 1024;
constexpr size_t WS_RW = WS_RIDX + 128 * 1024;
constexpr size_t WS_SLOT = WS_RW + 128 * 1024;
constexpr size_t WS_ROWTOK = WS_SLOT + 128 * 1024;
constexpr size_t WS_RANK = WS_ROWTOK + 256 * 1024;
constexpr size_t WS_WGCNT = WS_RANK + 128 * 1024;
constexpr size_t WS_SMALL_END = WS_WGCNT + 32 * 1024;
static_assert(WS_SMALL_END <= 3 * MiB, "small region");
constexpr size_t WS_W = 4 * MiB;
constexpr size_t W_IN = 0;
constexpr size_t W_BR = W_IN + (size_t)ZW * D * 2;
constexpr size_t W_OUT = W_BR + (size_t)D * D * 2;
constexpr size_t W_GU = W_OUT + (size_t)D * D * 2;
constexpr size_t W_DN = W_GU + (size_t)NE * 1024 * D * 2;
constexpr size_t LAYER_W = W_DN + (size_t)NE * D * DE * 2;
constexpr size_t WS_Z = WS_W + 2 * LAYER_W;
constexpr size_t WS_ACT = WS_Z;
constexpr size_t WS_Y = WS_ACT + (size_t)MOE_ROWS * DE * 2;
constexpr size_t WS_XA = WS_Z + (size_t)T * ZW * 2;
constexpr size_t WS_HCAT = WS_XA + (size_t)T * D * 2;
constexpr size_t WS_END = WS_HCAT + (size_t)T * D * 2;
static_assert(WS_Y + (size_t)MOE_ROWS * D * 2 <= WS_XA, "MoE overlay fits in z");
constexpr int CW_CNT = 1024;
constexpr int CW_CUR = 2048;

typedef unsigned short bf16;
typedef float f32x4 __attribute__((ext_vector_type(4)));
typedef unsigned u32x4 __attribute__((ext_vector_type(4)));
typedef unsigned u32x2 __attribute__((ext_vector_type(2)));
#define LAS __attribute__((address_space(3)))

__device__ __forceinline__ unsigned f2bf(float f) { unsigned u = __builtin_bit_cast(unsigned, f); return (u + 0x7fffu + ((u >> 16) & 1u)) >> 16; }
__device__ __forceinline__ unsigned pk2(float lo, float hi) { return f2bf(lo) | (f2bf(hi) << 16); }
__device__ __forceinline__ float bf2f(unsigned b) { return __builtin_bit_cast(float, b << 16); }
__device__ __forceinline__ float bflo(unsigned w) { return __builtin_bit_cast(float, w << 16); }
__device__ __forceinline__ float bfhi(unsigned w) { return __builtin_bit_cast(float, w & 0xffff0000u); }
__device__ __forceinline__ float sigmoidf_(float x) { return 1.f / (1.f + __expf(-x)); }
__device__ __forceinline__ float siluf_(float x) { return x / (1.f + __expf(-x)); }
__device__ __forceinline__ float wave_sum(float v) {
#pragma unroll
    for (int o = 1; o < 64; o <<= 1) v += __shfl_xor(v, o);
    return v;
}

__device__ const unsigned char T5_BUCKET[128] = {0,1,2,3,4,5,6,7,8,9,10,11,12,13,14,15,16,16,16,17,17,18,18,18,19,19,19,20,20,20,20,21,21,21,21,22,22,22,22,22,23,23,23,23,23,23,24,24,24,24,24,24,25,25,25,25,25,25,25,26,26,26,26,26,26,26,26,27,27,27,27,27,27,27,27,27,27,28,28,28,28,28,28,28,28,28,28,29,29,29,29,29,29,29,29,29,29,29,29,30,30,30,30,30,30,30,30,30,30,30,30,30,30,31,31,31,31,31,31,31,31,31,31,31,31,31,31,31};

struct Args {
    const float* in[23];
    float* out; unsigned char* ws;
    int ph_lo, ph_hi;
};
enum { I_X = 0, I_C, I_WADA, I_BADA, I_WN1, I_WIN, I_CONVW, I_CONVB, I_BIG, I_BFG, I_WMN, I_SINK, I_RELB, I_WBRM, I_WBRA, I_WOUT, I_WN2, I_WR, I_RB, I_WG, I_WU, I_WD, I_WF };

constexpr int NT = 512, NWAVES = 8;
constexpr int LDS_BYTES = 147456;

struct Ctx {
    Args a; LAS unsigned char* lds; int tid, lane, wave, G, bid;
    __device__ __forceinline__ unsigned* ctl() const { return (unsigned*)(a.ws + WS_CTL); }
    __device__ __forceinline__ float* mod(int l) const { return (float*)(a.ws + WS_MOD) + (size_t)l * 4 * 6144; }
    __device__ __forceinline__ unsigned char* wl(int l) const { return a.ws + WS_W + (size_t)l * LAYER_W; }
};

__device__ __forceinline__ void conv_tile(const float* src, int ldsrc, int k0, int n_src0, bf16* dst, int ldd, int dst_row0, LAS float* scr, int lane) {
#pragma unroll 4
    for (int i = 0; i < 16; ++i) { const int kk = 4 * i + (lane >> 4); const f32x4 v = *(const f32x4*)(src + (size_t)(k0 + kk) * ldsrc + n_src0 + 4 * (lane & 15));
        LAS float* p = scr + kk * 65 + 4 * (lane & 15); p[0] = v.x; p[1] = v.y; p[2] = v.z; p[3] = v.w; }
    asm volatile("s_waitcnt lgkmcnt(0)" ::: "memory");
    const int c = lane & 7;
#pragma unroll
    for (int j = 0; j < 8; ++j) { const int n = (lane >> 3) + 8 * j; const LAS float* s = scr + (8 * c) * 65 + n;
        u32x4 o; o.x = pk2(s[0], s[65]); o.y = pk2(s[2 * 65], s[3 * 65]); o.z = pk2(s[4 * 65], s[5 * 65]); o.w = pk2(s[6 * 65], s[7 * 65]);
        *(u32x4*)(dst + (size_t)(dst_row0 + n) * ldd + k0 + 8 * c) = o; }
    asm volatile("s_waitcnt lgkmcnt(0)" ::: "memory");
}

__device__ __forceinline__ void phase_prologue(const Ctx& c) {
    {
        LAS float* cond = (LAS float*)c.lds;
        LAS float* red = cond + 4096;
        for (int item = c.bid; item < 192; item += c.G) {
            __syncthreads();
            for (int i = c.tid; i < 4096; i += NT) cond[i] = siluf_(c.a.in[I_C][i]);
            __syncthreads();
            const int l = item / 96, col = (item % 96) * 64 + c.lane;
            const float* w = c.a.in[I_WADA] + (size_t)l * D * 6144 + col;
            float acc[4] = {0.f, 0.f, 0.f, 0.f};
            for (int k = c.wave * 128; k < c.wave * 128 + 128; ++k) { const float wv = w[(size_t)k * 6144];
#pragma unroll
                for (int b = 0; b < 4; ++b) acc[b] += cond[b * 1024 + k] * wv; }
#pragma unroll
            for (int b = 0; b < 4; ++b) red[(c.wave * 4 + b) * 64 + c.lane] = acc[b];
            __syncthreads();
            if (c.tid < 256) { const int b = c.tid >> 6, ln = c.tid & 63; float s = 0.f;
#pragma unroll
                for (int wv = 0; wv < 8; ++wv) s += red[(wv * 4 + b) * 64 + ln];
                const int cc = (item % 96) * 64 + ln;
                c.mod(l)[b * 6144 + cc] = s + c.a.in[I_BADA][l * 6144 + cc]; }
        }
        __syncthreads();
    }
    {
        LAS float* scr = (LAS float*)c.lds + c.wave * (64 * 65 + 64);
        const int gw = c.bid * NWAVES + c.wave, NGW = c.G * NWAVES;
        constexpr int I_IN = 16 * 68, I_BRM = 8 * 16, I_BRA = 8 * 16, I_OUT = 16 * 16, I_GU1 = 16 * 8, I_DN1 = 8 * 16;
        constexpr int PER_LAYER = I_IN + I_BRM + I_BRA + I_OUT + NE * 2 * I_GU1 + NE * I_DN1;
        for (int it = gw; it < 2 * PER_LAYER; it += NGW) {
            const int l = it / PER_LAYER; int r = it % PER_LAYER; unsigned char* wl = c.wl(l);
            if (r < I_IN) { const int kb = r / 68, nb = r % 68; const int n0 = nb * 64; const int ns = n0 < 1536 ? n0 : n0 + 8;
                conv_tile(c.a.in[I_WIN] + (size_t)l * D * D_IN, D_IN, kb * 64, ns, (bf16*)(wl + W_IN), D, n0, scr, c.lane); continue; } r -= I_IN;
            if (r < I_BRM) { const int kb = r / 16, nb = r % 16;
                conv_tile(c.a.in[I_WBRM] + (size_t)l * 512 * D, D, kb * 64, nb * 64, (bf16*)(wl + W_BR), D, nb * 64, scr, c.lane); continue; } r -= I_BRM;
            if (r < I_BRA) { const int kb = r / 16, nb = r % 16;
                conv_tile(c.a.in[I_WBRA] + (size_t)l * 512 * D, D, kb * 64, nb * 64, (bf16*)(wl + W_BR) + 512, D, nb * 64, scr, c.lane); continue; } r -= I_BRA;
            if (r < I_OUT) { const int kb = r / 16, nb = r % 16;
                conv_tile(c.a.in[I_WOUT] + (size_t)l * D * D, D, kb * 64, nb * 64, (bf16*)(wl + W_OUT), D, nb * 64, scr, c.lane); continue; } r -= I_OUT;
            if (r < NE * 2 * I_GU1) { const int e = r / (2 * I_GU1); int q = r % (2 * I_GU1); const int up = q / I_GU1; q %= I_GU1; const int kb = q / 8, nb = q % 8;
                const float* src = (up ? c.a.in[I_WU] : c.a.in[I_WG]) + ((size_t)l * NE + e) * D * DE;
                const int j0 = nb * 64; const int drow = (j0 / 128) * 256 + up * 128 + (j0 % 128);
                conv_tile(src, DE, kb * 64, j0, (bf16*)(wl + W_GU) + (size_t)e * 1024 * D, D, drow, scr, c.lane); continue; } r -= NE * 2 * I_GU1;
            { const int e = r / I_DN1; const int q = r % I_DN1; const int kb = q / 16, nb = q % 16;
                conv_tile(c.a.in[I_WD] + ((size_t)l * NE + e) * DE * D, D, kb * 64, nb * 64, (bf16*)(wl + W_DN) + (size_t)e * D * DE, DE, nb * 64, scr, c.lane); }
        }
    }
}

__device__ __forceinline__ void phase_xn(const Ctx& c, int l) {
    LAS float* w8 = (LAS float*)c.lds;
    const float* win = c.a.in[I_WIN] + (size_t)l * D * D_IN;
    for (int i = c.tid; i < 8192; i += NT) { const int k = i >> 3, j = i & 7; w8[j * 1024 + k] = win[(size_t)k * D_IN + 1536 + j]; }
    __syncthreads();
    const float* xs = (l == 0) ? c.a.in[I_X] : c.a.out;
    const float* wn = c.a.in[I_WN1] + l * D; const float* mod = c.mod(l);
    bf16* XN = (bf16*)(c.a.ws + WS_XA); float* IFG = (float*)(c.a.ws + WS_IFG);
    const int gw = c.bid * NWAVES + c.wave, NGW = c.G * NWAVES;
    for (int m = gw; m < T; m += NGW) {
        const int b = m / SEQ; const f32x4* xr = (const f32x4*)(xs + (size_t)m * D) + c.lane;
        f32x4 v[4]; float s = 0.f;
#pragma unroll
        for (int j = 0; j < 4; ++j) { v[j] = xr[64 * j]; s += (v[j].x * v[j].x + v[j].y * v[j].y) + (v[j].z * v[j].z + v[j].w * v[j].w); }
        const float rstd = rsqrtf(wave_sum(s) * (1.f / D) + EPS);
        float g[8] = {0.f, 0.f, 0.f, 0.f, 0.f, 0.f, 0.f, 0.f};
        u32x2* o8 = (u32x2*)(XN + (size_t)m * D) + c.lane;
#pragma unroll
        for (int j = 0; j < 4; ++j) { const int col = 256 * j + 4 * c.lane;
            const f32x4 w = *(const f32x4*)(wn + col), sh = *(const f32x4*)(mod + b * 6144 + col), sc = *(const f32x4*)(mod + b * 6144 + 1024 + col);
            v[j] = (v[j] * rstd * w) * (sc + 1.f) + sh;
            u32x2 o; o.x = pk2(v[j].x, v[j].y); o.y = pk2(v[j].z, v[j].w); o8[64 * j] = o; }
#pragma unroll
        for (int q = 0; q < 8; ++q) {
#pragma unroll
            for (int j = 0; j < 4; ++j) { const f32x4 ww = *(const LAS f32x4*)(w8 + q * 1024 + 256 * j + 4 * c.lane); g[q] += (v[j].x * ww.x + v[j].y * ww.y) + (v[j].z * ww.z + v[j].w * ww.w); }
            asm volatile("" ::: "memory"); }
#pragma unroll
        for (int q = 0; q < 8; ++q) g[q] = wave_sum(g[q]);
        if (c.lane < 8) { float val = 0.f;
#pragma unroll
            for (int q = 0; q < 8; ++q) val = (c.lane == q) ? g[q] : val;
            const float bias = (c.lane < 4) ? c.a.in[I_BIG][l * 4 + c.lane] : c.a.in[I_BFG][l * 4 + c.lane - 4];
            IFG[(size_t)m * 8 + c.lane] = val + bias; }
    }
}

template <class RowA, class RowB0, class RowB1, class Epi>
__device__ __forceinline__ void naive_gemm_tile(const Ctx& c, int m0, int n0, int K0, int K1, const RowA& ra, const RowA& ra1, const RowB0& rb0, const RowB1& rb1, const Epi& epi) {
    LAS float* As = (LAS float*)c.lds;
    LAS float* Bs = As + 32 * 132;
    const int ty = c.tid >> 4, tx = c.tid & 15;
    f32x4 acc[2][4];
#pragma unroll
    for (int p = 0; p < 2; ++p)
#pragma unroll
        for (int i = 0; i < 4; ++i) acc[p][i] = (f32x4){0.f, 0.f, 0.f, 0.f};
#pragma unroll
    for (int p = 0; p < 2; ++p) {
        const int K = p ? K1 : K0;
        const int ar = c.tid >> 2, akc = c.tid & 3;
        const bf16* arow = p ? ra1(m0 + ar) : ra(m0 + ar);
        const int br = (c.tid & 255) >> 2, bkc = c.tid & 3;
        const bf16* brow = p ? rb1(n0 + br) : rb0(n0 + br);
        for (int k0 = 0; k0 < K; k0 += 32) {
            __syncthreads();
            { const u32x4 v = *(const u32x4*)(arow + k0 + 8 * akc); LAS float* d = As + (8 * akc) * 132 + ar;
              d[0] = bflo(v.x); d[132] = bfhi(v.x); d[2 * 132] = bflo(v.y); d[3 * 132] = bfhi(v.y); d[4 * 132] = bflo(v.z); d[5 * 132] = bfhi(v.z); d[6 * 132] = bflo(v.w); d[7 * 132] = bfhi(v.w); }
            if (c.tid < 256) { const u32x4 v = *(const u32x4*)(brow + k0 + 8 * bkc); LAS float* d = Bs + (8 * bkc) * 68 + br;
              d[0] = bflo(v.x); d[68] = bfhi(v.x); d[2 * 68] = bflo(v.y); d[3 * 68] = bfhi(v.y); d[4 * 68] = bflo(v.z); d[5 * 68] = bfhi(v.z); d[6 * 68] = bflo(v.w); d[7 * 68] = bfhi(v.w); }
            __syncthreads();
#pragma unroll 8
            for (int k = 0; k < 32; ++k) { const f32x4 av = *(const LAS f32x4*)(As + k * 132 + 4 * ty), bv = *(const LAS f32x4*)(Bs + k * 68 + 4 * tx);
                acc[p][0] += av.x * bv; acc[p][1] += av.y * bv; acc[p][2] += av.z * bv; acc[p][3] += av.w * bv; }
        }
    }
#pragma unroll
    for (int i = 0; i < 4; ++i) epi(m0 + 4 * ty + i, n0 + 4 * tx, acc[0][i], acc[1][i]);
}

struct RowPlain { const bf16* p; int ld; __device__ __forceinline__ const bf16* operator()(int r) const { return p + (size_t)r * ld; } };
struct RowGather { const bf16* p; int ld; const int* map; __device__ __forceinline__ const bf16* operator()(int r) const { return p + (size_t)map[r] * ld; } };
struct RowGU { const bf16* p; int up; __device__ __forceinline__ const bf16* operator()(int j) const { return p + (size_t)((j >> 7) * 256 + up * 128 + (j & 127)) * D; } };

struct EpiZ { bf16* z; __device__ __forceinline__ void operator()(int r, int cc, f32x4 a, f32x4) const { u32x2 o; o.x = pk2(a.x, a.y); o.y = pk2(a.z, a.w); *(u32x2*)(z + (size_t)r * ZW + cc) = o; } };
struct EpiBR { const bf16* z; bf16* mg; __device__ __forceinline__ void operator()(int r, int cc, f32x4 a, f32x4 b) const {
    const u32x2 gm = *(const u32x2*)(z + (size_t)r * ZW + Z_GM + cc), ga = *(const u32x2*)(z + (size_t)r * ZW + Z_GA + cc);
    const float m0 = sigmoidf_(bflo(gm.x)) * a.x + sigmoidf_(bflo(ga.x)) * b.x, m1 = sigmoidf_(bfhi(gm.x)) * a.y + sigmoidf_(bfhi(ga.x)) * b.y;
    const float m2 = sigmoidf_(bflo(gm.y)) * a.z + sigmoidf_(bflo(ga.y)) * b.z, m3 = sigmoidf_(bfhi(gm.y)) * a.w + sigmoidf_(bfhi(ga.y)) * b.w;
    u32x2 o; o.x = pk2(m0, m1); o.y = pk2(m2, m3); *(u32x2*)(mg + (size_t)r * D + cc) = o; } };
struct EpiOut { const float* xin; float* xout; const float* g1; __device__ __forceinline__ void operator()(int r, int cc, f32x4 a, f32x4) const {
    const int b = r / SEQ; const f32x4 g = *(const f32x4*)(g1 + b * 6144 + cc), xo = *(const f32x4*)(xin + (size_t)r * D + cc);
    *(f32x4*)(xout + (size_t)r * D + cc) = xo + g * a; } };
struct EpiAct { bf16* act; __device__ __forceinline__ void operator()(int r, int cc, f32x4 a, f32x4 b) const {
    u32x2 o; o.x = pk2(siluf_(a.x) * b.x, siluf_(a.y) * b.y); o.y = pk2(siluf_(a.z) * b.z, siluf_(a.w) * b.w); *(u32x2*)(act + (size_t)r * DE + cc) = o; } };
struct EpiY { bf16* y; __device__ __forceinline__ void operator()(int r, int cc, f32x4 a, f32x4) const { u32x2 o; o.x = pk2(a.x, a.y); o.y = pk2(a.z, a.w); *(u32x2*)(y + (size_t)r * D + cc) = o; } };

__device__ __forceinline__ void phase_inproj(const Ctx& c, int l) {
    const RowPlain ra{(const bf16*)(c.a.ws + WS_XA), D}, rb{(const bf16*)(c.wl(l) + W_IN), D}; const EpiZ e{(bf16*)(c.a.ws + WS_Z)};
    constexpr int NTN = ZW / 64, NTM = T / 128;
    for (int u = c.bid; u < NTN * NTM; u += c.G) naive_gemm_tile(c, (u / NTN) * 128, (u % NTN) * 64, D, 0, ra, ra, rb, rb, e);
}
__device__ __forceinline__ void phase_br(const Ctx& c, int l) {
    const bf16* hc = (const bf16*)(c.a.ws + WS_HCAT); const bf16* w = (const bf16*)(c.wl(l) + W_BR);
    const RowPlain ra{hc, D}, ra1{hc + 512, D}, rb0{w, D}, rb1{w + 512, D}; const EpiBR e{(const bf16*)(c.a.ws + WS_Z), (bf16*)(c.a.ws + WS_XA)};
    constexpr int NTN = D / 64, NTM = T / 128;
    for (int u = c.bid; u < NTN * NTM; u += c.G) naive_gemm_tile(c, (u / NTN) * 128, (u % NTN) * 64, 512, 512, ra, ra1, rb0, rb1, e);
}
__device__ __forceinline__ void phase_out(const Ctx& c, int l) {
    const RowPlain ra{(const bf16*)(c.a.ws + WS_XA), D}, rb{(const bf16*)(c.wl(l) + W_OUT), D};
    const EpiOut e{l == 0 ? c.a.in[I_X] : c.a.out, c.a.out, c.mod(l) + 2048};
    constexpr int NTN = D / 64, NTM = T / 128;
    for (int u = c.bid; u < NTN * NTM; u += c.G) naive_gemm_tile(c, (u / NTN) * 128, (u % NTN) * 64, D, 0, ra, ra, rb, rb, e);
}

__device__ __forceinline__ void naive_mlstm(const Ctx& c, int l, int bh) {
    const int b = bh >> 2, h = bh & 3, d = c.tid >> 2, eq = c.tid & 3, e0 = eq * 16;
    const bf16* z = (const bf16*)(c.a.ws + WS_Z); const float* IFG = (const float*)(c.a.ws + WS_IFG); float* HR = (float*)(c.a.ws + WS_XA);
    const float* cw = c.a.in[I_CONVW] + (size_t)l * 4 * 512; const float* cb = c.a.in[I_CONVB] + l * 512;
    float C[16], n[16], m = 0.f;
#pragma unroll
    for (int i = 0; i < 16; ++i) { C[i] = 0.f; n[i] = 0.f; }
    LAS float* cwl = (LAS float*)c.lds;
    for (int i = c.tid; i < 640; i += NT) { if (i < 512) { const int j = i >> 7, ch = i & 127; cwl[i] = cw[j * 512 + (ch < 64 ? h * 64 + ch : 256 + h * 64 + ch - 64)]; } else { const int ch = i - 512; cwl[i] = cb[ch < 64 ? h * 64 + ch : 256 + h * 64 + ch - 64]; } }
    __syncthreads();
    for (int s = 0; s < SEQ; ++s) {
        const size_t t = (size_t)b * SEQ + s;
        float q[16], k[16];
#pragma unroll
        for (int i = 0; i < 16; ++i) { q[i] = cwl[512 + e0 + i]; k[i] = cwl[512 + 64 + e0 + i]; }
#pragma unroll
        for (int j = 0; j < 4; ++j) { const int sj = s - 3 + j; if (sj >= 0) { const bf16* zr = z + ((size_t)b * SEQ + sj) * ZW;
            const u32x4 q0 = *(const u32x4*)(zr + Z_QM + h * 64 + e0), q1 = *(const u32x4*)(zr + Z_QM + h * 64 + e0 + 8);
            const u32x4 k0 = *(const u32x4*)(zr + Z_KM + h * 64 + e0), k1 = *(const u32x4*)(zr + Z_KM + h * 64 + e0 + 8);
            const unsigned qa[8] = {q0.x, q0.y, q0.z, q0.w, q1.x, q1.y, q1.z, q1.w}, ka[8] = {k0.x, k0.y, k0.z, k0.w, k1.x, k1.y, k1.z, k1.w};
#pragma unroll
            for (int i = 0; i < 8; ++i) { q[2 * i] += cwl[j * 128 + e0 + 2 * i] * bflo(qa[i]); q[2 * i + 1] += cwl[j * 128 + e0 + 2 * i + 1] * bfhi(qa[i]); k[2 * i] += cwl[j * 128 + 64 + e0 + 2 * i] * bflo(ka[i]); k[2 * i + 1] += cwl[j * 128 + 64 + e0 + 2 * i + 1] * bfhi(ka[i]); } }
            asm volatile("" ::: "memory"); }
#pragma unroll
        for (int i = 0; i < 16; ++i) { q[i] = siluf_(q[i]) * 0.125f; k[i] = siluf_(k[i]); }
        const float v = bf2f(z[t * ZW + Z_VM + h * 128 + d]);
        const float ig = IFG[t * 8 + h], fp = IFG[t * 8 + 4 + h];
        const float logf = fminf(fp, 0.f) - log1pf(__expf(-fabsf(fp)));
        const float mn = fmaxf(logf + m, ig), dec = __expf(logf + m - mn), fr = __expf(ig - mn);
        float num = 0.f, den = 0.f;
#pragma unroll
        for (int i = 0; i < 16; ++i) { C[i] = dec * C[i] + fr * v * k[i]; n[i] = dec * n[i] + fr * k[i]; num += C[i] * q[i]; den += n[i] * q[i]; }
        num += __shfl_xor(num, 1); num += __shfl_xor(num, 2); den += __shfl_xor(den, 1); den += __shfl_xor(den, 2);
        m = mn;
        if (eq == 0) HR[t * 512 + h * 128 + d] = num / fmaxf(fabsf(den), __expf(-mn));
    }
}
__device__ __forceinline__ void naive_swa(const Ctx& c, int l, int first_blk) {
    const bf16* z = (const bf16*)(c.a.ws + WS_Z); bf16* hc = (bf16*)(c.a.ws + WS_HCAT);
    const float* relb = c.a.in[I_RELB]; const float* sinks = c.a.in[I_SINK] + l * AH;
    const int nblk = c.G - first_blk;
    for (int idx = (c.bid - first_blk) * NT + c.tid; idx < T * AH * 4; idx += nblk * NT) {
        const int part = idx & 3, hd = (idx >> 2) & 7, t = idx >> 5, kh = hd >> 2, s = t % SEQ, d0 = part * 16;
        float q[16], o[16];
        { const bf16* qp = z + (size_t)t * ZW + Z_QA + hd * 64 + d0;
#pragma unroll
          for (int i = 0; i < 2; ++i) { const u32x4 v = *(const u32x4*)(qp + 8 * i); q[8 * i] = bflo(v.x); q[8 * i + 1] = bfhi(v.x); q[8 * i + 2] = bflo(v.y); q[8 * i + 3] = bfhi(v.y); q[8 * i + 4] = bflo(v.z); q[8 * i + 5] = bfhi(v.z); q[8 * i + 6] = bflo(v.w); q[8 * i + 7] = bfhi(v.w); } }
#pragma unroll
        for (int i = 0; i < 16; ++i) o[i] = 0.f;
        float mx = sinks[hd], lsum = 1.f;
        const int j0 = s - 127 < 0 ? 0 : s - 127;
        for (int j = j0; j <= s; ++j) {
            const bf16* kp = z + (size_t)(t - s + j) * ZW + Z_KA + kh * 64 + d0; const bf16* vp = z + (size_t)(t - s + j) * ZW + Z_VA + kh * 64 + d0;
            float sc = 0.f;
#pragma unroll
            for (int i = 0; i < 2; ++i) { const u32x4 v = *(const u32x4*)(kp + 8 * i);
                sc += q[8 * i] * bflo(v.x) + q[8 * i + 1] * bfhi(v.x) + q[8 * i + 2] * bflo(v.y) + q[8 * i + 3] * bfhi(v.y) + q[8 * i + 4] * bflo(v.z) + q[8 * i + 5] * bfhi(v.z) + q[8 * i + 6] * bflo(v.w) + q[8 * i + 7] * bfhi(v.w); }
            sc += __shfl_xor(sc, 1); sc += __shfl_xor(sc, 2);
            sc = sc * 0.125f + relb[T5_BUCKET[s - j] * AH + hd];
            const float mn = fmaxf(mx, sc), corr = __expf(mx - mn), p = __expf(sc - mn);
            lsum = lsum * corr + p; mx = mn;
#pragma unroll
            for (int i = 0; i < 2; ++i) { const u32x4 v = *(const u32x4*)(vp + 8 * i);
                o[8 * i] = o[8 * i] * corr + p * bflo(v.x); o[8 * i + 1] = o[8 * i + 1] * corr + p * bfhi(v.x); o[8 * i + 2] = o[8 * i + 2] * corr + p * bflo(v.y); o[8 * i + 3] = o[8 * i + 3] * corr + p * bfhi(v.y);
                o[8 * i + 4] = o[8 * i + 4] * corr + p * bflo(v.z); o[8 * i + 5] = o[8 * i + 5] * corr + p * bfhi(v.z); o[8 * i + 6] = o[8 * i + 6] * corr + p * bflo(v.w); o[8 * i + 7] = o[8 * i + 7] * corr + p * bfhi(v.w); }
        }
        const float inv = 1.f / lsum; bf16* op = hc + (size_t)t * D + 512 + hd * 64 + d0;
#pragma unroll
        for (int i = 0; i < 2; ++i) { u32x4 w; w.x = pk2(o[8 * i] * inv, o[8 * i + 1] * inv); w.y = pk2(o[8 * i + 2] * inv, o[8 * i + 3] * inv); w.z = pk2(o[8 * i + 4] * inv, o[8 * i + 5] * inv); w.w = pk2(o[8 * i + 6] * inv, o[8 * i + 7] * inv); *(u32x4*)(op + 8 * i) = w; }
    }
}
__device__ __forceinline__ void phase_mix1(const Ctx& c, int l) {
    if (c.bid < 16) naive_mlstm(c, l, c.bid); else naive_swa(c, l, 16);
}
__device__ __forceinline__ void phase_mix2(const Ctx& c, int l) {
    const float* HR = (const float*)(c.a.ws + WS_XA); const bf16* z = (const bf16*)(c.a.ws + WS_Z); bf16* hc = (bf16*)(c.a.ws + WS_HCAT);
    const float* wm = c.a.in[I_WMN] + l * 512;
    const int gw = c.bid * NWAVES + c.wave, NGW = c.G * NWAVES;
    for (int it = gw; it < T * MH; it += NGW) { const int t = it >> 2, h = it & 3; const int col = h * 128 + 2 * c.lane;
        const float a0 = HR[(size_t)t * 512 + col], a1 = HR[(size_t)t * 512 + col + 1];
        const float rstd = rsqrtf(wave_sum(a0 * a0 + a1 * a1) * (1.f / 128.f) + EPS);
        const unsigned og = *(const unsigned*)(z + (size_t)t * ZW + Z_OM + col);
        *(unsigned*)(hc + (size_t)t * D + col) = pk2(a0 * rstd * wm[col] * sigmoidf_(bflo(og)), a1 * rstd * wm[col + 1] * sigmoidf_(bfhi(og))); }
}

__device__ __forceinline__ void phase_route(const Ctx& c, int l) {
    LAS float* wr = (LAS float*)c.lds;
    for (int i = c.tid; i < 16384; i += NT) { const int k = i >> 4, e = i & 15; wr[e * 1024 + k] = c.a.in[I_WR][i]; }
    __syncthreads();
    LAS int* ridx_l = (LAS int*)(c.lds + 65536);
    const int chunk = (T + c.G - 1) / c.G, m0 = c.bid * chunk, m1 = (m0 + chunk < T) ? m0 + chunk : T;
    const float* wn = c.a.in[I_WN2] + l * D; const float* mod = c.mod(l); const float* rbias = c.a.in[I_RB];
    bf16* XN = (bf16*)(c.a.ws + WS_XA); int* RIDX = (int*)(c.a.ws + WS_RIDX); float* RW = (float*)(c.a.ws + WS_RW);
    for (int m = m0 + c.wave; m < m1; m += NWAVES) {
        const int b = m / SEQ; const f32x4* xr = (const f32x4*)(c.a.out + (size_t)m * D) + c.lane;
        f32x4 v[4]; float s = 0.f;
#pragma unroll
        for (int j = 0; j < 4; ++j) { v[j] = xr[64 * j]; s += (v[j].x * v[j].x + v[j].y * v[j].y) + (v[j].z * v[j].z + v[j].w * v[j].w); }
        const float rstd = rsqrtf(wave_sum(s) * (1.f / D) + EPS);
        float lg[16];
#pragma unroll
        for (int e = 0; e < 16; ++e) lg[e] = 0.f;
        u32x2* o8 = (u32x2*)(XN + (size_t)m * D) + c.lane;
#pragma unroll
        for (int j = 0; j < 4; ++j) { const int col = 256 * j + 4 * c.lane;
            const f32x4 w = *(const f32x4*)(wn + col), sh = *(const f32x4*)(mod + b * 6144 + 3072 + col), sc = *(const f32x4*)(mod + b * 6144 + 4096 + col);
            v[j] = (v[j] * rstd * w) * (sc + 1.f) + sh;
            u32x2 o; o.x = pk2(v[j].x, v[j].y); o.y = pk2(v[j].z, v[j].w); o8[64 * j] = o; }
#pragma unroll
        for (int e = 0; e < 16; ++e) {
#pragma unroll
            for (int j = 0; j < 4; ++j) { const f32x4 ww = *(const LAS f32x4*)(wr + e * 1024 + 256 * j + 4 * c.lane); lg[e] += (v[j].x * ww.x + v[j].y * ww.y) + (v[j].z * ww.z + v[j].w * ww.w); }
            asm volatile("" ::: "memory"); }
#pragma unroll
        for (int e = 0; e < 16; ++e) lg[e] = wave_sum(lg[e]);
        float sc[16], sel[16];
#pragma unroll
        for (int e = 0; e < 16; ++e) { sc[e] = 1.f / (1.f + expf(-lg[e])); sel[e] = sc[e] + rbias[e]; }
        int bg = 0; float bgs = -INFINITY;
#pragma unroll
        for (int g = 0; g < 4; ++g) { float m1 = -INFINITY, m2 = -INFINITY;
#pragma unroll
            for (int i = 0; i < 4; ++i) { const float x = sel[4 * g + i]; if (x > m1) { m2 = m1; m1 = x; } else if (x > m2) m2 = x; }
            const float gs = m1 + m2; if (gs > bgs) { bgs = gs; bg = g; } }
        int i1 = -1, i2 = -1; float v1 = -INFINITY, v2 = -INFINITY;
#pragma unroll
        for (int e = 0; e < 16; ++e) { if ((e >> 2) == bg) { const float x = sel[e]; if (x > v1) { v2 = v1; i2 = i1; v1 = x; i1 = e; } else if (x > v2) { v2 = x; i2 = e; } } }
        float s1 = 0.f, s2 = 0.f;
#pragma unroll
        for (int e = 0; e < 16; ++e) { s1 = (e == i1) ? sc[e] : s1; s2 = (e == i2) ? sc[e] : s2; }
        if (c.lane == 0) { const float inv = 1.f / (s1 + s2); RIDX[2 * m] = i1; RIDX[2 * m + 1] = i2; RW[2 * m] = s1 * inv; RW[2 * m + 1] = s2 * inv;
            ridx_l[2 * (m - m0)] = i1; ridx_l[2 * (m - m0) + 1] = i2; }
    }
    __syncthreads();
    if (c.tid < NE) { const int n2 = 2 * (m1 - m0); int cnt = 0; int* RANK = (int*)(c.a.ws + WS_RANK) + 2 * m0;
        for (int i = 0; i < n2; ++i) { if (ridx_l[i] == c.tid) { RANK[i] = cnt; ++cnt; } }
        ((int*)(c.a.ws + WS_WGCNT))[c.bid * NE + c.tid] = cnt; }
    __syncthreads();
}
__device__ __forceinline__ void phase_fill(const Ctx& c, int l) {
    LAS int* wg = (LAS int*)c.lds;
    LAS int* base = wg + 512 * NE;
    LAS int* tot = base + NE;
    LAS int* offs = tot + NE;
    const int* WGCNT = (const int*)(c.a.ws + WS_WGCNT);
    for (int i = c.tid; i < c.G * NE; i += NT) wg[i] = WGCNT[i];
    __syncthreads();
    if (c.tid < NE) { int s = 0, bs = 0; for (int w = 0; w < c.G; ++w) { if (w == c.bid) bs = s; s += wg[w * NE + c.tid]; } base[c.tid] = bs; tot[c.tid] = s; }
    __syncthreads();
    if (c.tid == 0) { int o = 0; for (int e = 0; e < NE; ++e) { offs[e] = o; o += (tot[e] + 255) & ~255; } offs[NE] = o; }
    __syncthreads();
    const int* RIDX = (const int*)(c.a.ws + WS_RIDX); const int* RANK = (const int*)(c.a.ws + WS_RANK); int* SLOT = (int*)(c.a.ws + WS_SLOT); int* ROWTOK = (int*)(c.a.ws + WS_ROWTOK);
    const int chunk = (T + c.G - 1) / c.G, m0 = c.bid * chunk, m1 = (m0 + chunk < T) ? m0 + chunk : T;
    for (int i = 2 * m0 + c.tid; i < 2 * m1; i += NT) { const int e = RIDX[i]; const int row = offs[e] + base[e] + RANK[i]; ROWTOK[row] = i >> 1; SLOT[i] = row; }
    if (c.bid < NE) { const int e = c.bid; for (int r = offs[e] + tot[e] + c.tid; r < offs[e + 1]; r += NT) ROWTOK[r] = 0; }
    if (c.bid == 0 && c.tid < NE) (c.ctl() + CW_CNT + 64 * l)[c.tid] = (unsigned)tot[c.tid];
    __syncthreads();
}
__device__ __forceinline__ void phase_g1(const Ctx& c, int l) {
    LAS int* offs = (LAS int*)(c.lds + 65536);
    const unsigned* cnt = c.ctl() + CW_CNT + 64 * l;
    if (c.tid == 0) { int o = 0; for (int e = 0; e < NE; ++e) { offs[e] = o; o += (int)((__hip_atomic_load(cnt + e, __ATOMIC_RELAXED, __HIP_MEMORY_SCOPE_AGENT) + 255u) & ~255u); } offs[NE] = o; }
    __syncthreads();
    const int R = offs[NE]; const int NTM = R / 128; constexpr int NTN = DE / 64;
    const RowGather ra{(const bf16*)(c.a.ws + WS_XA), D, (const int*)(c.a.ws + WS_ROWTOK)}; const EpiAct ep{(bf16*)(c.a.ws + WS_ACT)};
    for (int u = c.bid; u < NTM * NTN; u += c.G) { const int m0 = (u / NTN) * 128, n0 = (u % NTN) * 64; int e = 0; for (int i = 1; i < NE; ++i) if (m0 >= offs[i]) e = i;
        const bf16* w = (const bf16*)(c.wl(l) + W_GU) + (size_t)e * 1024 * D; const RowGU rb0{w, 0}, rb1{w, 1};
        naive_gemm_tile(c, m0, n0, D, D, ra, ra, rb0, rb1, ep); }
    __syncthreads();
}
__device__ __forceinline__ void phase_g2(const Ctx& c, int l) {
    LAS int* offs = (LAS int*)(c.lds + 65536);
    const unsigned* cnt = c.ctl() + CW_CNT + 64 * l;
    if (c.tid == 0) { int o = 0; for (int e = 0; e < NE; ++e) { offs[e] = o; o += (int)((__hip_atomic_load(cnt + e, __ATOMIC_RELAXED, __HIP_MEMORY_SCOPE_AGENT) + 255u) & ~255u); } offs[NE] = o; }
    __syncthreads();
    const int R = offs[NE]; const int NTM = R / 128; constexpr int NTN = D / 64;
    const RowPlain ra{(const bf16*)(c.a.ws + WS_ACT), DE}; const EpiY ep{(bf16*)(c.a.ws + WS_Y)};
    for (int u = c.bid; u < NTM * NTN; u += c.G) { const int m0 = (u / NTN) * 128, n0 = (u % NTN) * 64; int e = 0; for (int i = 1; i < NE; ++i) if (m0 >= offs[i]) e = i;
        const RowPlain rb{(const bf16*)(c.wl(l) + W_DN) + (size_t)e * D * DE, DE};
        naive_gemm_tile(c, m0, n0, DE, 0, ra, ra, rb, rb, ep); }
    __syncthreads();
}
__device__ __forceinline__ void phase_combine(const Ctx& c, int l) {
    const float* mod = c.mod(l); const bf16* Y = (const bf16*)(c.a.ws + WS_Y); const int* SLOT = (const int*)(c.a.ws + WS_SLOT); const float* RW = (const float*)(c.a.ws + WS_RW);
    const float* wf = c.a.in[I_WF];
    const int gw = c.bid * NWAVES + c.wave, NGW = c.G * NWAVES;
    for (int m = gw; m < T; m += NGW) {
        const int b = m / SEQ; f32x4* xr = (f32x4*)(c.a.out + (size_t)m * D) + c.lane;
        const int s0 = SLOT[2 * m], s1 = SLOT[2 * m + 1]; const float w0 = RW[2 * m], w1 = RW[2 * m + 1];
        const u32x2* y0 = (const u32x2*)(Y + (size_t)s0 * D) + c.lane; const u32x2* y1 = (const u32x2*)(Y + (size_t)s1 * D) + c.lane;
        f32x4 v[4]; float s = 0.f;
#pragma unroll
        for (int j = 0; j < 4; ++j) { const int col = 256 * j + 4 * c.lane; const f32x4 g = *(const f32x4*)(mod + b * 6144 + 5120 + col);
            const u32x2 a = y0[64 * j], bb = y1[64 * j];
            const f32x4 ya = {bflo(a.x), bfhi(a.x), bflo(a.y), bfhi(a.y)}, yb = {bflo(bb.x), bfhi(bb.x), bflo(bb.y), bfhi(bb.y)};
            v[j] = xr[64 * j] + g * (ya * w0 + yb * w1);
            s += (v[j].x * v[j].x + v[j].y * v[j].y) + (v[j].z * v[j].z + v[j].w * v[j].w); }
        if (l == DEPTH - 1) { const float rstd = rsqrtf(wave_sum(s) * (1.f / D) + EPS);
#pragma unroll
            for (int j = 0; j < 4; ++j) xr[64 * j] = v[j] * rstd * *(const f32x4*)(wf + 256 * j + 4 * c.lane); }
        else {
#pragma unroll
            for (int j = 0; j < 4; ++j) xr[64 * j] = v[j]; }
    }
}

namespace pg8 {
typedef short bf16x8 __attribute__((ext_vector_type(8)));
constexpr int BM = 256, BK = 64, HALF = 128, HTB = HALF * BK * 2, STAGE_BYTES = 8 * HTB, NXCD = 8, WGM = 8;
__host__ __device__ __forceinline__ int lds_byte(int r, int c) { const int st = (r >> 4) * 2 + (c >> 5), rr = r & 15, cc = c & 31, ob = rr * 64 + cc * 2; return st * 1024 + (ob ^ (((ob >> 9) & 1) << 5)); }
__host__ __device__ __forceinline__ void stage_rc(int b, int& R, int& C) { const int st = b / 1024, sb = b % 1024, swz = sb ^ (((sb >> 9) & 1) << 5); R = (st >> 1) * 16 + swz / 64; C = (st & 1) * 32 + (swz % 64) / 2; }
__host__ __device__ __forceinline__ int perm32(int rho) { const int n = rho >> 4, i = rho & 15; return 8 * (i >> 2) + 4 * n + (i & 3); }
struct Unit { int pm, pn; };
struct StaticOrder {
    int nM, nN, nwg, G, c;
    __device__ void init(int M, int N, int G_, int c_) { nM = M / BM; nN = N / BM; nwg = nM * nN; G = G_; c = c_; }
    __device__ bool next(int i, Unit& u) const {
        const long L = (long)i * G + c; if (L >= nwg) return false;
        int wgid = (int)L; { const int q = nwg / NXCD, r = nwg % NXCD, xcd = wgid % NXCD, off = wgid / NXCD; wgid = (xcd < r ? xcd * (q + 1) : r * (q + 1) + (xcd - r) * q) + off; }
        const int nig = WGM * nN, gid = wgid / nig, fm = gid * WGM, gsz = (nM - fm) < WGM ? (nM - fm) : WGM;
        u.pm = fm + ((wgid % nig) % gsz); u.pn = (wgid % nig) / gsz; return true;
    }
};
__device__ __forceinline__ unsigned cvt_pk_bf16(float lo, float hi) { unsigned r; asm volatile("v_cvt_pk_bf16_f32 %0, %1, %2" : "=v"(r) : "v"(lo), "v"(hi)); return r; }

template <class Epi, class Sched, class Prob, bool ALIGN_EPI, bool SP2>
__device__ __forceinline__ void gemm_phase(LAS unsigned char* lds, const Prob& P, const Sched& S, const Epi& E) {
    int tid_ = threadIdx.x; asm volatile("" : "+v"(tid_));
    const int tid = tid_, wid = __builtin_amdgcn_readfirstlane(tid >> 6), lane = tid & 63, wr = wid >> 2, wc = wid & 3, fr = lane & 15, fq = lane >> 4;
    const int K = P.K, nt = K / BK;
    unsigned voffA[2], voffB[2]; int RA[2], CA[2];
#pragma unroll
    for (int i = 0; i < 2; ++i) { int R, C; stage_rc(tid * 16 + i * 8192, R, C); const int Rb = Epi::PERM ? ((R & ~31) + perm32(R & 31)) : R;
        RA[i] = R; CA[i] = C; voffA[i] = (unsigned)(R * K + C) * 2u; voffB[i] = (unsigned)(Rb * K + C) * 2u; }
    const size_t kstep = (size_t)(BK * 2);
    const size_t hstep = (size_t)HALF * K * 2;
    const unsigned ldsw = (unsigned)wid * 1024u;
    const int aoff = lds_byte(wr * 64 + fr, fq * 8), boff = lds_byte(wc * 32 + fr, fq * 8);
    unsigned vac[2][2], van[2][2];
#define PG8_SA(b, h) (((b) * 2 + (h)) * HTB)
#define PG8_SB(b, h) ((4 + (b) * 2 + (h)) * HTB)
#define PG8_GLDS(src, dstoff) __builtin_amdgcn_global_load_lds((const unsigned*)(src), (LAS unsigned*)(lds + (dstoff)), 16, 0, 0)
#define PG8_STAGE(bufoff, gbase, voff) do { _Pragma("unroll") for (int _i = 0; _i < 2; ++_i) PG8_GLDS((const char*)(gbase) + (voff)[_i], (bufoff) + ldsw + _i * 8192); } while (0)
#define PG8_STAGEA(bufoff, gbase, h, VG) do { if constexpr (Prob::GATHER) { _Pragma("unroll") for (int _i = 0; _i < 2; ++_i) PG8_GLDS((const char*)(gbase) + (VG)[h][_i], (bufoff) + ldsw + _i * 8192); } \
        else { _Pragma("unroll") for (int _i = 0; _i < 2; ++_i) PG8_GLDS((const char*)(gbase) + (h) * hstep + voffA[_i], (bufoff) + ldsw + _i * 8192); } } while (0)
#define PG8_LDA(dst, b, h) do { _Pragma("unroll") for (int m = 0; m < 4; ++m) _Pragma("unroll") for (int k = 0; k < 2; ++k) dst[m][k] = *(const LAS bf16x8*)(lds + PG8_SA(b, h) + aoff + m * 2048 + k * 1024); } while (0)
#define PG8_LDB(dst, b, h) do { _Pragma("unroll") for (int n = 0; n < 2; ++n) _Pragma("unroll") for (int k = 0; k < 2; ++k) dst[n][k] = *(const LAS bf16x8*)(lds + PG8_SB(b, h) + boff + n * 2048 + k * 1024); } while (0)
#define PG8_MMA(ai, bj, At, Bt) do { __builtin_amdgcn_s_setprio(1); _Pragma("unroll") for (int m = 0; m < 4; ++m) _Pragma("unroll") for (int n = 0; n < 2; ++n) _Pragma("unroll") for (int k = 0; k < 2; ++k) \
        acc[ai][bj][m][n] = __builtin_amdgcn_mfma_f32_16x16x32_bf16(Bt[n][k], At[m][k], acc[ai][bj][m][n], 0, 0, 0); __builtin_amdgcn_s_setprio(0); } while (0)
#define PG8_WAIT_V(n) asm volatile("s_waitcnt vmcnt(" #n ")" ::: "memory")
#define PG8_WAIT_L(n) asm volatile("s_waitcnt lgkmcnt(" #n ")" ::: "memory")
#define PG8_BAR __builtin_amdgcn_s_barrier()
#define PG8_SCHED __builtin_amdgcn_sched_barrier(0)
    Unit cur, nxt; int ui = 0;
    if (!S.next(0, cur)) return;
    f32x4 acc[2][2][4][2];
#pragma unroll
    for (int a = 0; a < 2; ++a)
#pragma unroll
        for (int b = 0; b < 2; ++b)
#pragma unroll
            for (int m = 0; m < 4; ++m)
#pragma unroll
                for (int n = 0; n < 2; ++n) acc[a][b][m][n] = (f32x4){0.f, 0.f, 0.f, 0.f};
    bf16x8 At[4][2], B0[2][2], B1[2][2];
    const char* cA = P.a_tile(cur); const char* cB = P.b_tile(cur);
    if constexpr (Prob::GATHER) { P.a_voff(cur, RA, CA, vac); }
    if constexpr (SP2) {
        PG8_STAGE(PG8_SB(0, 0), cB, voffB); PG8_STAGE(PG8_SB(0, 1), cB + hstep, voffB); PG8_STAGEA(PG8_SA(0, 0), cA, 0, vac); PG8_STAGEA(PG8_SA(0, 1), cA, 1, vac);
        if (wr == 1) PG8_BAR;
        PG8_WAIT_V(2); PG8_BAR;
        PG8_STAGE(PG8_SB(1, 0), cB + kstep, voffB); PG8_STAGEA(PG8_SA(1, 0), cA + kstep, 0, vac); PG8_STAGE(PG8_SB(1, 1), cB + hstep + kstep, voffB);
        PG8_WAIT_V(6); PG8_BAR;
    } else {
        PG8_STAGE(PG8_SB(0, 0), cB, voffB); PG8_STAGEA(PG8_SA(0, 0), cA, 0, vac); PG8_STAGE(PG8_SB(0, 1), cB + hstep, voffB); PG8_STAGEA(PG8_SA(0, 1), cA, 1, vac);
        if (wr == 1) PG8_BAR;
        PG8_WAIT_V(4); PG8_BAR;
        PG8_STAGE(PG8_SB(1, 0), cB + kstep, voffB); PG8_STAGEA(PG8_SA(1, 0), cA + kstep, 0, vac); PG8_STAGE(PG8_SB(1, 1), cB + hstep + kstep, voffB);
        PG8_WAIT_V(6); PG8_BAR;
    }
    for (;;) {
        const bool has_next = S.next(ui + 1, nxt);
        const char* nA = has_next ? P.a_tile(nxt) : cA; const char* nB = has_next ? P.b_tile(nxt) : cB;
        if constexpr (Prob::GATHER) { if (has_next) P.a_voff(nxt, RA, CA, van); else {
#pragma unroll
            for (int h = 0; h < 2; ++h)
#pragma unroll
                for (int i = 0; i < 2; ++i) van[h][i] = vac[h][i]; } }
        for (int t = 0; t < nt; t += 2) {
            const bool last = (t == nt - 2);
            const char* a1 = cA + (size_t)(t + 1) * kstep;
            const char* a2 = last ? nA : cA + (size_t)(t + 2) * kstep; const char* b2 = last ? nB : cB + (size_t)(t + 2) * kstep;
            const char* a3 = a2 + kstep; const char* b3 = b2 + kstep;
            unsigned v2[2][2];
            if constexpr (Prob::GATHER) {
#pragma unroll
                for (int h = 0; h < 2; ++h)
#pragma unroll
                    for (int i = 0; i < 2; ++i) v2[h][i] = last ? van[h][i] : vac[h][i]; }
            if constexpr (SP2) {
            PG8_LDB(B0, 0, 0); PG8_LDB(B1, 0, 1); PG8_SCHED; PG8_LDA(At, 0, 0); PG8_STAGEA(PG8_SA(1, 1), a1, 1, vac);
            PG8_WAIT_V(8); PG8_WAIT_L(0); PG8_BAR; PG8_MMA(0, 0, At, B0); PG8_MMA(0, 1, At, B1); PG8_BAR; PG8_SCHED;
            PG8_LDA(At, 0, 1); PG8_STAGE(PG8_SB(0, 0), b2, voffB); PG8_STAGE(PG8_SB(0, 1), b2 + hstep, voffB); PG8_STAGEA(PG8_SA(0, 0), a2, 0, v2);
            PG8_WAIT_V(8); PG8_WAIT_L(0); PG8_BAR; PG8_MMA(1, 0, At, B0); PG8_MMA(1, 1, At, B1); PG8_BAR; PG8_SCHED;
            PG8_LDB(B0, 1, 0); PG8_LDB(B1, 1, 1); PG8_SCHED; PG8_LDA(At, 1, 0); PG8_STAGEA(PG8_SA(0, 1), a2, 1, v2);
            PG8_WAIT_V(8); PG8_WAIT_L(0); PG8_BAR; PG8_MMA(0, 0, At, B0); PG8_MMA(0, 1, At, B1); PG8_BAR; PG8_SCHED;
            PG8_LDA(At, 1, 1); PG8_STAGE(PG8_SB(1, 0), b3, voffB); PG8_STAGE(PG8_SB(1, 1), b3 + hstep, voffB); PG8_STAGEA(PG8_SA(1, 0), a3, 0, v2);
            PG8_WAIT_V(8); PG8_WAIT_L(0); PG8_BAR; PG8_MMA(1, 0, At, B0); PG8_MMA(1, 1, At, B1); PG8_BAR; PG8_SCHED;
            } else {
            PG8_LDB(B0, 0, 0); PG8_SCHED; PG8_LDA(At, 0, 0); PG8_STAGEA(PG8_SA(1, 1), a1, 1, vac);
            PG8_WAIT_L(8); PG8_BAR; PG8_WAIT_L(0); PG8_MMA(0, 0, At, B0); PG8_BAR; PG8_SCHED;
            PG8_LDB(B1, 0, 1); PG8_STAGE(PG8_SB(0, 0), b2, voffB);
            PG8_BAR; PG8_WAIT_L(0); PG8_MMA(0, 1, At, B1); PG8_BAR;
            PG8_LDA(At, 0, 1); PG8_STAGEA(PG8_SA(0, 0), a2, 0, v2);
            PG8_BAR; PG8_WAIT_L(0); PG8_MMA(1, 0, At, B0); PG8_BAR; PG8_SCHED;
            PG8_STAGE(PG8_SB(0, 1), b2 + hstep, voffB);
            PG8_WAIT_V(6); PG8_BAR; PG8_MMA(1, 1, At, B1); PG8_BAR;
            PG8_LDB(B0, 1, 0); PG8_SCHED; PG8_LDA(At, 1, 0); PG8_STAGEA(PG8_SA(0, 1), a2, 1, v2);
            PG8_WAIT_L(8); PG8_BAR; PG8_WAIT_L(0); PG8_MMA(0, 0, At, B0); PG8_BAR; PG8_SCHED;
            PG8_LDB(B1, 1, 1); PG8_STAGE(PG8_SB(1, 0), b3, voffB);
            PG8_BAR; PG8_WAIT_L(0); PG8_MMA(0, 1, At, B1); PG8_BAR;
            PG8_LDA(At, 1, 1); PG8_STAGEA(PG8_SA(1, 0), a3, 0, v2);
            PG8_BAR; PG8_WAIT_L(0); PG8_MMA(1, 0, At, B0); PG8_BAR; PG8_SCHED;
            PG8_STAGE(PG8_SB(1, 1), b3 + hstep, voffB);
            PG8_WAIT_V(6); PG8_BAR; PG8_MMA(1, 1, At, B1); PG8_BAR;
            }
            if constexpr (Epi::HAS_MID) { if (t == nt / 2 - 2) E.mid(acc, cur, wr, wc, fr, fq); }
        }
        if constexpr (ALIGN_EPI) { if (wr == 0) PG8_BAR; }
        E(acc, cur, wr, wc, fr, fq);
        if (!has_next) break;
#pragma unroll
        for (int a = 0; a < 2; ++a)
#pragma unroll
            for (int b = 0; b < 2; ++b)
#pragma unroll
                for (int m = 0; m < 4; ++m)
#pragma unroll
                    for (int n = 0; n < 2; ++n) acc[a][b][m][n] = (f32x4){0.f, 0.f, 0.f, 0.f};
        cur = nxt; cA = nA; cB = nB; ++ui;
        if constexpr (Prob::GATHER) {
#pragma unroll
            for (int h = 0; h < 2; ++h)
#pragma unroll
                for (int i = 0; i < 2; ++i) vac[h][i] = van[h][i]; }
        if constexpr (ALIGN_EPI) { if (wr == 1) PG8_BAR; }
    }
    PG8_WAIT_V(0);
    if constexpr (!ALIGN_EPI) { if (wr == 0) PG8_BAR; }
    PG8_BAR;
#undef PG8_SA
#undef PG8_SB
#undef PG8_GLDS
#undef PG8_STAGE
#undef PG8_STAGEA
#undef PG8_LDA
#undef PG8_LDB
#undef PG8_MMA
#undef PG8_WAIT_V
#undef PG8_WAIT_L
#undef PG8_BAR
#undef PG8_SCHED
}

struct ProbPlain { static constexpr bool GATHER = false; const bf16* A; const bf16* Bt; int K;
    __device__ __forceinline__ const char* a_tile(const Unit& u) const { return (const char*)A + (size_t)u.pm * BM * K * 2; }
    __device__ __forceinline__ const char* b_tile(const Unit& u) const { return (const char*)Bt + (size_t)u.pn * BM * K * 2; }
    __device__ __forceinline__ void a_voff(const Unit&, const int (&)[2], const int (&)[2], unsigned (&)[2][2]) const {} };
__device__ __forceinline__ int moe_expert(const LAS int* offs, int row) { int e = 0;
#pragma unroll
    for (int i = 1; i < NE; ++i) e = (row >= offs[i]) ? i : e;
    return e; }
struct ProbMoeGather { static constexpr bool GATHER = true; const bf16* A; const bf16* Bt; int K; const int* rowtok; const LAS int* offs; size_t estride;
    __device__ __forceinline__ const char* a_tile(const Unit&) const { return (const char*)A; }
    __device__ __forceinline__ const char* b_tile(const Unit& u) const { const int e = __builtin_amdgcn_readfirstlane(moe_expert(offs, u.pm * BM)); return (const char*)(Bt + (size_t)e * estride) + (size_t)u.pn * BM * K * 2; }
    __device__ __forceinline__ void a_voff(const Unit& u, const int (&R)[2], const int (&C)[2], unsigned (&v)[2][2]) const {
#pragma unroll
        for (int h = 0; h < 2; ++h)
#pragma unroll
            for (int i = 0; i < 2; ++i) { const int tok = rowtok[u.pm * BM + h * HALF + R[i]]; v[h][i] = (unsigned)(tok * K + C[i]) * 2u; }
#pragma unroll
        for (int h = 0; h < 2; ++h)
#pragma unroll
            for (int i = 0; i < 2; ++i) asm volatile("" : "+v"(v[h][i]));
    } };
struct ProbMoePlain { static constexpr bool GATHER = false; const bf16* A; const bf16* Bt; int K; const LAS int* offs; size_t estride;
    __device__ __forceinline__ const char* a_tile(const Unit& u) const { return (const char*)A + (size_t)u.pm * BM * K * 2; }
    __device__ __forceinline__ const char* b_tile(const Unit& u) const { const int e = __builtin_amdgcn_readfirstlane(moe_expert(offs, u.pm * BM)); return (const char*)(Bt + (size_t)e * estride) + (size_t)u.pn * BM * K * 2; }
    __device__ __forceinline__ void a_voff(const Unit&, const int (&)[2], const int (&)[2], unsigned (&)[2][2]) const {} };

struct EpiStoreBf16 {
    static constexpr bool PERM = true, HAS_MID = false; bf16* O; int ldc;
    __device__ __forceinline__ void operator()(const f32x4 (&acc)[2][2][4][2], const Unit& u, int wr, int wc, int fr, int fq) const {
        int row0 = u.pm * BM + wr * 64 + fr, col0 = u.pn * BM + wc * 32 + 8 * fq; asm volatile("" : "+v"(row0), "+v"(col0));
#pragma unroll
        for (int ai = 0; ai < 2; ++ai)
#pragma unroll
            for (int m = 0; m < 4; ++m) { bf16* rowp = O + (size_t)(row0 + ai * HALF + m * 16) * ldc + col0;
#pragma unroll
                for (int bj = 0; bj < 2; ++bj) { const f32x4 v0 = acc[ai][bj][m][0], v1 = acc[ai][bj][m][1];
                    u32x4 w; w.x = cvt_pk_bf16(v0[0], v0[1]); w.y = cvt_pk_bf16(v0[2], v0[3]); w.z = cvt_pk_bf16(v1[0], v1[1]); w.w = cvt_pk_bf16(v1[2], v1[3]);
                    *(u32x4*)(rowp + bj * HALF) = w; } }
    }
};
__device__ __forceinline__ void unpack8(const u32x4 w, float (&f)[8]) { f[0] = bflo(w.x); f[1] = bfhi(w.x); f[2] = bflo(w.y); f[3] = bfhi(w.y); f[4] = bflo(w.z); f[5] = bfhi(w.z); f[6] = bflo(w.w); f[7] = bfhi(w.w); }
struct EpiMerge {
    static constexpr bool PERM = true, HAS_MID = true; const bf16* z; bf16* O;
    __device__ __forceinline__ void mid(f32x4 (&acc)[2][2][4][2], const Unit& u, int wr, int wc, int fr, int fq) const {
        int row0 = u.pm * BM + wr * 64 + fr, col0 = u.pn * BM + wc * 32 + 8 * fq; asm volatile("" : "+v"(row0), "+v"(col0));
        const bf16* zr0 = z + (size_t)row0 * ZW + col0;
#pragma unroll
        for (int ai = 0; ai < 2; ++ai)
#pragma unroll
            for (int m = 0; m < 4; ++m)
#pragma unroll
                for (int bj = 0; bj < 2; ++bj) { const bf16* zr = zr0 + (size_t)(ai * HALF + m * 16) * ZW + bj * HALF;
                    const u32x4 gmw = *(const u32x4*)(zr + Z_GM), gaw = *(const u32x4*)(zr + Z_GA);
                    f32x4 r0, r1;
                    r0[0] = (1.f + __expf(-bflo(gaw.x))) * __builtin_amdgcn_rcpf(1.f + __expf(-bflo(gmw.x))); r0[1] = (1.f + __expf(-bfhi(gaw.x))) * __builtin_amdgcn_rcpf(1.f + __expf(-bfhi(gmw.x)));
                    r0[2] = (1.f + __expf(-bflo(gaw.y))) * __builtin_amdgcn_rcpf(1.f + __expf(-bflo(gmw.y))); r0[3] = (1.f + __expf(-bfhi(gaw.y))) * __builtin_amdgcn_rcpf(1.f + __expf(-bfhi(gmw.y)));
                    r1[0] = (1.f + __expf(-bflo(gaw.z))) * __builtin_amdgcn_rcpf(1.f + __expf(-bflo(gmw.z))); r1[1] = (1.f + __expf(-bfhi(gaw.z))) * __builtin_amdgcn_rcpf(1.f + __expf(-bfhi(gmw.z)));
                    r1[2] = (1.f + __expf(-bflo(gaw.w))) * __builtin_amdgcn_rcpf(1.f + __expf(-bflo(gmw.w))); r1[3] = (1.f + __expf(-bfhi(gaw.w))) * __builtin_amdgcn_rcpf(1.f + __expf(-bfhi(gmw.w)));
                    acc[ai][bj][m][0] *= r0; acc[ai][bj][m][1] *= r1;
                    asm volatile("" ::: "memory"); }
    }
    __device__ __forceinline__ void operator()(const f32x4 (&acc)[2][2][4][2], const Unit& u, int wr, int wc, int fr, int fq) const {
        int row0 = u.pm * BM + wr * 64 + fr, col0 = u.pn * BM + wc * 32 + 8 * fq; asm volatile("" : "+v"(row0), "+v"(col0));
#pragma unroll
        for (int ai = 0; ai < 2; ++ai)
#pragma unroll
            for (int m = 0; m < 4; ++m) { const size_t row = (size_t)(row0 + ai * HALF + m * 16); const bf16* zr = z + row * ZW + col0; bf16* rowp = O + row * D + col0;
#pragma unroll
                for (int bj = 0; bj < 2; ++bj) { float ga[8]; unpack8(*(const u32x4*)(zr + Z_GA + bj * HALF), ga);
                    float s[8];
#pragma unroll
                    for (int i = 0; i < 8; ++i) s[i] = __builtin_amdgcn_rcpf(1.f + __expf(-ga[i]));
                    const f32x4 v0 = acc[ai][bj][m][0] * (f32x4){s[0], s[1], s[2], s[3]}, v1 = acc[ai][bj][m][1] * (f32x4){s[4], s[5], s[6], s[7]};
                    u32x4 w; w.x = cvt_pk_bf16(v0[0], v0[1]); w.y = cvt_pk_bf16(v0[2], v0[3]); w.z = cvt_pk_bf16(v1[0], v1[1]); w.w = cvt_pk_bf16(v1[2], v1[3]);
                    *(u32x4*)(rowp + bj * HALF) = w; }
                asm volatile("" ::: "memory"); }
    }
};
struct EpiResidual {
    static constexpr bool PERM = false, HAS_MID = false; const float* xin; float* xout; const float* gmod;
    __device__ __forceinline__ void operator()(const f32x4 (&acc)[2][2][4][2], const Unit& u, int wr, int wc, int fr, int fq) const {
        int row0 = u.pm * BM + wr * 64 + fr, col0 = u.pn * BM + wc * 32 + 4 * fq; asm volatile("" : "+v"(row0), "+v"(col0)); const int b = (u.pm * BM) / SEQ;
        f32x4 gv[2][2];
#pragma unroll
        for (int bj = 0; bj < 2; ++bj)
#pragma unroll
            for (int n = 0; n < 2; ++n) gv[bj][n] = *(const f32x4*)(gmod + b * 6144 + col0 + bj * HALF + n * 16);
#pragma unroll
        for (int ai = 0; ai < 2; ++ai)
#pragma unroll
            for (int m = 0; m < 4; ++m) { const size_t off = (size_t)(row0 + ai * HALF + m * 16) * D + col0;
#pragma unroll
                for (int bj = 0; bj < 2; ++bj)
#pragma unroll
                    for (int n = 0; n < 2; ++n) { const f32x4 xo = *(const f32x4*)(xin + off + bj * HALF + n * 16); *(f32x4*)(xout + off + bj * HALF + n * 16) = xo + gv[bj][n] * acc[ai][bj][m][n]; }
                if (m & 1) asm volatile("" ::: "memory"); }
    }
};
struct EpiAct {
    static constexpr bool PERM = true, HAS_MID = false; bf16* O;
    __device__ __forceinline__ void operator()(const f32x4 (&acc)[2][2][4][2], const Unit& u, int wr, int wc, int fr, int fq) const {
        int row0 = u.pm * BM + wr * 64 + fr, col0 = u.pn * HALF + wc * 32 + 8 * fq; asm volatile("" : "+v"(row0), "+v"(col0));
#pragma unroll
        for (int ai = 0; ai < 2; ++ai)
#pragma unroll
            for (int m = 0; m < 4; ++m) { bf16* rowp = O + (size_t)(row0 + ai * HALF + m * 16) * DE + col0; float a[8];
#pragma unroll
                for (int n = 0; n < 2; ++n)
#pragma unroll
                    for (int i = 0; i < 4; ++i) { const float g = acc[ai][0][m][n][i], up = acc[ai][1][m][n][i]; a[4 * n + i] = g * __builtin_amdgcn_rcpf(1.f + __expf(-g)) * up; }
                u32x4 w; w.x = cvt_pk_bf16(a[0], a[1]); w.y = cvt_pk_bf16(a[2], a[3]); w.z = cvt_pk_bf16(a[4], a[5]); w.w = cvt_pk_bf16(a[6], a[7]);
                *(u32x4*)rowp = w; }
    }
};
}

#ifndef OPT_GEMM
#define OPT_GEMM 1
#endif
#ifndef OPT_MIX
#define OPT_MIX 1
#endif
constexpr int OFFS_LDS = 131072;
__device__ __forceinline__ void moe_offsets_lds(const Ctx& c, int l) {
    LAS int* offs = (LAS int*)(c.lds + OFFS_LDS);
    const unsigned* cnt = c.ctl() + CW_CNT + 64 * l;
    if (c.tid == 0) { int o = 0; for (int e = 0; e < NE; ++e) { offs[e] = o; o += (int)((__hip_atomic_load(cnt + e, __ATOMIC_RELAXED, __HIP_MEMORY_SCOPE_AGENT) + 255u) & ~255u); } offs[NE] = o; }
    __syncthreads();
}
__device__ __forceinline__ void phase_inproj_opt(const Ctx& c, int l) {
    const pg8::ProbPlain P{(const bf16*)(c.a.ws + WS_XA), (const bf16*)(c.wl(l) + W_IN), D}; pg8::StaticOrder S; S.init(T, ZW, c.G, c.bid);
    const pg8::EpiStoreBf16 E{(bf16*)(c.a.ws + WS_Z), ZW};
    pg8::gemm_phase<pg8::EpiStoreBf16, pg8::StaticOrder, pg8::ProbPlain, true, true>(c.lds, P, S, E);
}
__device__ __forceinline__ void phase_br_opt(const Ctx& c, int l) {
    const pg8::ProbPlain P{(const bf16*)(c.a.ws + WS_HCAT), (const bf16*)(c.wl(l) + W_BR), D}; pg8::StaticOrder S; S.init(T, D, c.G, c.bid);
    const pg8::EpiMerge E{(const bf16*)(c.a.ws + WS_Z), (bf16*)(c.a.ws + WS_XA)};
    pg8::gemm_phase<pg8::EpiMerge, pg8::StaticOrder, pg8::ProbPlain, true, true>(c.lds, P, S, E);
}
__device__ __forceinline__ void phase_out_opt(const Ctx& c, int l) {
    const pg8::ProbPlain P{(const bf16*)(c.a.ws + WS_XA), (const bf16*)(c.wl(l) + W_OUT), D}; pg8::StaticOrder S; S.init(T, D, c.G, c.bid);
    const pg8::EpiResidual E{l == 0 ? c.a.in[I_X] : c.a.out, c.a.out, c.mod(l) + 2048};
    pg8::gemm_phase<pg8::EpiResidual, pg8::StaticOrder, pg8::ProbPlain, true, true>(c.lds, P, S, E);
}
__device__ __forceinline__ void phase_g1_opt(const Ctx& c, int l) {
    moe_offsets_lds(c, l); const LAS int* offs = (const LAS int*)(c.lds + OFFS_LDS); const int R = offs[NE];
    const pg8::ProbMoeGather P{(const bf16*)(c.a.ws + WS_XA), (const bf16*)(c.wl(l) + W_GU), D, (const int*)(c.a.ws + WS_ROWTOK), offs, (size_t)1024 * D};
    pg8::StaticOrder S; S.init(R, 1024, c.G, c.bid);
    const pg8::EpiAct E{(bf16*)(c.a.ws + WS_ACT)};
    pg8::gemm_phase<pg8::EpiAct, pg8::StaticOrder, pg8::ProbMoeGather, true, true>(c.lds, P, S, E);
}
__device__ __forceinline__ void phase_g2_opt(const Ctx& c, int l) {
    moe_offsets_lds(c, l); const LAS int* offs = (const LAS int*)(c.lds + OFFS_LDS); const int R = offs[NE];
    const pg8::ProbMoePlain P{(const bf16*)(c.a.ws + WS_ACT), (const bf16*)(c.wl(l) + W_DN), DE, offs, (size_t)D * DE};
    pg8::StaticOrder S; S.init(R, D, c.G, c.bid);
    const pg8::EpiStoreBf16 E{(bf16*)(c.a.ws + WS_Y), D};
    pg8::gemm_phase<pg8::EpiStoreBf16, pg8::StaticOrder, pg8::ProbMoePlain, true, true>(c.lds, P, S, E);
}

__device__ __forceinline__ void unpack8_(const u32x4 w, float (&f)[8]) { f[0] = bflo(w.x); f[1] = bfhi(w.x); f[2] = bflo(w.y); f[3] = bfhi(w.y); f[4] = bflo(w.z); f[5] = bfhi(w.z); f[6] = bflo(w.w); f[7] = bfhi(w.w); }
typedef short bf16x8 __attribute__((ext_vector_type(8)));
typedef float f32x16 __attribute__((ext_vector_type(16)));
typedef float f32x2_t __attribute__((ext_vector_type(2)));
typedef __bf16 bf16x2_t __attribute__((ext_vector_type(2)));
#define MFMA32(a, b, c) __builtin_amdgcn_mfma_f32_32x32x16_bf16((a), (b), (c), 0, 0, 0)
__device__ __forceinline__ unsigned cvtpk(float lo, float hi) { f32x2_t v = {lo, hi}; bf16x2_t b = __builtin_convertvector(v, bf16x2_t); return __builtin_bit_cast(unsigned, b); }
__device__ __forceinline__ int crow(int i, int h) { return (i & 3) + 8 * (i >> 2) + 4 * h; }
template <int S> __device__ __forceinline__ bf16x8 pack_step(const f32x16& x) {
    u32x4 p; p.x = cvtpk(x[8 * S], x[8 * S + 1]); p.y = cvtpk(x[8 * S + 2], x[8 * S + 3]); p.z = cvtpk(x[8 * S + 4], x[8 * S + 5]); p.w = cvtpk(x[8 * S + 6], x[8 * S + 7]);
    return __builtin_bit_cast(bf16x8, p);
}
__device__ __forceinline__ float logsigmoidf_(float x) { return fminf(x, 0.f) - log1pf(__expf(-fabsf(x))); }
__device__ __forceinline__ float wave_incl_sum(float x, int lane) {
#pragma unroll
    for (int o = 1; o < 64; o <<= 1) { const float y = __shfl_up(x, o); x = (lane >= o) ? x + y : x; }
    return x;
}
__device__ __forceinline__ float wave_incl_max(float x, int lane) {
#pragma unroll
    for (int o = 1; o < 64; o <<= 1) { const float y = __shfl_up(x, o); x = (lane >= o) ? fmaxf(x, y) : x; }
    return x;
}
__device__ __forceinline__ float wave_max(float v) {
#pragma unroll
    for (int o = 1; o < 64; o <<= 1) v = fmaxf(v, __shfl_xor(v, o));
    return v;
}
constexpr size_t WS_NLOC = 3 * MiB;
constexpr size_t WS_MLOC = WS_NLOC + 256 * 1024;
constexpr size_t WS_BLAST = WS_MLOC + 4096;
constexpr size_t WS_MPREV = WS_BLAST + 4096;
static_assert(WS_MPREV + 4096 <= 4 * MiB, "mlstm small state");

__device__ __forceinline__ void swa_unit(const Ctx& c, int l, int u) {
    const int b = u >> 6, kh = (u >> 5) & 1, n = u & 31;
    LAS unsigned char* Ks = c.lds;
    LAS unsigned char* VT = c.lds + 36864;
    LAS float* BT = (LAS float*)(c.lds + 70144);
    const bf16* z = (const bf16*)(c.a.ws + WS_Z); bf16* hc = (bf16*)(c.a.ws + WS_HCAT);
    const size_t tblk = (size_t)b * SEQ + (size_t)n * 128;
#pragma unroll
    for (int it = 0; it < 4; ++it) { const int idx = c.tid + NT * it, row = idx >> 3, ch = idx & 7; const int srel = n * 128 - 128 + row;
        u32x4 kv = {0u, 0u, 0u, 0u}, vv = {0u, 0u, 0u, 0u};
        if (srel >= 0) { const bf16* zr = z + ((size_t)b * SEQ + srel) * ZW; kv = *(const u32x4*)(zr + Z_KA + kh * 64 + ch * 8); vv = *(const u32x4*)(zr + Z_VA + kh * 64 + ch * 8); }
        *(LAS u32x4*)(Ks + row * 144 + ch * 16) = kv;
        LAS unsigned short* vt = (LAS unsigned short*)(VT + (ch * 8) * 520 + row * 2);
        vt[0] = (unsigned short)(vv.x & 0xffffu); vt[260] = (unsigned short)(vv.x >> 16); vt[2 * 260] = (unsigned short)(vv.y & 0xffffu); vt[3 * 260] = (unsigned short)(vv.y >> 16);
        vt[4 * 260] = (unsigned short)(vv.z & 0xffffu); vt[5 * 260] = (unsigned short)(vv.z >> 16); vt[6 * 260] = (unsigned short)(vv.w & 0xffffu); vt[7 * 260] = (unsigned short)(vv.w >> 16); }
    { const int g = c.tid >> 7, dist = c.tid & 127; BT[c.tid] = c.a.in[I_RELB][T5_BUCKET[dist] * AH + kh * 4 + g]; }
    __syncthreads();
    const int r = c.lane & 31, hh = c.lane >> 5, g = c.wave >> 1, head = kh * 4 + g;
    const float sink = c.a.in[I_SINK][l * AH + head];
#pragma unroll 1
    for (int jj = 0; jj < 2; ++jj) {
        const int j = (c.wave & 1) * 2 + jj;
        const size_t tq = tblk + 32 * j + r;
        bf16x8 qf[4];
#pragma unroll
        for (int kk = 0; kk < 4; ++kk) qf[kk] = *(const bf16x8*)(z + tq * ZW + Z_QA + head * 64 + 16 * kk + 8 * hh);
        f32x16 X[5];
#pragma unroll
        for (int kt = 0; kt < 5; ++kt) { const int kb0 = 32 * (j + kt);
            f32x16 x = {0.f, 0.f, 0.f, 0.f, 0.f, 0.f, 0.f, 0.f, 0.f, 0.f, 0.f, 0.f, 0.f, 0.f, 0.f, 0.f};
#pragma unroll
            for (int kk = 0; kk < 4; ++kk) { const bf16x8 a = *(const LAS bf16x8*)(Ks + (kb0 + r) * 144 + 32 * kk + 16 * hh); x = MFMA32(a, qf[kk], x); }
            X[kt] = x; asm volatile("" ::: "memory"); }
        float mx = sink;
#pragma unroll
        for (int kt = 0; kt < 5; ++kt) {
#pragma unroll
            for (int i = 0; i < 16; ++i) { const int cr = crow(i, hh), dist = r + 128 - 32 * kt - cr, kb = 32 * (j + kt) + cr;
                const bool valid = (dist >= 0) && (dist < 128) && (n > 0 || kb >= 128);
                const float s = X[kt][i] * 0.125f + BT[g * 128 + (dist & 127)];
                X[kt][i] = valid ? s : -1e30f; mx = fmaxf(mx, X[kt][i]); }
            asm volatile("" ::: "memory"); }
        mx = fmaxf(mx, __shfl_xor(mx, 32));
        float ls = 0.f;
#pragma unroll
        for (int kt = 0; kt < 5; ++kt)
#pragma unroll
            for (int i = 0; i < 16; ++i) { const float p = __expf(X[kt][i] - mx); X[kt][i] = p; ls += p; }
        ls += __shfl_xor(ls, 32);
        const float inv = 1.f / (ls + __expf(sink - mx));
        f32x16 O0 = {0.f, 0.f, 0.f, 0.f, 0.f, 0.f, 0.f, 0.f, 0.f, 0.f, 0.f, 0.f, 0.f, 0.f, 0.f, 0.f}, O1 = O0;
#pragma unroll
        for (int kt = 0; kt < 5; ++kt) { const int kb0 = 32 * (j + kt);
            X[kt] = X[kt] * inv;
            const bf16x8 p0 = pack_step<0>(X[kt]), p1 = pack_step<1>(X[kt]);
            const LAS unsigned char* v0 = VT + r * 520 + (kb0 + 4 * hh) * 2; const LAS unsigned char* v1 = VT + (32 + r) * 520 + (kb0 + 4 * hh) * 2;
            { const u32x2 lo = *(const LAS u32x2*)(v0), hi = *(const LAS u32x2*)(v0 + 16); const u32x4 w = {lo.x, lo.y, hi.x, hi.y}; O0 = MFMA32(p0, __builtin_bit_cast(bf16x8, w), O0); }
            { const u32x2 lo = *(const LAS u32x2*)(v0 + 32), hi = *(const LAS u32x2*)(v0 + 48); const u32x4 w = {lo.x, lo.y, hi.x, hi.y}; O0 = MFMA32(p1, __builtin_bit_cast(bf16x8, w), O0); }
            { const u32x2 lo = *(const LAS u32x2*)(v1), hi = *(const LAS u32x2*)(v1 + 16); const u32x4 w = {lo.x, lo.y, hi.x, hi.y}; O1 = MFMA32(p0, __builtin_bit_cast(bf16x8, w), O1); }
            { const u32x2 lo = *(const LAS u32x2*)(v1 + 32), hi = *(const LAS u32x2*)(v1 + 48); const u32x4 w = {lo.x, lo.y, hi.x, hi.y}; O1 = MFMA32(p1, __builtin_bit_cast(bf16x8, w), O1); }
            asm volatile("" ::: "memory"); }
        bf16* ob = hc + (tblk + 32 * j) * D + 512 + head * 64 + r;
#pragma unroll
        for (int i = 0; i < 16; ++i) { const int q = crow(i, hh); ob[(size_t)q * D] = (bf16)f2bf(O0[i]); ob[(size_t)q * D + 32] = (bf16)f2bf(O1[i]); }
    }
    __syncthreads();
}

struct ChunkGates { float ig, bcum, blast; };
__device__ __forceinline__ ChunkGates chunk_gates(const Ctx& c, size_t t0, int h) {
    const float* IFG = (const float*)(c.a.ws + WS_IFG);
    ChunkGates g; g.ig = IFG[(t0 + c.lane) * 8 + h]; const float fp = IFG[(t0 + c.lane) * 8 + 4 + h];
    g.bcum = wave_incl_sum(logsigmoidf_(fp), c.lane); g.blast = __shfl(g.bcum, 63); return g;
}
__device__ __forceinline__ void conv8(const Ctx& c, int l, const bf16* zrow, int spos, int zc0, int cc0, float scale, float (&out)[8]) {
    const float* cw = c.a.in[I_CONVW] + (size_t)l * 4 * 512 + cc0; const float* cb = c.a.in[I_CONVB] + l * 512 + cc0;
    { const f32x4 b0 = *(const f32x4*)cb, b1 = *(const f32x4*)(cb + 4); out[0] = b0.x; out[1] = b0.y; out[2] = b0.z; out[3] = b0.w; out[4] = b1.x; out[5] = b1.y; out[6] = b1.z; out[7] = b1.w; }
#pragma unroll
    for (int j = 0; j < 4; ++j) { const int sj = spos - 3 + j;
        if (sj >= 0) { float zv[8]; unpack8_(*(const u32x4*)(zrow + (ptrdiff_t)(j - 3) * ZW + zc0), zv);
            const f32x4 w0 = *(const f32x4*)(cw + j * 512), w1 = *(const f32x4*)(cw + j * 512 + 4);
            out[0] += w0.x * zv[0]; out[1] += w0.y * zv[1]; out[2] += w0.z * zv[2]; out[3] += w0.w * zv[3]; out[4] += w1.x * zv[4]; out[5] += w1.y * zv[5]; out[6] += w1.z * zv[6]; out[7] += w1.w * zv[7]; } }
#pragma unroll
    for (int i = 0; i < 8; ++i) out[i] = siluf_(out[i]) * scale;
}

__device__ __forceinline__ void mlstm_local_unit(const Ctx& c, int l, int u) {
    const int b = u >> 8, h = (u >> 6) & 3, ch = u & 63;
    const size_t t0 = (size_t)b * SEQ + (size_t)ch * 64;
    LAS unsigned char* kT = c.lds;
    LAS unsigned char* avT = c.lds + 9216;
    LAS float* a_l = (LAS float*)(c.lds + 27648);
    const bf16* z = (const bf16*)(c.a.ws + WS_Z);
    const ChunkGates g = chunk_gates(c, t0, h);
    const float w = g.blast - g.bcum + g.ig; const float mloc = wave_max(w); const float a = __expf(w - mloc);
    if (c.wave == 0) a_l[c.lane] = a;
    { const int lp = c.tid >> 3, c8 = c.tid & 7; float kc[8];
      conv8(c, l, z + (t0 + lp) * ZW, ch * 64 + lp, Z_KM + h * 64 + c8 * 8, 256 + h * 64 + c8 * 8, 1.f, kc);
      LAS unsigned short* d = (LAS unsigned short*)(kT + (c8 * 8) * 144 + lp * 2);
#pragma unroll
      for (int i = 0; i < 8; ++i) d[i * 72] = (unsigned short)f2bf(kc[i]); }
    __syncthreads();
#pragma unroll
    for (int it = 0; it < 2; ++it) { const int idx = c.tid + NT * it, lp = idx >> 4, c16 = idx & 15; float vv[8]; unpack8_(*(const u32x4*)(z + (t0 + lp) * ZW + Z_VM + h * 128 + c16 * 8), vv);
        const float al = a_l[lp]; LAS unsigned short* d = (LAS unsigned short*)(avT + (c16 * 8) * 144 + lp * 2);
#pragma unroll
        for (int i = 0; i < 8; ++i) d[i * 72] = (unsigned short)f2bf(vv[i] * al); }
    __syncthreads();
    const int r = c.lane & 31, hh = c.lane >> 5, dt = c.wave >> 1, et = c.wave & 1;
    f32x16 acc = {0.f, 0.f, 0.f, 0.f, 0.f, 0.f, 0.f, 0.f, 0.f, 0.f, 0.f, 0.f, 0.f, 0.f, 0.f, 0.f};
#pragma unroll
    for (int kk = 0; kk < 4; ++kk) { const bf16x8 af = *(const LAS bf16x8*)(avT + (32 * dt + r) * 144 + 32 * kk + 16 * hh), bfr = *(const LAS bf16x8*)(kT + (32 * et + r) * 144 + 32 * kk + 16 * hh); acc = MFMA32(af, bfr, acc); }
    float* CL = (float*)(c.a.ws + WS_XA) + (size_t)u * 8192;
#pragma unroll
    for (int i = 0; i < 16; ++i) CL[(32 * dt + crow(i, hh)) * 64 + 32 * et + r] = acc[i];
    if (c.tid < 64) { float s = 0.f; const LAS unsigned short* kr = (const LAS unsigned short*)(kT + c.tid * 144);
#pragma unroll 8
        for (int lp = 0; lp < 64; ++lp) s += a_l[lp] * bf2f(kr[lp]);
        ((float*)(c.a.ws + WS_NLOC))[(size_t)u * 64 + c.tid] = s;
        if (c.tid == 0) { ((float*)(c.a.ws + WS_MLOC))[u] = mloc; ((float*)(c.a.ws + WS_BLAST))[u] = g.blast; } }
    __syncthreads();
}

__device__ __forceinline__ void phase_scan(const Ctx& c) {
    LAS float* ml = (LAS float*)c.lds; LAS float* bl = ml + 64;
    for (int w = c.bid; w < 256; w += c.G) {
        const int bh = w >> 4, slice = w & 15;
        __syncthreads();
        if (c.tid < 64) { ml[c.tid] = ((const float*)(c.a.ws + WS_MLOC))[bh * 64 + c.tid]; bl[c.tid] = ((const float*)(c.a.ws + WS_BLAST))[bh * 64 + c.tid]; }
        __syncthreads();
        float* CL = (float*)(c.a.ws + WS_XA) + (size_t)bh * 64 * 8192 + slice * 512 + c.tid;
        float x[64];
#pragma unroll
        for (int ch = 0; ch < 64; ++ch) x[ch] = CL[(size_t)ch * 8192];
        float m = 0.f, C = 0.f;
#pragma unroll
        for (int ch = 0; ch < 64; ++ch) { CL[(size_t)ch * 8192] = C;
            const float mn = fmaxf(bl[ch] + m, ml[ch]); const float dec = __expf(bl[ch] + m - mn), fr = __expf(ml[ch] - mn);
            C = dec * C + fr * x[ch]; m = mn; }
        if (slice == 0 && c.tid < 64) { float* NL = (float*)(c.a.ws + WS_NLOC) + (size_t)bh * 64 * 64 + c.tid; float* MP = (float*)(c.a.ws + WS_MPREV) + bh * 64;
            float mm = 0.f, nn = 0.f;
#pragma unroll 4
            for (int ch = 0; ch < 64; ++ch) { const float xv = NL[ch * 64]; NL[ch * 64] = nn; if (c.tid == 0) MP[ch] = mm;
                const float mn = fmaxf(bl[ch] + mm, ml[ch]); const float dec = __expf(bl[ch] + mm - mn), fr = __expf(ml[ch] - mn);
                nn = dec * nn + fr * xv; mm = mn; } }
    }
    __syncthreads();
}

__device__ __forceinline__ void mlstm_out_unit(const Ctx& c, int l, int u) {
    const int b = u >> 8, h = (u >> 6) & 3, ch = u & 63;
    const size_t t0 = (size_t)b * SEQ + (size_t)ch * 64;
    LAS unsigned char* qs = c.lds;
    LAS unsigned char* qis = c.lds + 9216;
    LAS unsigned char* ks = c.lds + 18432;
    LAS unsigned char* vT = c.lds + 27648;
    LAS float* T_bm = (LAS float*)(c.lds + 46080);
    LAS float* T_g = T_bm + 64;
    LAS float* T_em = T_bm + 128;
    LAS float* T_np = T_bm + 192;
    LAS float* T_ri = T_bm + 256;
    LAS float* hbuf = (LAS float*)(c.lds + 47616);
    const bf16* z = (const bf16*)(c.a.ws + WS_Z); bf16* hc = (bf16*)(c.a.ws + WS_HCAT);
    const ChunkGates g = chunk_gates(c, t0, h);
    const float mprev = ((const float*)(c.a.ws + WS_MPREV))[u];
    const float gg = g.ig - g.bcum; const float pm = wave_incl_max(gg, c.lane);
    const float mrow = g.bcum + fmaxf(mprev, pm); const float inter = __expf(g.bcum + mprev - mrow);
    if (c.wave == 0) { T_bm[c.lane] = g.bcum - mrow; T_g[c.lane] = gg; T_em[c.lane] = __expf(-mrow); T_np[c.lane] = ((const float*)(c.a.ws + WS_NLOC))[(size_t)u * 64 + c.lane]; }
    { const int lp = c.tid >> 3, c8 = c.tid & 7; float qc[8], kc[8]; const bf16* zr = z + (t0 + lp) * ZW;
      conv8(c, l, zr, ch * 64 + lp, Z_QM + h * 64 + c8 * 8, h * 64 + c8 * 8, 0.125f, qc);
      conv8(c, l, zr, ch * 64 + lp, Z_KM + h * 64 + c8 * 8, 256 + h * 64 + c8 * 8, 1.f, kc);
      const float il = __shfl(inter, lp);
      u32x4 w; w.x = cvtpk(qc[0], qc[1]); w.y = cvtpk(qc[2], qc[3]); w.z = cvtpk(qc[4], qc[5]); w.w = cvtpk(qc[6], qc[7]); *(LAS u32x4*)(qs + lp * 144 + c8 * 16) = w;
      w.x = cvtpk(qc[0] * il, qc[1] * il); w.y = cvtpk(qc[2] * il, qc[3] * il); w.z = cvtpk(qc[4] * il, qc[5] * il); w.w = cvtpk(qc[6] * il, qc[7] * il); *(LAS u32x4*)(qis + lp * 144 + c8 * 16) = w;
      w.x = cvtpk(kc[0], kc[1]); w.y = cvtpk(kc[2], kc[3]); w.z = cvtpk(kc[4], kc[5]); w.w = cvtpk(kc[6], kc[7]); *(LAS u32x4*)(ks + lp * 144 + c8 * 16) = w; }
#pragma unroll
    for (int it = 0; it < 2; ++it) { const int idx = c.tid + NT * it, lp = idx >> 4, c16 = idx & 15; const u32x4 vv = *(const u32x4*)(z + (t0 + lp) * ZW + Z_VM + h * 128 + c16 * 8);
        LAS unsigned short* d = (LAS unsigned short*)(vT + (c16 * 8) * 144 + lp * 2);
        d[0] = (unsigned short)(vv.x & 0xffffu); d[72] = (unsigned short)(vv.x >> 16); d[2 * 72] = (unsigned short)(vv.y & 0xffffu); d[3 * 72] = (unsigned short)(vv.y >> 16);
        d[4 * 72] = (unsigned short)(vv.z & 0xffffu); d[5 * 72] = (unsigned short)(vv.z >> 16); d[6 * 72] = (unsigned short)(vv.w & 0xffffu); d[7 * 72] = (unsigned short)(vv.w >> 16); }
    __syncthreads();
    const int r = c.lane & 31, hh = c.lane >> 5, lt = c.wave >> 2, dt = c.wave & 3;
    f32x16 acc = {0.f, 0.f, 0.f, 0.f, 0.f, 0.f, 0.f, 0.f, 0.f, 0.f, 0.f, 0.f, 0.f, 0.f, 0.f, 0.f};
    float den = 0.f;
    const float bm = T_bm[32 * lt + r];
#pragma unroll
    for (int st = 0; st < 2; ++st) { if (st <= lt) {
        f32x16 X = {0.f, 0.f, 0.f, 0.f, 0.f, 0.f, 0.f, 0.f, 0.f, 0.f, 0.f, 0.f, 0.f, 0.f, 0.f, 0.f};
#pragma unroll
        for (int kk = 0; kk < 4; ++kk) { const bf16x8 af = *(const LAS bf16x8*)(ks + (32 * st + r) * 144 + 32 * kk + 16 * hh), bfr = *(const LAS bf16x8*)(qs + (32 * lt + r) * 144 + 32 * kk + 16 * hh); X = MFMA32(af, bfr, X); }
#pragma unroll
        for (int i = 0; i < 16; ++i) { const int s = 32 * st + crow(i, hh); const float wgt = (s <= 32 * lt + r) ? __expf(bm + T_g[s]) : 0.f; X[i] *= wgt; den += X[i]; }
        const bf16x8 p0 = pack_step<0>(X), p1 = pack_step<1>(X);
        const LAS unsigned char* v0 = vT + (32 * dt + r) * 144 + (32 * st + 4 * hh) * 2;
        { const u32x2 lo = *(const LAS u32x2*)(v0), hi = *(const LAS u32x2*)(v0 + 16); const u32x4 w = {lo.x, lo.y, hi.x, hi.y}; acc = MFMA32(p0, __builtin_bit_cast(bf16x8, w), acc); }
        { const u32x2 lo = *(const LAS u32x2*)(v0 + 32), hi = *(const LAS u32x2*)(v0 + 48); const u32x4 w = {lo.x, lo.y, hi.x, hi.y}; acc = MFMA32(p1, __builtin_bit_cast(bf16x8, w), acc); } } }
    { const float* CP = (const float*)(c.a.ws + WS_XA) + (size_t)u * 8192 + (size_t)(32 * dt + r) * 64 + 8 * hh;
#pragma unroll
      for (int kk = 0; kk < 4; ++kk) { const f32x4 c0 = *(const f32x4*)(CP + 16 * kk), c1 = *(const f32x4*)(CP + 16 * kk + 4);
          u32x4 w; w.x = cvtpk(c0.x, c0.y); w.y = cvtpk(c0.z, c0.w); w.z = cvtpk(c1.x, c1.y); w.w = cvtpk(c1.z, c1.w);
          const bf16x8 af = *(const LAS bf16x8*)(qis + (32 * lt + r) * 144 + 32 * kk + 16 * hh); acc = MFMA32(af, __builtin_bit_cast(bf16x8, w), acc); } }
    { const LAS unsigned char* qr = qis + (32 * lt + r) * 144 + 64 * hh;
#pragma unroll
      for (int q4 = 0; q4 < 4; ++q4) { float qv[8]; unpack8_(*(const LAS u32x4*)(qr + 16 * q4), qv);
#pragma unroll
          for (int i = 0; i < 8; ++i) den += qv[i] * T_np[32 * hh + 8 * q4 + i]; } }
    den += __shfl_xor(den, 32);
    if (hh == 0) T_ri[32 * lt + r] = 1.f / fmaxf(fabsf(den), T_em[32 * lt + r]);
    asm volatile("s_waitcnt lgkmcnt(0)" ::: "memory");
#pragma unroll
    for (int i = 0; i < 16; ++i) { const int lr = 32 * lt + crow(i, hh); hbuf[lr * 132 + 32 * dt + r] = acc[i] * T_ri[lr]; }
    __syncthreads();
    { const int lp = c.tid >> 3, part = c.tid & 7; const LAS float* hr = hbuf + lp * 132 + part * 16; float hv[16]; float ss = 0.f;
#pragma unroll
      for (int q4 = 0; q4 < 4; ++q4) { const f32x4 v = *(const LAS f32x4*)(hr + 4 * q4); hv[4 * q4] = v.x; hv[4 * q4 + 1] = v.y; hv[4 * q4 + 2] = v.z; hv[4 * q4 + 3] = v.w; ss += (v.x * v.x + v.y * v.y) + (v.z * v.z + v.w * v.w); }
      ss += __shfl_xor(ss, 1); ss += __shfl_xor(ss, 2); ss += __shfl_xor(ss, 4);
      const float rstd = rsqrtf(ss * (1.f / 128.f) + EPS);
      const int col = h * 128 + part * 16; const float* wm = c.a.in[I_WMN] + l * 512 + col;
      const bf16* og = z + (t0 + lp) * ZW + Z_OM + col; bf16* op = hc + (t0 + lp) * D + col;
#pragma unroll
      for (int q8 = 0; q8 < 2; ++q8) { float o8[8]; unpack8_(*(const u32x4*)(og + 8 * q8), o8); const f32x4 w0 = *(const f32x4*)(wm + 8 * q8), w1 = *(const f32x4*)(wm + 8 * q8 + 4);
          const float wv[8] = {w0.x, w0.y, w0.z, w0.w, w1.x, w1.y, w1.z, w1.w}; float ov[8];
#pragma unroll
          for (int i = 0; i < 8; ++i) ov[i] = hv[8 * q8 + i] * rstd * wv[i] * sigmoidf_(o8[i]);
          u32x4 w; w.x = cvtpk(ov[0], ov[1]); w.y = cvtpk(ov[2], ov[3]); w.z = cvtpk(ov[4], ov[5]); w.w = cvtpk(ov[6], ov[7]); *(u32x4*)(op + 8 * q8) = w; } }
    __syncthreads();
}

#ifndef OPT_SWA
#define OPT_SWA 1
#endif
#ifndef OPT_MLSTM
#define OPT_MLSTM 1
#endif
__device__ __forceinline__ void phase_mix1_opt(const Ctx& c, int l) {
    if (OPT_SWA) { for (int u = c.bid; u < NB * AKV * 32; u += c.G) swa_unit(c, l, u); } else naive_swa(c, l, 0);
    if (OPT_MLSTM) { for (int u = c.bid * 4; u < NB * MH * 64; u += c.G * 4) for (int k = 0; k < 4; ++k) mlstm_local_unit(c, l, u + k); }
    else if (c.bid < 16) naive_mlstm(c, l, c.bid);
}
__device__ __forceinline__ void phase_mix2_opt(const Ctx& c, int l) {
    if (OPT_MLSTM) { for (int u = c.bid * 4; u < NB * MH * 64; u += c.G * 4) for (int k = 0; k < 4; ++k) mlstm_out_unit(c, l, u + k); }
    else phase_mix2(c, l);
}

#define XB_TMO      128
#define XB_XCNT(j)  (256  + 64 * (j))
#define XB_XSUB(j)  (1280 + 64 * (j))
#define XB_XGEN(j)  (2304 + 64 * (j))
#define XB_TOP      3328
#define XB_TOPGEN   3392
#define XCD_BAR_WORDS 3456
#define XB_SPIN_CAP (1u << 22)
constexpr int CW_BAR = 8192;
__device__ __forceinline__ unsigned xb_ld(unsigned* p)              { return __hip_atomic_load(p, __ATOMIC_RELAXED, __HIP_MEMORY_SCOPE_AGENT); }
__device__ __forceinline__ unsigned xb_add(unsigned* p, unsigned v) { return __hip_atomic_fetch_add(p, v, __ATOMIC_RELAXED, __HIP_MEMORY_SCOPE_AGENT); }
__device__ __forceinline__ unsigned xb_xcc_id() { return (unsigned)__builtin_amdgcn_s_getreg((3 << 11) | 20) & 0xFu; }
#define XB_SPIN(cond, bar) do { unsigned _sp = 0; while (cond) { __builtin_amdgcn_s_sleep(1); \
    if ((++_sp & 255u) == 0u) { if (xb_ld(&(bar)[XB_TMO])) break; if (_sp > XB_SPIN_CAP) { atomicAdd(&(bar)[XB_TMO], 1u); break; } } } } while (0)
struct XcdBarrier { unsigned* bar; unsigned x; volatile LAS unsigned* st; };
__device__ __forceinline__ XcdBarrier xcd_barrier_post(unsigned* bar, volatile LAS unsigned* st) {
    XcdBarrier b; b.bar = bar; b.x = xb_xcc_id(); b.st = st;
    if (threadIdx.x == 0) { (void)xb_add(&bar[XB_XCNT(b.x)], 1u); st[2] = b.x; }
    return b;
}
__device__ __forceinline__ void xcd_barrier_complete(unsigned* bar, unsigned x, unsigned& nloc, unsigned& nx) {
    const unsigned G = gridDim.x * gridDim.y * gridDim.z;
    unsigned sum, cnt, mine, sp = 0u;
    for (;;) {
        sum = 0u; cnt = 0u; mine = 0u;
#pragma unroll
        for (unsigned j = 0; j < 16; ++j) { const unsigned c = xb_ld(&bar[XB_XCNT(j)]); sum += c; cnt += (c > 0u) ? 1u : 0u; mine = (j == x) ? c : mine; }
        if (sum == G) break;
        __builtin_amdgcn_s_sleep(1);
        if ((++sp & 255u) == 0u) { if (xb_ld(&bar[XB_TMO])) break; if (sp > XB_SPIN_CAP) { atomicAdd(&bar[XB_TMO], 1u); break; } }
    }
    nloc = mine > 0u ? mine : 1u; nx = cnt > 0u ? cnt : 1u;
}
__device__ __forceinline__ void xcd_barrier(const XcdBarrier& b) {
    asm volatile("s_waitcnt vmcnt(0)" ::: "memory");
    __syncthreads();
    if (threadIdx.x == 0) {
        unsigned* bar = b.bar;
        __builtin_amdgcn_s_waitcnt(0);
        unsigned nloc = b.st[0], nx = b.st[1]; const unsigned bx = b.st[2];
        if (nloc == 0u) { xcd_barrier_complete(bar, bx, nloc, nx); b.st[0] = nloc; b.st[1] = nx; }
        const unsigned old = xb_add(&bar[XB_XSUB(bx)], 1u);
        const unsigned gen = old / nloc;
        if (old + 1u == (gen + 1u) * nloc) {
            __builtin_amdgcn_fence(__ATOMIC_RELEASE, "agent");
            asm volatile("s_waitcnt vmcnt(0)" ::: "memory");
            const unsigned og = xb_add(&bar[XB_TOP], 1u);
            const unsigned tg = og / nx;
            if (og + 1u == (tg + 1u) * nx) xb_add(&bar[XB_TOPGEN], 1u);
            else XB_SPIN(xb_ld(&bar[XB_TOPGEN]) == tg, bar);
            __builtin_amdgcn_fence(__ATOMIC_ACQUIRE, "agent");
            xb_add(&bar[XB_XGEN(bx)], 1u);
            asm volatile("s_waitcnt vmcnt(0)" ::: "memory");
        } else {
            XB_SPIN(xb_ld(&bar[XB_XGEN(bx)]) == gen, bar);
            __builtin_amdgcn_fence(__ATOMIC_ACQUIRE, "agent");
            asm volatile("s_waitcnt vmcnt(0)" ::: "memory");
        }
    }
    __syncthreads();
}

constexpr int MISC_OFF = 143360 + 320;
#ifndef MK_MULTI
#define MK_MULTI 0
#endif
constexpr int PH_PER_LAYER = 11, NPHASES = 1 + DEPTH * PH_PER_LAYER;
__device__ __forceinline__ void run_phase(const Ctx& c, int l, int p) {
    switch (p) {
        case 0: phase_xn(c, l); break;
        case 1: phase_inproj(c, l); break;
        case 2: phase_mix1(c, l); break;
        case 3: phase_mix2(c, l); break;
        case 4: phase_br(c, l); break;
        case 5: phase_out(c, l); break;
        case 6: phase_route(c, l); break;
        case 7: phase_fill(c, l); break;
        case 8: phase_g1(c, l); break;
        case 9: phase_g2(c, l); break;
        case 10: phase_combine(c, l); break;
    }
}
__global__ void __launch_bounds__(NT, 2) mega(Args a) {
    extern __shared__ __attribute__((aligned(16))) unsigned char lds_raw[];
    Ctx c; c.a = a; c.lds = (LAS unsigned char*)lds_raw; c.tid = threadIdx.x; c.lane = c.tid & 63; c.wave = __builtin_amdgcn_readfirstlane(c.tid >> 6); c.G = gridDim.x; c.bid = blockIdx.x;
#if MK_MULTI
    { const int ph = a.ph_lo; if (ph == 0) { phase_prologue(c); return; } run_phase(c, (ph - 1) / PH_PER_LAYER, (ph - 1) % PH_PER_LAYER); }
#else
    volatile LAS unsigned* MISC = (volatile LAS unsigned*)(c.lds + MISC_OFF);
    if (c.tid < 32) MISC[c.tid] = 0u;
    __syncthreads();
    const XcdBarrier bar = xcd_barrier_post(c.ctl() + CW_BAR, MISC + 8);
#ifndef REP_PHASE
#define REP_PHASE -1
#endif
#ifndef REP_N
#define REP_N 1
#endif
#define PH(call) do { Ctx f = c; asm volatile("" : "+v"(f.tid)); f.lane = f.tid & 63; f.wave = __builtin_amdgcn_readfirstlane(f.tid >> 6); { const Ctx& c = f; call; } } while (0)
#define RP(id, call) do { for (int rep_ = 0; rep_ < ((id) == REP_PHASE ? REP_N : 1); ++rep_) { PH(call); xcd_barrier(bar); } } while (0)
    RP(0, phase_prologue(c));
#pragma unroll 1
    for (int l = 0; l < DEPTH; ++l) {
        RP(1, phase_xn(c, l));
        if (OPT_GEMM) RP(2, phase_inproj_opt(c, l)); else RP(2, phase_inproj(c, l));
        if (OPT_MIX) { RP(3, phase_mix1_opt(c, l)); if (OPT_MLSTM) { RP(4, phase_scan(c)); } RP(5, phase_mix2_opt(c, l)); }
        else { RP(3, phase_mix1(c, l)); RP(5, phase_mix2(c, l)); }
        if (OPT_GEMM) RP(6, phase_br_opt(c, l)); else RP(6, phase_br(c, l));
        if (OPT_GEMM) RP(7, phase_out_opt(c, l)); else RP(7, phase_out(c, l));
        RP(8, phase_route(c, l));
        RP(9, phase_fill(c, l));
        if (OPT_GEMM) RP(10, phase_g1_opt(c, l)); else RP(10, phase_g1(c, l));
        if (OPT_GEMM) RP(11, phase_g2_opt(c, l)); else RP(11, phase_g2(c, l));
        PH(phase_combine(c, l)); if (l + 1 < DEPTH) xcd_barrier(bar);
    }
#undef RP
#undef PH
#endif
}

extern "C" void kernel_launch(void* const* d_in, const int* in_sizes, int n_in, void* d_out, int out_size, void* d_ws, size_t ws_size, hipStream_t stream) {
    static int grid = 0;
    if (grid == 0) {
        if (n_in != 23 || out_size != T * D || ws_size < WS_END) { fprintf(stderr, "kernel_launch: unexpected shapes (n_in %d out %d ws %zu need %zu)\n", n_in, out_size, ws_size, (size_t)WS_END); grid = -1; return; }
        int dev = 0, cus = 0, per_cu = 0;
        if (hipGetDevice(&dev) != hipSuccess || hipDeviceGetAttribute(&cus, hipDeviceAttributeMultiprocessorCount, dev) != hipSuccess) { grid = -1; return; }
        if (hipFuncSetAttribute((const void*)mega, hipFuncAttributeMaxDynamicSharedMemorySize, LDS_BYTES) != hipSuccess) { grid = -1; return; }
        if (hipOccupancyMaxActiveBlocksPerMultiprocessor(&per_cu, (const void*)mega, NT, LDS_BYTES) != hipSuccess || per_cu < 1) { fprintf(stderr, "kernel_launch: occupancy query says %d blocks per CU\n", per_cu); (void)hipGetLastError(); grid = -1; return; }
        grid = cus;
    }
    if (grid < 0) return;
    (void)hipMemsetAsync((char*)d_ws + WS_CTL, 0, CTL_BYTES, stream);
    Args a{};
    for (int i = 0; i < 23; ++i) a.in[i] = (const float*)d_in[i];
    a.out = (float*)d_out; a.ws = (unsigned char*)d_ws;
#if MK_MULTI
    for (int ph = 0; ph < NPHASES; ++ph) { a.ph_lo = ph; a.ph_hi = ph + 1; hipLaunchKernelGGL(mega, dim3(grid), dim3(NT), LDS_BYTES, stream, a); }
#else
    a.ph_lo = 0; a.ph_hi = NPHASES;
    hipLaunchKernelGGL(mega, dim3(grid), dim3(NT), LDS_BYTES, stream, a);
#endif
}
```

```cpp
#include <hip/hip_runtime.h>
#include <cstdio>
#include <cstdint>

constexpr int NB = 4, SEQ = 4096, T = NB * SEQ, D = 1024, DEPTH = 2;
constexpr int MH = 4, DQK = 64, DV = 128;
constexpr int AH = 8, AKV = 2, AD = 64;
constexpr int NE = 16, DE = 512;
constexpr int D_IN = 4360, ZW = 4352;
constexpr int Z_QM = 0, Z_KM = 256, Z_VM = 512, Z_OM = 1024, Z_QA = 1536, Z_KA = 2048, Z_VA = 2176, Z_GM = 2304, Z_GA = 3328;
constexpr float EPS = 1e-6f;
constexpr int MOE_ROWS = 2 * T + NE * 256;

constexpr size_t MiB = 1u << 20;
constexpr size_t WS_CTL = 0, CTL_BYTES = 1 * MiB;
constexpr size_t WS_MOD = 1 * MiB;
constexpr size_t WS_IFG = WS_MOD + 256 * 1024;
constexpr size_t WS_RIDX = WS_IFG + 512 * 1024;
constexpr size_t WS_RW = WS_RIDX + 128 * 1024;
constexpr size_t WS_SLOT = WS_RW + 128 * 1024;
constexpr size_t WS_ROWTOK = WS_SLOT + 128 * 1024;
constexpr size_t WS_RANK = WS_ROWTOK + 256 * 1024;
constexpr size_t WS_WGCNT = WS_RANK + 128 * 1024;
constexpr size_t WS_SMALL_END = WS_WGCNT + 32 * 1024;
static_assert(WS_SMALL_END <= 3 * MiB, "small region");
constexpr size_t WS_W = 4 * MiB;
constexpr size_t W_IN = 0;
constexpr size_t W_BR = W_IN + (size_t)ZW * D * 2;
constexpr size_t W_OUT = W_BR + (size_t)D * D * 2;
constexpr size_t W_GU = W_OUT + (size_t)D * D * 2;
constexpr size_t W_DN = W_GU + (size_t)NE * 1024 * D * 2;
constexpr size_t LAYER_W = W_DN + (size_t)NE * D * DE * 2;
constexpr size_t WS_Z = WS_W + 2 * LAYER_W;
constexpr size_t WS_ACT = WS_Z;
constexpr size_t WS_Y = WS_ACT + (size_t)MOE_ROWS * DE * 2;
constexpr size_t WS_XA = WS_Z + (size_t)T * ZW * 2;
constexpr size_t WS_HCAT = WS_XA + (size_t)T * D * 2;
constexpr size_t WS_END = WS_HCAT + (size_t)T * D * 2;
static_assert(WS_Y + (size_t)MOE_ROWS * D * 2 <= WS_XA, "MoE overlay fits in z");
constexpr int CW_CNT = 1024;
constexpr int CW_CUR = 2048;

typedef unsigned short bf16;
typedef float f32x4 __attribute__((ext_vector_type(4)));
typedef unsigned u32x4 __attribute__((ext_vector_type(4)));
typedef unsigned u32x2 __attribute__((ext_vector_type(2)));
#define LAS __attribute__((address_space(3)))

__device__ __forceinline__ unsigned f2bf(float f) { unsigned u = __builtin_bit_cast(unsigned, f); return (u + 0x7fffu + ((u >> 16) & 1u)) >> 16; }
__device__ __forceinline__ unsigned pk2(float lo, float hi) { return f2bf(lo) | (f2bf(hi) << 16); }
__device__ __forceinline__ float bf2f(unsigned b) { return __builtin_bit_cast(float, b << 16); }
__device__ __forceinline__ float bflo(unsigned w) { return __builtin_bit_cast(float, w << 16); }
__device__ __forceinline__ float bfhi(unsigned w) { return __builtin_bit_cast(float, w & 0xffff0000u); }
__device__ __forceinline__ float sigmoidf_(float x) { return 1.f / (1.f + __expf(-x)); }
__device__ __forceinline__ float siluf_(float x) { return x / (1.f + __expf(-x)); }
__device__ __forceinline__ float wave_sum(float v) {
#pragma unroll
    for (int o = 1; o < 64; o <<= 1) v += __shfl_xor(v, o);
    return v;
}

__device__ const unsigned char T5_BUCKET[128] = {0,1,2,3,4,5,6,7,8,9,10,11,12,13,14,15,16,16,16,17,17,18,18,18,19,19,19,20,20,20,20,21,21,21,21,22,22,22,22,22,23,23,23,23,23,23,24,24,24,24,24,24,25,25,25,25,25,25,25,26,26,26,26,26,26,26,26,27,27,27,27,27,27,27,27,27,27,28,28,28,28,28,28,28,28,28,28,29,29,29,29,29,29,29,29,29,29,29,29,30,30,30,30,30,30,30,30,30,30,30,30,30,30,31,31,31,31,31,31,31,31,31,31,31,31,31,31,31};

struct Args {
    const float* in[23];
    float* out; unsigned char* ws;
    int ph_lo, ph_hi;
};
enum { I_X = 0, I_C, I_WADA, I_BADA, I_WN1, I_WIN, I_CONVW, I_CONVB, I_BIG, I_BFG, I_WMN, I_SINK, I_RELB, I_WBRM, I_WBRA, I_WOUT, I_WN2, I_WR, I_RB, I_WG, I_WU, I_WD, I_WF };

constexpr int NT = 512, NWAVES = 8;
constexpr int LDS_BYTES = 147456;

struct Ctx {
    Args a; LAS unsigned char* lds; int tid, lane, wave, G, bid;
    __device__ __forceinline__ unsigned* ctl() const { return (unsigned*)(a.ws + WS_CTL); }
    __device__ __forceinline__ float* mod(int l) const { return (float*)(a.ws + WS_MOD) + (size_t)l * 4 * 6144; }
    __device__ __forceinline__ unsigned char* wl(int l) const { return a.ws + WS_W + (size_t)l * LAYER_W; }
};

__device__ __forceinline__ void conv_tile(const float* src, int ldsrc, int k0, int n_src0, bf16* dst, int ldd, int dst_row0, LAS float* scr, int lane) {
#pragma unroll 4
    for (int i = 0; i < 16; ++i) { const int kk = 4 * i + (lane >> 4); const f32x4 v = *(const f32x4*)(src + (size_t)(k0 + kk) * ldsrc + n_src0 + 4 * (lane & 15));
        LAS float* p = scr + kk * 65 + 4 * (lane & 15); p[0] = v.x; p[1] = v.y; p[2] = v.z; p[3] = v.w; }
    asm volatile("s_waitcnt lgkmcnt(0)" ::: "memory");
    const int c = lane & 7;
#pragma unroll
    for (int j = 0; j < 8; ++j) { const int n = (lane >> 3) + 8 * j; const LAS float* s = scr + (8 * c) * 65 + n;
        u32x4 o; o.x = pk2(s[0], s[65]); o.y = pk2(s[2 * 65], s[3 * 65]); o.z = pk2(s[4 * 65], s[5 * 65]); o.w = pk2(s[6 * 65], s[7 * 65]);
        *(u32x4*)(dst + (size_t)(dst_row0 + n) * ldd + k0 + 8 * c) = o; }
    asm volatile("s_waitcnt lgkmcnt(0)" ::: "memory");
}

__device__ __forceinline__ void phase_prologue(const Ctx& c) {
    {
        LAS float* cond = (LAS float*)c.lds;
        LAS float* red = cond + 4096;
        for (int item = c.bid; item < 192; item += c.G) {
            __syncthreads();
            for (int i = c.tid; i < 4096; i += NT) cond[i] = siluf_(c.a.in[I_C][i]);
            __syncthreads();
            const int l = item / 96, col = (item % 96) * 64 + c.lane;
            const float* w = c.a.in[I_WADA] + (size_t)l * D * 6144 + col;
            float acc[4] = {0.f, 0.f, 0.f, 0.f};
            for (int k = c.wave * 128; k < c.wave * 128 + 128; ++k) { const float wv = w[(size_t)k * 6144];
#pragma unroll
                for (int b = 0; b < 4; ++b) acc[b] += cond[b * 1024 + k] * wv; }
#pragma unroll
            for (int b = 0; b < 4; ++b) red[(c.wave * 4 + b) * 64 + c.lane] = acc[b];
            __syncthreads();
            if (c.tid < 256) { const int b = c.tid >> 6, ln = c.tid & 63; float s = 0.f;
#pragma unroll
                for (int wv = 0; wv < 8; ++wv) s += red[(wv * 4 + b) * 64 + ln];
                const int cc = (item % 96) * 64 + ln;
                c.mod(l)[b * 6144 + cc] = s + c.a.in[I_BADA][l * 6144 + cc]; }
        }
        __syncthreads();
    }
    {
        LAS float* scr = (LAS float*)c.lds + c.wave * (64 * 65 + 64);
        const int gw = c.bid * NWAVES + c.wave, NGW = c.G * NWAVES;
        constexpr int I_IN = 16 * 68, I_BRM = 8 * 16, I_BRA = 8 * 16, I_OUT = 16 * 16, I_GU1 = 16 * 8, I_DN1 = 8 * 16;
        constexpr int PER_LAYER = I_IN + I_BRM + I_BRA + I_OUT + NE * 2 * I_GU1 + NE * I_DN1;
        for (int it = gw; it < 2 * PER_LAYER; it += NGW) {
            const int l = it / PER_LAYER; int r = it % PER_LAYER; unsigned char* wl = c.wl(l);
            if (r < I_IN) { const int kb = r / 68, nb = r % 68; const int n0 = nb * 64; const int ns = n0 < 1536 ? n0 : n0 + 8;
                conv_tile(c.a.in[I_WIN] + (size_t)l * D * D_IN, D_IN, kb * 64, ns, (bf16*)(wl + W_IN), D, n0, scr, c.lane); continue; } r -= I_IN;
            if (r < I_BRM) { const int kb = r / 16, nb = r % 16;
                conv_tile(c.a.in[I_WBRM] + (size_t)l * 512 * D, D, kb * 64, nb * 64, (bf16*)(wl + W_BR), D, nb * 64, scr, c.lane); continue; } r -= I_BRM;
            if (r < I_BRA) { const int kb = r / 16, nb = r % 16;
                conv_tile(c.a.in[I_WBRA] + (size_t)l * 512 * D, D, kb * 64, nb * 64, (bf16*)(wl + W_BR) + 512, D, nb * 64, scr, c.lane); continue; } r -= I_BRA;
            if (r < I_OUT) { const int kb = r / 16, nb = r % 16;
                conv_tile(c.a.in[I_WOUT] + (size_t)l * D * D, D, kb * 64, nb * 64, (bf16*)(wl + W_OUT), D, nb * 64, scr, c.lane); continue; } r -= I_OUT;
            if (r < NE * 2 * I_GU1) { const int e = r / (2 * I_GU1); int q = r % (2 * I_GU1); const int up = q / I_GU1; q %= I_GU1; const int kb = q / 8, nb = q % 8;
                const float* src = (up ? c.a.in[I_WU] : c.a.in[I_WG]) + ((size_t)l * NE + e) * D * DE;
                const int j0 = nb * 64; const int drow = (j0 / 128) * 256 + up * 128 + (j0 % 128);
                conv_tile(src, DE, kb * 64, j0, (bf16*)(wl + W_GU) + (size_t)e * 1024 * D, D, drow, scr, c.lane); continue; } r -= NE * 2 * I_GU1;
            { const int e = r / I_DN1; const int q = r % I_DN1; const int kb = q / 16, nb = q % 16;
                conv_tile(c.a.in[I_WD] + ((size_t)l * NE + e) * DE * D, D, kb * 64, nb * 64, (bf16*)(wl + W_DN) + (size_t)e * D * DE, DE, nb * 64, scr, c.lane); }
        }
    }
}

__device__ __forceinline__ float tree_reduce16(float (&v)[16], int lane) {
    { const bool hi = (lane >> 5) & 1;
#pragma unroll
      for (int i = 0; i < 8; ++i) { const float keep = hi ? v[i + 8] : v[i], send = hi ? v[i] : v[i + 8]; v[i] = keep + __shfl_xor(send, 32); } }
    { const bool hi = (lane >> 4) & 1;
#pragma unroll
      for (int i = 0; i < 4; ++i) { const float keep = hi ? v[i + 4] : v[i], send = hi ? v[i] : v[i + 4]; v[i] = keep + __shfl_xor(send, 16); } }
    { const bool hi = (lane >> 3) & 1;
#pragma unroll
      for (int i = 0; i < 2; ++i) { const float keep = hi ? v[i + 2] : v[i], send = hi ? v[i] : v[i + 2]; v[i] = keep + __shfl_xor(send, 8); } }
    { const bool hi = (lane >> 2) & 1; const float keep = hi ? v[1] : v[0], send = hi ? v[0] : v[1]; v[0] = keep + __shfl_xor(send, 4); }
    v[0] += __shfl_xor(v[0], 2); v[0] += __shfl_xor(v[0], 1);
    return v[0];
}
__device__ __forceinline__ float tree_reduce8(float (&v)[8], int lane) {
    { const bool hi = (lane >> 5) & 1;
#pragma unroll
      for (int i = 0; i < 4; ++i) { const float keep = hi ? v[i + 4] : v[i], send = hi ? v[i] : v[i + 4]; v[i] = keep + __shfl_xor(send, 32); } }
    { const bool hi = (lane >> 4) & 1;
#pragma unroll
      for (int i = 0; i < 2; ++i) { const float keep = hi ? v[i + 2] : v[i], send = hi ? v[i] : v[i + 2]; v[i] = keep + __shfl_xor(send, 16); } }
    { const bool hi = (lane >> 3) & 1; const float keep = hi ? v[1] : v[0], send = hi ? v[0] : v[1]; v[0] = keep + __shfl_xor(send, 8); }
    v[0] += __shfl_xor(v[0], 4); v[0] += __shfl_xor(v[0], 2); v[0] += __shfl_xor(v[0], 1);
    return v[0];
}
__device__ __forceinline__ void xn_row_tail(const Ctx& c, int l, int m, f32x4 (&v)[4], float s, const LAS float* w8) {
    const int b = m / SEQ; const float* wn = c.a.in[I_WN1] + l * D; const float* mod = c.mod(l);
    bf16* XN = (bf16*)(c.a.ws + WS_XA); float* IFG = (float*)(c.a.ws + WS_IFG);
    const float rstd = rsqrtf(wave_sum(s) * (1.f / D) + EPS);
    float g[8] = {0.f, 0.f, 0.f, 0.f, 0.f, 0.f, 0.f, 0.f};
    u32x2* o8 = (u32x2*)(XN + (size_t)m * D) + c.lane;
#pragma unroll
    for (int j = 0; j < 4; ++j) { const int col = 256 * j + 4 * c.lane;
        const f32x4 w = *(const f32x4*)(wn + col), sh = *(const f32x4*)(mod + b * 6144 + col), sc = *(const f32x4*)(mod + b * 6144 + 1024 + col);
        v[j] = (v[j] * rstd * w) * (sc + 1.f) + sh;
        u32x2 o; o.x = pk2(v[j].x, v[j].y); o.y = pk2(v[j].z, v[j].w); o8[64 * j] = o; }
#pragma unroll
    for (int q = 0; q < 8; ++q) {
#pragma unroll
        for (int j = 0; j < 4; ++j) { const f32x4 ww = *(const LAS f32x4*)(w8 + q * 1024 + 256 * j + 4 * c.lane); g[q] += (v[j].x * ww.x + v[j].y * ww.y) + (v[j].z * ww.z + v[j].w * ww.w); }
        asm volatile("" ::: "memory"); }
    const float val = tree_reduce8(g, c.lane);
    if ((c.lane & 7) == 0) { const int q = c.lane >> 3; const float bias = (q < 4) ? c.a.in[I_BIG][l * 4 + q] : c.a.in[I_BFG][l * 4 + q - 4];
        IFG[(size_t)m * 8 + q] = val + bias; }
}
__device__ __forceinline__ void stage_w8(const Ctx& c, int l, LAS float* w8) {
    const float* win = c.a.in[I_WIN] + (size_t)l * D * D_IN;
    for (int i = c.tid; i < 8192; i += NT) { const int k = i >> 3, j = i & 7; w8[j * 1024 + k] = win[(size_t)k * D_IN + 1536 + j]; }
    __syncthreads();
}
__device__ __forceinline__ void phase_xn(const Ctx& c, int l) {
    LAS float* w8 = (LAS float*)c.lds;
    stage_w8(c, l, w8);
    const float* xs = (l == 0) ? c.a.in[I_X] : c.a.out;
    const int gw = c.bid * NWAVES + c.wave, NGW = c.G * NWAVES;
    f32x4 vn[4];
    if (gw < T) { const f32x4* xr = (const f32x4*)(xs + (size_t)gw * D) + c.lane;
#pragma unroll
        for (int j = 0; j < 4; ++j) vn[j] = xr[64 * j]; }
    for (int m = gw; m < T; m += NGW) {
        f32x4 v[4]; float s = 0.f;
#pragma unroll
        for (int j = 0; j < 4; ++j) { v[j] = vn[j]; s += (v[j].x * v[j].x + v[j].y * v[j].y) + (v[j].z * v[j].z + v[j].w * v[j].w); }
        if (m + NGW < T) { const f32x4* xr = (const f32x4*)(xs + (size_t)(m + NGW) * D) + c.lane;
#pragma unroll
            for (int j = 0; j < 4; ++j) vn[j] = xr[64 * j]; }
        xn_row_tail(c, l, m, v, s, w8);
    }
}

template <class RowA, class RowB0, class RowB1, class Epi>
__device__ __forceinline__ void naive_gemm_tile(const Ctx& c, int m0, int n0, int K0, int K1, const RowA& ra, const RowA& ra1, const RowB0& rb0, const RowB1& rb1, const Epi& epi) {
    LAS float* As = (LAS float*)c.lds;
    LAS float* Bs = As + 32 * 132;
    const int ty = c.tid >> 4, tx = c.tid & 15;
    f32x4 acc[2][4];
#pragma unroll
    for (int p = 0; p < 2; ++p)
#pragma unroll
        for (int i = 0; i < 4; ++i) acc[p][i] = (f32x4){0.f, 0.f, 0.f, 0.f};
#pragma unroll
    for (int p = 0; p < 2; ++p) {
        const int K = p ? K1 : K0;
        const int ar = c.tid >> 2, akc = c.tid & 3;
        const bf16* arow = p ? ra1(m0 + ar) : ra(m0 + ar);
        const int br = (c.tid & 255) >> 2, bkc = c.tid & 3;
        const bf16* brow = p ? rb1(n0 + br) : rb0(n0 + br);
        for (int k0 = 0; k0 < K; k0 += 32) {
            __syncthreads();
            { const u32x4 v = *(const u32x4*)(arow + k0 + 8 * akc); LAS float* d = As + (8 * akc) * 132 + ar;
              d[0] = bflo(v.x); d[132] = bfhi(v.x); d[2 * 132] = bflo(v.y); d[3 * 132] = bfhi(v.y); d[4 * 132] = bflo(v.z); d[5 * 132] = bfhi(v.z); d[6 * 132] = bflo(v.w); d[7 * 132] = bfhi(v.w); }
            if (c.tid < 256) { const u32x4 v = *(const u32x4*)(brow + k0 + 8 * bkc); LAS float* d = Bs + (8 * bkc) * 68 + br;
              d[0] = bflo(v.x); d[68] = bfhi(v.x); d[2 * 68] = bflo(v.y); d[3 * 68] = bfhi(v.y); d[4 * 68] = bflo(v.z); d[5 * 68] = bfhi(v.z); d[6 * 68] = bflo(v.w); d[7 * 68] = bfhi(v.w); }
            __syncthreads();
#pragma unroll 8
            for (int k = 0; k < 32; ++k) { const f32x4 av = *(const LAS f32x4*)(As + k * 132 + 4 * ty), bv = *(const LAS f32x4*)(Bs + k * 68 + 4 * tx);
                acc[p][0] += av.x * bv; acc[p][1] += av.y * bv; acc[p][2] += av.z * bv; acc[p][3] += av.w * bv; }
        }
    }
#pragma unroll
    for (int i = 0; i < 4; ++i) epi(m0 + 4 * ty + i, n0 + 4 * tx, acc[0][i], acc[1][i]);
}

struct RowPlain { const bf16* p; int ld; __device__ __forceinline__ const bf16* operator()(int r) const { return p + (size_t)r * ld; } };
struct RowGather { const bf16* p; int ld; const int* map; __device__ __forceinline__ const bf16* operator()(int r) const { return p + (size_t)map[r] * ld; } };
struct RowGU { const bf16* p; int up; __device__ __forceinline__ const bf16* operator()(int j) const { return p + (size_t)((j >> 7) * 256 + up * 128 + (j & 127)) * D; } };

struct EpiZ { bf16* z; __device__ __forceinline__ void operator()(int r, int cc, f32x4 a, f32x4) const { u32x2 o; o.x = pk2(a.x, a.y); o.y = pk2(a.z, a.w); *(u32x2*)(z + (size_t)r * ZW + cc) = o; } };
struct EpiBR { const bf16* z; bf16* mg; __device__ __forceinline__ void operator()(int r, int cc, f32x4 a, f32x4 b) const {
    const u32x2 gm = *(const u32x2*)(z + (size_t)r * ZW + Z_GM + cc), ga = *(const u32x2*)(z + (size_t)r * ZW + Z_GA + cc);
    const float m0 = sigmoidf_(bflo(gm.x)) * a.x + sigmoidf_(bflo(ga.x)) * b.x, m1 = sigmoidf_(bfhi(gm.x)) * a.y + sigmoidf_(bfhi(ga.x)) * b.y;
    const float m2 = sigmoidf_(bflo(gm.y)) * a.z + sigmoidf_(bflo(ga.y)) * b.z, m3 = sigmoidf_(bfhi(gm.y)) * a.w + sigmoidf_(bfhi(ga.y)) * b.w;
    u32x2 o; o.x = pk2(m0, m1); o.y = pk2(m2, m3); *(u32x2*)(mg + (size_t)r * D + cc) = o; } };
struct EpiOut { const float* xin; float* xout; const float* g1; __device__ __forceinline__ void operator()(int r, int cc, f32x4 a, f32x4) const {
    const int b = r / SEQ; const f32x4 g = *(const f32x4*)(g1 + b * 6144 + cc), xo = *(const f32x4*)(xin + (size_t)r * D + cc);
    *(f32x4*)(xout + (size_t)r * D + cc) = xo + g * a; } };
struct EpiAct { bf16* act; __device__ __forceinline__ void operator()(int r, int cc, f32x4 a, f32x4 b) const {
    u32x2 o; o.x = pk2(siluf_(a.x) * b.x, siluf_(a.y) * b.y); o.y = pk2(siluf_(a.z) * b.z, siluf_(a.w) * b.w); *(u32x2*)(act + (size_t)r * DE + cc) = o; } };
struct EpiY { bf16* y; __device__ __forceinline__ void operator()(int r, int cc, f32x4 a, f32x4) const { u32x2 o; o.x = pk2(a.x, a.y); o.y = pk2(a.z, a.w); *(u32x2*)(y + (size_t)r * D + cc) = o; } };

__device__ __forceinline__ void phase_inproj(const Ctx& c, int l) {
    const RowPlain ra{(const bf16*)(c.a.ws + WS_XA), D}, rb{(const bf16*)(c.wl(l) + W_IN), D}; const EpiZ e{(bf16*)(c.a.ws + WS_Z)};
    constexpr int NTN = ZW / 64, NTM = T / 128;
    for (int u = c.bid; u < NTN * NTM; u += c.G) naive_gemm_tile(c, (u / NTN) * 128, (u % NTN) * 64, D, 0, ra, ra, rb, rb, e);
}
__device__ __forceinline__ void phase_br(const Ctx& c, int l) {
    const bf16* hc = (const bf16*)(c.a.ws + WS_HCAT); const bf16* w = (const bf16*)(c.wl(l) + W_BR);
    const RowPlain ra{hc, D}, ra1{hc + 512, D}, rb0{w, D}, rb1{w + 512, D}; const EpiBR e{(const bf16*)(c.a.ws + WS_Z), (bf16*)(c.a.ws + WS_XA)};
    constexpr int NTN = D / 64, NTM = T / 128;
    for (int u = c.bid; u < NTN * NTM; u += c.G) naive_gemm_tile(c, (u / NTN) * 128, (u % NTN) * 64, 512, 512, ra, ra1, rb0, rb1, e);
}
__device__ __forceinline__ void phase_out(const Ctx& c, int l) {
    const RowPlain ra{(const bf16*)(c.a.ws + WS_XA), D}, rb{(const bf16*)(c.wl(l) + W_OUT), D};
    const EpiOut e{l == 0 ? c.a.in[I_X] : c.a.out, c.a.out, c.mod(l) + 2048};
    constexpr int NTN = D / 64, NTM = T / 128;
    for (int u = c.bid; u < NTN * NTM; u += c.G) naive_gemm_tile(c, (u / NTN) * 128, (u % NTN) * 64, D, 0, ra, ra, rb, rb, e);
}

__device__ __forceinline__ void naive_mlstm(const Ctx& c, int l, int bh) {
    const int b = bh >> 2, h = bh & 3, d = c.tid >> 2, eq = c.tid & 3, e0 = eq * 16;
    const bf16* z = (const bf16*)(c.a.ws + WS_Z); const float* IFG = (const float*)(c.a.ws + WS_IFG); float* HR = (float*)(c.a.ws + WS_XA);
    const float* cw = c.a.in[I_CONVW] + (size_t)l * 4 * 512; const float* cb = c.a.in[I_CONVB] + l * 512;
    float C[16], n[16], m = 0.f;
#pragma unroll
    for (int i = 0; i < 16; ++i) { C[i] = 0.f; n[i] = 0.f; }
    LAS float* cwl = (LAS float*)c.lds;
    for (int i = c.tid; i < 640; i += NT) { if (i < 512) { const int j = i >> 7, ch = i & 127; cwl[i] = cw[j * 512 + (ch < 64 ? h * 64 + ch : 256 + h * 64 + ch - 64)]; } else { const int ch = i - 512; cwl[i] = cb[ch < 64 ? h * 64 + ch : 256 + h * 64 + ch - 64]; } }
    __syncthreads();
    for (int s = 0; s < SEQ; ++s) {
        const size_t t = (size_t)b * SEQ + s;
        float q[16], k[16];
#pragma unroll
        for (int i = 0; i < 16; ++i) { q[i] = cwl[512 + e0 + i]; k[i] = cwl[512 + 64 + e0 + i]; }
#pragma unroll
        for (int j = 0; j < 4; ++j) { const int sj = s - 3 + j; if (sj >= 0) { const bf16* zr = z + ((size_t)b * SEQ + sj) * ZW;
            const u32x4 q0 = *(const u32x4*)(zr + Z_QM + h * 64 + e0), q1 = *(const u32x4*)(zr + Z_QM + h * 64 + e0 + 8);
            const u32x4 k0 = *(const u32x4*)(zr + Z_KM + h * 64 + e0), k1 = *(const u32x4*)(zr + Z_KM + h * 64 + e0 + 8);
            const unsigned qa[8] = {q0.x, q0.y, q0.z, q0.w, q1.x, q1.y, q1.z, q1.w}, ka[8] = {k0.x, k0.y, k0.z, k0.w, k1.x, k1.y, k1.z, k1.w};
#pragma unroll
            for (int i = 0; i < 8; ++i) { q[2 * i] += cwl[j * 128 + e0 + 2 * i] * bflo(qa[i]); q[2 * i + 1] += cwl[j * 128 + e0 + 2 * i + 1] * bfhi(qa[i]); k[2 * i] += cwl[j * 128 + 64 + e0 + 2 * i] * bflo(ka[i]); k[2 * i + 1] += cwl[j * 128 + 64 + e0 + 2 * i + 1] * bfhi(ka[i]); } }
            asm volatile("" ::: "memory"); }
#pragma unroll
        for (int i = 0; i < 16; ++i) { q[i] = siluf_(q[i]) * 0.125f; k[i] = siluf_(k[i]); }
        const float v = bf2f(z[t * ZW + Z_VM + h * 128 + d]);
        const float ig = IFG[t * 8 + h], fp = IFG[t * 8 + 4 + h];
        const float logf = fminf(fp, 0.f) - log1pf(__expf(-fabsf(fp)));
        const float mn = fmaxf(logf + m, ig), dec = __expf(logf + m - mn), fr = __expf(ig - mn);
        float num = 0.f, den = 0.f;
#pragma unroll
        for (int i = 0; i < 16; ++i) { C[i] = dec * C[i] + fr * v * k[i]; n[i] = dec * n[i] + fr * k[i]; num += C[i] * q[i]; den += n[i] * q[i]; }
        num += __shfl_xor(num, 1); num += __shfl_xor(num, 2); den += __shfl_xor(den, 1); den += __shfl_xor(den, 2);
        m = mn;
        if (eq == 0) HR[t * 512 + h * 128 + d] = num / fmaxf(fabsf(den), __expf(-mn));
    }
}
__device__ __forceinline__ void naive_swa(const Ctx& c, int l, int first_blk) {
    const bf16* z = (const bf16*)(c.a.ws + WS_Z); bf16* hc = (bf16*)(c.a.ws + WS_HCAT);
    const float* relb = c.a.in[I_RELB]; const float* sinks = c.a.in[I_SINK] + l * AH;
    const int nblk = c.G - first_blk;
    for (int idx = (c.bid - first_blk) * NT + c.tid; idx < T * AH * 4; idx += nblk * NT) {
        const int part = idx & 3, hd = (idx >> 2) & 7, t = idx >> 5, kh = hd >> 2, s = t % SEQ, d0 = part * 16;
        float q[16], o[16];
        { const bf16* qp = z + (size_t)t * ZW + Z_QA + hd * 64 + d0;
#pragma unroll
          for (int i = 0; i < 2; ++i) { const u32x4 v = *(const u32x4*)(qp + 8 * i); q[8 * i] = bflo(v.x); q[8 * i + 1] = bfhi(v.x); q[8 * i + 2] = bflo(v.y); q[8 * i + 3] = bfhi(v.y); q[8 * i + 4] = bflo(v.z); q[8 * i + 5] = bfhi(v.z); q[8 * i + 6] = bflo(v.w); q[8 * i + 7] = bfhi(v.w); } }
#pragma unroll
        for (int i = 0; i < 16; ++i) o[i] = 0.f;
        float mx = sinks[hd], lsum = 1.f;
        const int j0 = s - 127 < 0 ? 0 : s - 127;
        for (int j = j0; j <= s; ++j) {
            const bf16* kp = z + (size_t)(t - s + j) * ZW + Z_KA + kh * 64 + d0; const bf16* vp = z + (size_t)(t - s + j) * ZW + Z_VA + kh * 64 + d0;
            float sc = 0.f;
#pragma unroll
            for (int i = 0; i < 2; ++i) { const u32x4 v = *(const u32x4*)(kp + 8 * i);
                sc += q[8 * i] * bflo(v.x) + q[8 * i + 1] * bfhi(v.x) + q[8 * i + 2] * bflo(v.y) + q[8 * i + 3] * bfhi(v.y) + q[8 * i + 4] * bflo(v.z) + q[8 * i + 5] * bfhi(v.z) + q[8 * i + 6] * bflo(v.w) + q[8 * i + 7] * bfhi(v.w); }
            sc += __shfl_xor(sc, 1); sc += __shfl_xor(sc, 2);
            sc = sc * 0.125f + relb[T5_BUCKET[s - j] * AH + hd];
            const float mn = fmaxf(mx, sc), corr = __expf(mx - mn), p = __expf(sc - mn);
            lsum = lsum * corr + p; mx = mn;
#pragma unroll
            for (int i = 0; i < 2; ++i) { const u32x4 v = *(const u32x4*)(vp + 8 * i);
                o[8 * i] = o[8 * i] * corr + p * bflo(v.x); o[8 * i + 1] = o[8 * i + 1] * corr + p * bfhi(v.x); o[8 * i + 2] = o[8 * i + 2] * corr + p * bflo(v.y); o[8 * i + 3] = o[8 * i + 3] * corr + p * bfhi(v.y);
                o[8 * i + 4] = o[8 * i + 4] * corr + p * bflo(v.z); o[8 * i + 5] = o[8 * i + 5] * corr + p * bfhi(v.z); o[8 * i + 6] = o[8 * i + 6] * corr + p * bflo(v.w); o[8 * i + 7] = o[8 * i + 7] * corr + p * bfhi(v.w); }
        }
        const float inv = 1.f / lsum; bf16* op = hc + (size_t)t * D + 512 + hd * 64 + d0;
#pragma unroll
        for (int i = 0; i < 2; ++i) { u32x4 w; w.x = pk2(o[8 * i] * inv, o[8 * i + 1] * inv); w.y = pk2(o[8 * i + 2] * inv, o[8 * i + 3] * inv); w.z = pk2(o[8 * i + 4] * inv, o[8 * i + 5] * inv); w.w = pk2(o[8 * i + 6] * inv, o[8 * i + 7] * inv); *(u32x4*)(op + 8 * i) = w; }
    }
}
__device__ __forceinline__ void phase_mix1(const Ctx& c, int l) {
    if (c.bid < 16) naive_mlstm(c, l, c.bid); else naive_swa(c, l, 16);
}
__device__ __forceinline__ void phase_mix2(const Ctx& c, int l) {
    const float* HR = (const float*)(c.a.ws + WS_XA); const bf16* z = (const bf16*)(c.a.ws + WS_Z); bf16* hc = (bf16*)(c.a.ws + WS_HCAT);
    const float* wm = c.a.in[I_WMN] + l * 512;
    const int gw = c.bid * NWAVES + c.wave, NGW = c.G * NWAVES;
    for (int it = gw; it < T * MH; it += NGW) { const int t = it >> 2, h = it & 3; const int col = h * 128 + 2 * c.lane;
        const float a0 = HR[(size_t)t * 512 + col], a1 = HR[(size_t)t * 512 + col + 1];
        const float rstd = rsqrtf(wave_sum(a0 * a0 + a1 * a1) * (1.f / 128.f) + EPS);
        const unsigned og = *(const unsigned*)(z + (size_t)t * ZW + Z_OM + col);
        *(unsigned*)(hc + (size_t)t * D + col) = pk2(a0 * rstd * wm[col] * sigmoidf_(bflo(og)), a1 * rstd * wm[col + 1] * sigmoidf_(bfhi(og))); }
}

__device__ __forceinline__ void phase_route(const Ctx& c, int l) {
    LAS float* wr = (LAS float*)c.lds;
    for (int i = c.tid; i < 16384; i += NT) { const int k = i >> 4, e = i & 15; wr[e * 1024 + k] = c.a.in[I_WR][i]; }
    __syncthreads();
    LAS int* ridx_l = (LAS int*)(c.lds + 65536);
    const int chunk = (T + c.G - 1) / c.G, m0 = c.bid * chunk, m1 = (m0 + chunk < T) ? m0 + chunk : T;
    const float* wn = c.a.in[I_WN2] + l * D; const float* mod = c.mod(l); const float* rbias = c.a.in[I_RB];
    bf16* XN = (bf16*)(c.a.ws + WS_XA); int* RIDX = (int*)(c.a.ws + WS_RIDX); float* RW = (float*)(c.a.ws + WS_RW);
    f32x4 vn[4];
    if (m0 + c.wave < m1) { const f32x4* xr = (const f32x4*)(c.a.out + (size_t)(m0 + c.wave) * D) + c.lane;
#pragma unroll
        for (int j = 0; j < 4; ++j) vn[j] = xr[64 * j]; }
    for (int m = m0 + c.wave; m < m1; m += NWAVES) {
        const int b = m / SEQ;
        f32x4 v[4]; float s = 0.f;
#pragma unroll
        for (int j = 0; j < 4; ++j) { v[j] = vn[j]; s += (v[j].x * v[j].x + v[j].y * v[j].y) + (v[j].z * v[j].z + v[j].w * v[j].w); }
        if (m + NWAVES < m1) { const f32x4* xr = (const f32x4*)(c.a.out + (size_t)(m + NWAVES) * D) + c.lane;
#pragma unroll
            for (int j = 0; j < 4; ++j) vn[j] = xr[64 * j]; }
        const float rstd = rsqrtf(wave_sum(s) * (1.f / D) + EPS);
        float lg[16];
#pragma unroll
        for (int e = 0; e < 16; ++e) lg[e] = 0.f;
        u32x2* o8 = (u32x2*)(XN + (size_t)m * D) + c.lane;
#pragma unroll
        for (int j = 0; j < 4; ++j) { const int col = 256 * j + 4 * c.lane;
            const f32x4 w = *(const f32x4*)(wn + col), sh = *(const f32x4*)(mod + b * 6144 + 3072 + col), sc = *(const f32x4*)(mod + b * 6144 + 4096 + col);
            v[j] = (v[j] * rstd * w) * (sc + 1.f) + sh;
            u32x2 o; o.x = pk2(v[j].x, v[j].y); o.y = pk2(v[j].z, v[j].w); o8[64 * j] = o; }
#pragma unroll
        for (int e = 0; e < 16; ++e) {
#pragma unroll
            for (int j = 0; j < 4; ++j) { const f32x4 ww = *(const LAS f32x4*)(wr + e * 1024 + 256 * j + 4 * c.lane); lg[e] += (v[j].x * ww.x + v[j].y * ww.y) + (v[j].z * ww.z + v[j].w * ww.w); }
            asm volatile("" ::: "memory"); }
        { const float tot = tree_reduce16(lg, c.lane);
#pragma unroll
          for (int e = 0; e < 16; ++e) lg[e] = __shfl(tot, 4 * e); }
        float sc[16], sel[16];
#pragma unroll
        for (int e = 0; e < 16; ++e) { sc[e] = 1.f / (1.f + expf(-lg[e])); sel[e] = sc[e] + rbias[e]; }
        int bg = 0; float bgs = -INFINITY;
#pragma unroll
        for (int g = 0; g < 4; ++g) { float m1 = -INFINITY, m2 = -INFINITY;
#pragma unroll
            for (int i = 0; i < 4; ++i) { const float x = sel[4 * g + i]; if (x > m1) { m2 = m1; m1 = x; } else if (x > m2) m2 = x; }
            const float gs = m1 + m2; if (gs > bgs) { bgs = gs; bg = g; } }
        int i1 = -1, i2 = -1; float v1 = -INFINITY, v2 = -INFINITY;
#pragma unroll
        for (int e = 0; e < 16; ++e) { if ((e >> 2) == bg) { const float x = sel[e]; if (x > v1) { v2 = v1; i2 = i1; v1 = x; i1 = e; } else if (x > v2) { v2 = x; i2 = e; } } }
        float s1 = 0.f, s2 = 0.f;
#pragma unroll
        for (int e = 0; e < 16; ++e) { s1 = (e == i1) ? sc[e] : s1; s2 = (e == i2) ? sc[e] : s2; }
        if (c.lane == 0) { const float inv = 1.f / (s1 + s2); RIDX[2 * m] = i1; RIDX[2 * m + 1] = i2; RW[2 * m] = s1 * inv; RW[2 * m + 1] = s2 * inv;
            ridx_l[2 * (m - m0)] = i1; ridx_l[2 * (m - m0) + 1] = i2; }
    }
    __syncthreads();
    if (c.tid < NE) { const int n2 = 2 * (m1 - m0); int cnt = 0; int* RANK = (int*)(c.a.ws + WS_RANK) + 2 * m0;
        for (int i = 0; i < n2; ++i) { if (ridx_l[i] == c.tid) { RANK[i] = cnt; ++cnt; } }
        ((int*)(c.a.ws + WS_WGCNT))[c.bid * NE + c.tid] = cnt; }
    __syncthreads();
}
__device__ __forceinline__ void phase_fill(const Ctx& c, int l) {
    LAS int* wg = (LAS int*)c.lds;
    LAS int* base = wg + 512 * NE;
    LAS int* tot = base + NE;
    LAS int* offs = tot + NE;
    const int* WGCNT = (const int*)(c.a.ws + WS_WGCNT);
    for (int i = c.tid; i < c.G * NE; i += NT) wg[i] = WGCNT[i];
    __syncthreads();
    if (c.tid < NE) { int s = 0, bs = 0; for (int w = 0; w < c.G; ++w) { if (w == c.bid) bs = s; s += wg[w * NE + c.tid]; } base[c.tid] = bs; tot[c.tid] = s; }
    __syncthreads();
    if (c.tid == 0) { int o = 0; for (int e = 0; e < NE; ++e) { offs[e] = o; o += (tot[e] + 255) & ~255; } offs[NE] = o; }
    __syncthreads();
    const int* RIDX = (const int*)(c.a.ws + WS_RIDX); const int* RANK = (const int*)(c.a.ws + WS_RANK); int* SLOT = (int*)(c.a.ws + WS_SLOT); int* ROWTOK = (int*)(c.a.ws + WS_ROWTOK);
    const int chunk = (T + c.G - 1) / c.G, m0 = c.bid * chunk, m1 = (m0 + chunk < T) ? m0 + chunk : T;
    for (int i = 2 * m0 + c.tid; i < 2 * m1; i += NT) { const int e = RIDX[i]; const int row = offs[e] + base[e] + RANK[i]; ROWTOK[row] = i >> 1; SLOT[i] = row; }
    if (c.bid < NE) { const int e = c.bid; for (int r = offs[e] + tot[e] + c.tid; r < offs[e + 1]; r += NT) ROWTOK[r] = 0; }
    if (c.bid == 0 && c.tid < NE) (c.ctl() + CW_CNT + 64 * l)[c.tid] = (unsigned)tot[c.tid];
    __syncthreads();
}
__device__ __forceinline__ void phase_g1(const Ctx& c, int l) {
    LAS int* offs = (LAS int*)(c.lds + 65536);
    const unsigned* cnt = c.ctl() + CW_CNT + 64 * l;
    if (c.tid == 0) { int o = 0; for (int e = 0; e < NE; ++e) { offs[e] = o; o += (int)((__hip_atomic_load(cnt + e, __ATOMIC_RELAXED, __HIP_MEMORY_SCOPE_AGENT) + 255u) & ~255u); } offs[NE] = o; }
    __syncthreads();
    const int R = offs[NE]; const int NTM = R / 128; constexpr int NTN = DE / 64;
    const RowGather ra{(const bf16*)(c.a.ws + WS_XA), D, (const int*)(c.a.ws + WS_ROWTOK)}; const EpiAct ep{(bf16*)(c.a.ws + WS_ACT)};
    for (int u = c.bid; u < NTM * NTN; u += c.G) { const int m0 = (u / NTN) * 128, n0 = (u % NTN) * 64; int e = 0; for (int i = 1; i < NE; ++i) if (m0 >= offs[i]) e = i;
        const bf16* w = (const bf16*)(c.wl(l) + W_GU) + (size_t)e * 1024 * D; const RowGU rb0{w, 0}, rb1{w, 1};
        naive_gemm_tile(c, m0, n0, D, D, ra, ra, rb0, rb1, ep); }
    __syncthreads();
}
__device__ __forceinline__ void phase_g2(const Ctx& c, int l) {
    LAS int* offs = (LAS int*)(c.lds + 65536);
    const unsigned* cnt = c.ctl() + CW_CNT + 64 * l;
    if (c.tid == 0) { int o = 0; for (int e = 0; e < NE; ++e) { offs[e] = o; o += (int)((__hip_atomic_load(cnt + e, __ATOMIC_RELAXED, __HIP_MEMORY_SCOPE_AGENT) + 255u) & ~255u); } offs[NE] = o; }
    __syncthreads();
    const int R = offs[NE]; const int NTM = R / 128; constexpr int NTN = D / 64;
    const RowPlain ra{(const bf16*)(c.a.ws + WS_ACT), DE}; const EpiY ep{(bf16*)(c.a.ws + WS_Y)};
    for (int u = c.bid; u < NTM * NTN; u += c.G) { const int m0 = (u / NTN) * 128, n0 = (u % NTN) * 64; int e = 0; for (int i = 1; i < NE; ++i) if (m0 >= offs[i]) e = i;
        const RowPlain rb{(const bf16*)(c.wl(l) + W_DN) + (size_t)e * D * DE, DE};
        naive_gemm_tile(c, m0, n0, DE, 0, ra, ra, rb, rb, ep); }
    __syncthreads();
}
__device__ __forceinline__ void phase_combine(const Ctx& c, int l) {
    LAS float* w8 = (LAS float*)c.lds;
    if (l + 1 < DEPTH) stage_w8(c, l + 1, w8);
    const float* mod = c.mod(l); const bf16* Y = (const bf16*)(c.a.ws + WS_Y); const int* SLOT = (const int*)(c.a.ws + WS_SLOT); const float* RW = (const float*)(c.a.ws + WS_RW);
    const float* wf = c.a.in[I_WF];
    const int gw = c.bid * NWAVES + c.wave, NGW = c.G * NWAVES;
    int ps0 = 0, ps1 = 0; float pw0 = 0.f, pw1 = 0.f;
    { const int mi = gw + NGW * c.lane; if (mi < T) { ps0 = SLOT[2 * mi]; ps1 = SLOT[2 * mi + 1]; pw0 = RW[2 * mi]; pw1 = RW[2 * mi + 1]; } }
    f32x4 xn_[4]; u32x2 yan[4], ybn[4];
#define CMB_ISSUE(i_, m_) do { const int s0_ = __shfl(ps0, (i_)), s1_ = __shfl(ps1, (i_)); const f32x4* xr_ = (const f32x4*)(c.a.out + (size_t)(m_) * D) + c.lane; \
        const u32x2* y0_ = (const u32x2*)(Y + (size_t)s0_ * D) + c.lane; const u32x2* y1_ = (const u32x2*)(Y + (size_t)s1_ * D) + c.lane; \
        _Pragma("unroll") for (int j = 0; j < 4; ++j) { xn_[j] = xr_[64 * j]; yan[j] = y0_[64 * j]; ybn[j] = y1_[64 * j]; } } while (0)
    if (gw < T) CMB_ISSUE(0, gw);
    int i = 0;
    for (int m = gw; m < T; m += NGW, ++i) {
        const int b = m / SEQ; f32x4* xr = (f32x4*)(c.a.out + (size_t)m * D) + c.lane;
        const float w0 = __shfl(pw0, i), w1 = __shfl(pw1, i);
        f32x4 v[4]; u32x2 ya[4], yb[4];
#pragma unroll
        for (int j = 0; j < 4; ++j) { v[j] = xn_[j]; ya[j] = yan[j]; yb[j] = ybn[j]; }
        if (m + NGW < T) CMB_ISSUE(i + 1, m + NGW);
        float s = 0.f;
#pragma unroll
        for (int j = 0; j < 4; ++j) { const int col = 256 * j + 4 * c.lane; const f32x4 g = *(const f32x4*)(mod + b * 6144 + 5120 + col);
            const f32x4 fa = {bflo(ya[j].x), bfhi(ya[j].x), bflo(ya[j].y), bfhi(ya[j].y)}, fb = {bflo(yb[j].x), bfhi(yb[j].x), bflo(yb[j].y), bfhi(yb[j].y)};
            v[j] = v[j] + g * (fa * w0 + fb * w1);
            s += (v[j].x * v[j].x + v[j].y * v[j].y) + (v[j].z * v[j].z + v[j].w * v[j].w); }
        if (l == DEPTH - 1) { const float rstd = rsqrtf(wave_sum(s) * (1.f / D) + EPS);
#pragma unroll
            for (int j = 0; j < 4; ++j) xr[64 * j] = v[j] * rstd * *(const f32x4*)(wf + 256 * j + 4 * c.lane); }
        else {
#pragma unroll
            for (int j = 0; j < 4; ++j) xr[64 * j] = v[j];
            xn_row_tail(c, l + 1, m, v, s, w8); }
    }
#undef CMB_ISSUE
}

namespace pg8 {
typedef short bf16x8 __attribute__((ext_vector_type(8)));
constexpr int BM = 256, BK = 64, HALF = 128, HTB = HALF * BK * 2, STAGE_BYTES = 8 * HTB, NXCD = 8, WGM = 8;
__host__ __device__ __forceinline__ int lds_byte(int r, int c) { const int st = (r >> 4) * 2 + (c >> 5), rr = r & 15, cc = c & 31, ob = rr * 64 + cc * 2; return st * 1024 + (ob ^ (((ob >> 9) & 1) << 5)); }
__host__ __device__ __forceinline__ void stage_rc(int b, int& R, int& C) { const int st = b / 1024, sb = b % 1024, swz = sb ^ (((sb >> 9) & 1) << 5); R = (st >> 1) * 16 + swz / 64; C = (st & 1) * 32 + (swz % 64) / 2; }
__host__ __device__ __forceinline__ int perm32(int rho) { const int n = rho >> 4, i = rho & 15; return 8 * (i >> 2) + 4 * n + (i & 3); }
struct Unit { int pm, pn; };
struct StaticOrder {
    int nM, nN, nwg, G, c;
    __device__ void init(int M, int N, int G_, int c_) { nM = M / BM; nN = N / BM; nwg = nM * nN; G = G_; c = c_; }
    __device__ bool next(int i, Unit& u) const {
        const long L = (long)i * G + c; if (L >= nwg) return false;
        int wgid = (int)L; { const int q = nwg / NXCD, r = nwg % NXCD, xcd = wgid % NXCD, off = wgid / NXCD; wgid = (xcd < r ? xcd * (q + 1) : r * (q + 1) + (xcd - r) * q) + off; }
        const int nig = WGM * nN, gid = wgid / nig, fm = gid * WGM, gsz = (nM - fm) < WGM ? (nM - fm) : WGM;
        u.pm = fm + ((wgid % nig) % gsz); u.pn = (wgid % nig) / gsz; return true;
    }
};
__device__ __forceinline__ unsigned cvt_pk_bf16(float lo, float hi) { unsigned r; asm volatile("v_cvt_pk_bf16_f32 %0, %1, %2" : "=v"(r) : "v"(lo), "v"(hi)); return r; }

template <class Epi, class Sched, class Prob, bool ALIGN_EPI, bool SP2>
__device__ __forceinline__ void gemm_phase(LAS unsigned char* lds, const Prob& P, const Sched& S, const Epi& E) {
    int tid_ = threadIdx.x; asm volatile("" : "+v"(tid_));
    const int tid = tid_, wid = __builtin_amdgcn_readfirstlane(tid >> 6), lane = tid & 63, wr = wid >> 2, wc = wid & 3, fr = lane & 15, fq = lane >> 4;
    const int K = P.K, nt = K / BK;
    unsigned voffA[2], voffB[2]; int RA[2], CA[2];
#pragma unroll
    for (int i = 0; i < 2; ++i) { int R, C; stage_rc(tid * 16 + i * 8192, R, C); const int Rb = Epi::PERM ? ((R & ~31) + perm32(R & 31)) : R;
        RA[i] = R; CA[i] = C; voffA[i] = (unsigned)(R * K + C) * 2u; voffB[i] = (unsigned)(Rb * K + C) * 2u; }
    const size_t kstep = (size_t)(BK * 2);
    const size_t hstep = (size_t)HALF * K * 2;
    const unsigned ldsw = (unsigned)wid * 1024u;
    const int aoff = lds_byte(wr * 64 + fr, fq * 8), boff = lds_byte(wc * 32 + fr, fq * 8);
    unsigned vac[2][2], van[2][2];
#define PG8_SA(b, h) (((b) * 2 + (h)) * HTB)
#define PG8_SB(b, h) ((4 + (b) * 2 + (h)) * HTB)
#define PG8_GLDS(src, dstoff) __builtin_amdgcn_global_load_lds((const unsigned*)(src), (LAS unsigned*)(lds + (dstoff)), 16, 0, 0)
#define PG8_STAGE(bufoff, gbase, voff) do { _Pragma("unroll") for (int _i = 0; _i < 2; ++_i) PG8_GLDS((const char*)(gbase) + (voff)[_i], (bufoff) + ldsw + _i * 8192); } while (0)
#define PG8_STAGEA(bufoff, gbase, h, VG) do { if constexpr (Prob::GATHER) { _Pragma("unroll") for (int _i = 0; _i < 2; ++_i) PG8_GLDS((const char*)(gbase) + (VG)[h][_i], (bufoff) + ldsw + _i * 8192); } \
        else { _Pragma("unroll") for (int _i = 0; _i < 2; ++_i) PG8_GLDS((const char*)(gbase) + (h) * hstep + voffA[_i], (bufoff) + ldsw + _i * 8192); } } while (0)
#define PG8_LDA(dst, b, h) do { _Pragma("unroll") for (int m = 0; m < 4; ++m) _Pragma("unroll") for (int k = 0; k < 2; ++k) dst[m][k] = *(const LAS bf16x8*)(lds + PG8_SA(b, h) + aoff + m * 2048 + k * 1024); } while (0)
#define PG8_LDB(dst, b, h) do { _Pragma("unroll") for (int n = 0; n < 2; ++n) _Pragma("unroll") for (int k = 0; k < 2; ++k) dst[n][k] = *(const LAS bf16x8*)(lds + PG8_SB(b, h) + boff + n * 2048 + k * 1024); } while (0)
#define PG8_MMA(ai, bj, At, Bt) do { __builtin_amdgcn_s_setprio(1); _Pragma("unroll") for (int m = 0; m < 4; ++m) _Pragma("unroll") for (int n = 0; n < 2; ++n) _Pragma("unroll") for (int k = 0; k < 2; ++k) \
        acc[ai][bj][m][n] = __builtin_amdgcn_mfma_f32_16x16x32_bf16(Bt[n][k], At[m][k], acc[ai][bj][m][n], 0, 0, 0); __builtin_amdgcn_s_setprio(0); } while (0)
#define PG8_WAIT_V(n) asm volatile("s_waitcnt vmcnt(" #n ")" ::: "memory")
#define PG8_WAIT_L(n) asm volatile("s_waitcnt lgkmcnt(" #n ")" ::: "memory")
#define PG8_BAR __builtin_amdgcn_s_barrier()
#define PG8_SCHED __builtin_amdgcn_sched_barrier(0)
    Unit cur, nxt; int ui = 0;
    if (!S.next(0, cur)) return;
    f32x4 acc[2][2][4][2];
#pragma unroll
    for (int a = 0; a < 2; ++a)
#pragma unroll
        for (int b = 0; b < 2; ++b)
#pragma unroll
            for (int m = 0; m < 4; ++m)
#pragma unroll
                for (int n = 0; n < 2; ++n) acc[a][b][m][n] = (f32x4){0.f, 0.f, 0.f, 0.f};
    bf16x8 At[4][2], B0[2][2], B1[2][2];
    const char* cA = P.a_tile(cur); const char* cB = P.b_tile(cur);
    if constexpr (Prob::GATHER) { P.a_voff(cur, RA, CA, vac); }
    if constexpr (SP2) {
        PG8_STAGE(PG8_SB(0, 0), cB, voffB); PG8_STAGE(PG8_SB(0, 1), cB + hstep, voffB); PG8_STAGEA(PG8_SA(0, 0), cA, 0, vac); PG8_STAGEA(PG8_SA(0, 1), cA, 1, vac);
        if (wr == 1) PG8_BAR;
        PG8_WAIT_V(2); PG8_BAR;
        PG8_STAGE(PG8_SB(1, 0), cB + kstep, voffB); PG8_STAGEA(PG8_SA(1, 0), cA + kstep, 0, vac); PG8_STAGE(PG8_SB(1, 1), cB + hstep + kstep, voffB);
        PG8_WAIT_V(6); PG8_BAR;
    } else {
        PG8_STAGE(PG8_SB(0, 0), cB, voffB); PG8_STAGEA(PG8_SA(0, 0), cA, 0, vac); PG8_STAGE(PG8_SB(0, 1), cB + hstep, voffB); PG8_STAGEA(PG8_SA(0, 1), cA, 1, vac);
        if (wr == 1) PG8_BAR;
        PG8_WAIT_V(4); PG8_BAR;
        PG8_STAGE(PG8_SB(1, 0), cB + kstep, voffB); PG8_STAGEA(PG8_SA(1, 0), cA + kstep, 0, vac); PG8_STAGE(PG8_SB(1, 1), cB + hstep + kstep, voffB);
        PG8_WAIT_V(6); PG8_BAR;
    }
    for (;;) {
        const bool has_next = S.next(ui + 1, nxt);
        const char* nA = has_next ? P.a_tile(nxt) : cA; const char* nB = has_next ? P.b_tile(nxt) : cB;
        if constexpr (Prob::GATHER) { if (has_next) P.a_voff(nxt, RA, CA, van); else {
#pragma unroll
            for (int h = 0; h < 2; ++h)
#pragma unroll
                for (int i = 0; i < 2; ++i) van[h][i] = vac[h][i]; } }
        for (int t = 0; t < nt; t += 2) {
            const bool last = (t == nt - 2);
            const char* a1 = cA + (size_t)(t + 1) * kstep;
            const char* a2 = last ? nA : cA + (size_t)(t + 2) * kstep; const char* b2 = last ? nB : cB + (size_t)(t + 2) * kstep;
            const char* a3 = a2 + kstep; const char* b3 = b2 + kstep;
            unsigned v2[2][2];
            if constexpr (Prob::GATHER) {
#pragma unroll
                for (int h = 0; h < 2; ++h)
#pragma unroll
                    for (int i = 0; i < 2; ++i) v2[h][i] = last ? van[h][i] : vac[h][i]; }
            if constexpr (SP2) {
            PG8_LDB(B0, 0, 0); PG8_LDB(B1, 0, 1); PG8_SCHED; PG8_LDA(At, 0, 0); PG8_STAGEA(PG8_SA(1, 1), a1, 1, vac);
            PG8_WAIT_V(8); PG8_WAIT_L(0); PG8_BAR; PG8_MMA(0, 0, At, B0); PG8_MMA(0, 1, At, B1); PG8_BAR; PG8_SCHED;
            PG8_LDA(At, 0, 1); PG8_STAGE(PG8_SB(0, 0), b2, voffB); PG8_STAGE(PG8_SB(0, 1), b2 + hstep, voffB); PG8_STAGEA(PG8_SA(0, 0), a2, 0, v2);
            PG8_WAIT_V(8); PG8_WAIT_L(0); PG8_BAR; PG8_MMA(1, 0, At, B0); PG8_MMA(1, 1, At, B1); PG8_BAR; PG8_SCHED;
            PG8_LDB(B0, 1, 0); PG8_LDB(B1, 1, 1); PG8_SCHED; PG8_LDA(At, 1, 0); PG8_STAGEA(PG8_SA(0, 1), a2, 1, v2);
            PG8_WAIT_V(8); PG8_WAIT_L(0); PG8_BAR; PG8_MMA(0, 0, At, B0); PG8_MMA(0, 1, At, B1); PG8_BAR; PG8_SCHED;
            PG8_LDA(At, 1, 1); PG8_STAGE(PG8_SB(1, 0), b3, voffB); PG8_STAGE(PG8_SB(1, 1), b3 + hstep, voffB); PG8_STAGEA(PG8_SA(1, 0), a3, 0, v2);
            PG8_WAIT_V(8); PG8_WAIT_L(0); PG8_BAR; PG8_MMA(1, 0, At, B0); PG8_MMA(1, 1, At, B1); PG8_BAR; PG8_SCHED;
            } else {
            PG8_LDB(B0, 0, 0); PG8_SCHED; PG8_LDA(At, 0, 0); PG8_STAGEA(PG8_SA(1, 1), a1, 1, vac);
            PG8_WAIT_L(8); PG8_BAR; PG8_WAIT_L(0); PG8_MMA(0, 0, At, B0); PG8_BAR; PG8_SCHED;
            PG8_LDB(B1, 0, 1); PG8_STAGE(PG8_SB(0, 0), b2, voffB);
            PG8_BAR; PG8_WAIT_L(0); PG8_MMA(0, 1, At, B1); PG8_BAR;
            PG8_LDA(At, 0, 1); PG8_STAGEA(PG8_SA(0, 0), a2, 0, v2);
            PG8_BAR; PG8_WAIT_L(0); PG8_MMA(1, 0, At, B0); PG8_BAR; PG8_SCHED;
            PG8_STAGE(PG8_SB(0, 1), b2 + hstep, voffB);
            PG8_WAIT_V(6); PG8_BAR; PG8_MMA(1, 1, At, B1); PG8_BAR;
            PG8_LDB(B0, 1, 0); PG8_SCHED; PG8_LDA(At, 1, 0); PG8_STAGEA(PG8_SA(0, 1), a2, 1, v2);
            PG8_WAIT_L(8); PG8_BAR; PG8_WAIT_L(0); PG8_MMA(0, 0, At, B0); PG8_BAR; PG8_SCHED;
            PG8_LDB(B1, 1, 1); PG8_STAGE(PG8_SB(1, 0), b3, voffB);
            PG8_BAR; PG8_WAIT_L(0); PG8_MMA(0, 1, At, B1); PG8_BAR;
            PG8_LDA(At, 1, 1); PG8_STAGEA(PG8_SA(1, 0), a3, 0, v2);
            PG8_BAR; PG8_WAIT_L(0); PG8_MMA(1, 0, At, B0); PG8_BAR; PG8_SCHED;
            PG8_STAGE(PG8_SB(1, 1), b3 + hstep, voffB);
            PG8_WAIT_V(6); PG8_BAR; PG8_MMA(1, 1, At, B1); PG8_BAR;
            }
            if constexpr (Epi::HAS_MID) { if (t == nt / 2 - 2) E.mid(acc, cur, wr, wc, fr, fq); }
        }
        if constexpr (ALIGN_EPI) { if (wr == 0) PG8_BAR; }
        E(acc, cur, wr, wc, fr, fq);
        if (!has_next) break;
#pragma unroll
        for (int a = 0; a < 2; ++a)
#pragma unroll
            for (int b = 0; b < 2; ++b)
#pragma unroll
                for (int m = 0; m < 4; ++m)
#pragma unroll
                    for (int n = 0; n < 2; ++n) acc[a][b][m][n] = (f32x4){0.f, 0.f, 0.f, 0.f};
        cur = nxt; cA = nA; cB = nB; ++ui;
        if constexpr (Prob::GATHER) {
#pragma unroll
            for (int h = 0; h < 2; ++h)
#pragma unroll
                for (int i = 0; i < 2; ++i) vac[h][i] = van[h][i]; }
        if constexpr (ALIGN_EPI) { if (wr == 1) PG8_BAR; }
    }
    PG8_WAIT_V(0);
    if constexpr (!ALIGN_EPI) { if (wr == 0) PG8_BAR; }
    PG8_BAR;
#undef PG8_SA
#undef PG8_SB
#undef PG8_GLDS
#undef PG8_STAGE
#undef PG8_STAGEA
#undef PG8_LDA
#undef PG8_LDB
#undef PG8_MMA
#undef PG8_WAIT_V
#undef PG8_WAIT_L
#undef PG8_BAR
#undef PG8_SCHED
}

struct ProbPlain { static constexpr bool GATHER = false; const bf16* A; const bf16* Bt; int K;
    __device__ __forceinline__ const char* a_tile(const Unit& u) const { return (const char*)A + (size_t)u.pm * BM * K * 2; }
    __device__ __forceinline__ const char* b_tile(const Unit& u) const { return (const char*)Bt + (size_t)u.pn * BM * K * 2; }
    __device__ __forceinline__ void a_voff(const Unit&, const int (&)[2], const int (&)[2], unsigned (&)[2][2]) const {} };
__device__ __forceinline__ int moe_expert(const LAS int* offs, int row) { int e = 0;
#pragma unroll
    for (int i = 1; i < NE; ++i) e = (row >= offs[i]) ? i : e;
    return e; }
struct ProbMoeGather { static constexpr bool GATHER = true; const bf16* A; const bf16* Bt; int K; const int* rowtok; const LAS int* offs; size_t estride;
    __device__ __forceinline__ const char* a_tile(const Unit&) const { return (const char*)A; }
    __device__ __forceinline__ const char* b_tile(const Unit& u) const { const int e = __builtin_amdgcn_readfirstlane(moe_expert(offs, u.pm * BM)); return (const char*)(Bt + (size_t)e * estride) + (size_t)u.pn * BM * K * 2; }
    __device__ __forceinline__ void a_voff(const Unit& u, const int (&R)[2], const int (&C)[2], unsigned (&v)[2][2]) const {
#pragma unroll
        for (int h = 0; h < 2; ++h)
#pragma unroll
            for (int i = 0; i < 2; ++i) { const int tok = rowtok[u.pm * BM + h * HALF + R[i]]; v[h][i] = (unsigned)(tok * K + C[i]) * 2u; }
#pragma unroll
        for (int h = 0; h < 2; ++h)
#pragma unroll
            for (int i = 0; i < 2; ++i) asm volatile("" : "+v"(v[h][i]));
    } };
struct ProbMoePlain { static constexpr bool GATHER = false; const bf16* A; const bf16* Bt; int K; const LAS int* offs; size_t estride;
    __device__ __forceinline__ const char* a_tile(const Unit& u) const { return (const char*)A + (size_t)u.pm * BM * K * 2; }
    __device__ __forceinline__ const char* b_tile(const Unit& u) const { const int e = __builtin_amdgcn_readfirstlane(moe_expert(offs, u.pm * BM)); return (const char*)(Bt + (size_t)e * estride) + (size_t)u.pn * BM * K * 2; }
    __device__ __forceinline__ void a_voff(const Unit&, const int (&)[2], const int (&)[2], unsigned (&)[2][2]) const {} };

struct EpiStoreBf16 {
    static constexpr bool PERM = true, HAS_MID = false; bf16* O; int ldc;
    __device__ __forceinline__ void operator()(const f32x4 (&acc)[2][2][4][2], const Unit& u, int wr, int wc, int fr, int fq) const {
        int row0 = u.pm * BM + wr * 64 + fr, col0 = u.pn * BM + wc * 32 + 8 * fq; asm volatile("" : "+v"(row0), "+v"(col0));
#pragma unroll
        for (int ai = 0; ai < 2; ++ai)
#pragma unroll
            for (int m = 0; m < 4; ++m) { bf16* rowp = O + (size_t)(row0 + ai * HALF + m * 16) * ldc + col0;
#pragma unroll
                for (int bj = 0; bj < 2; ++bj) { const f32x4 v0 = acc[ai][bj][m][0], v1 = acc[ai][bj][m][1];
                    u32x4 w; w.x = cvt_pk_bf16(v0[0], v0[1]); w.y = cvt_pk_bf16(v0[2], v0[3]); w.z = cvt_pk_bf16(v1[0], v1[1]); w.w = cvt_pk_bf16(v1[2], v1[3]);
                    *(u32x4*)(rowp + bj * HALF) = w; } }
    }
};
__device__ __forceinline__ void unpack8(const u32x4 w, float (&f)[8]) { f[0] = bflo(w.x); f[1] = bfhi(w.x); f[2] = bflo(w.y); f[3] = bfhi(w.y); f[4] = bflo(w.z); f[5] = bfhi(w.z); f[6] = bflo(w.w); f[7] = bfhi(w.w); }
struct EpiMerge {
    static constexpr bool PERM = true, HAS_MID = true; const bf16* z; bf16* O;
    static __device__ __forceinline__ float ratio_(float ga, float gm) { return (1.f + __expf(-ga)) * __builtin_amdgcn_rcpf(1.f + __expf(-gm)); }
    static __device__ __forceinline__ float sig_(float g) { return __builtin_amdgcn_rcpf(1.f + __expf(-g)); }
    __device__ __forceinline__ void mid(f32x4 (&acc)[2][2][4][2], const Unit& u, int wr, int wc, int fr, int fq) const {
        int row0 = u.pm * BM + wr * 64 + fr, col0 = u.pn * BM + wc * 32 + 8 * fq; asm volatile("" : "+v"(row0), "+v"(col0));
        const bf16* zr0 = z + (size_t)row0 * ZW + col0;
#pragma unroll
        for (int ai = 0; ai < 2; ++ai)
#pragma unroll
            for (int mp = 0; mp < 2; ++mp) {
                u32x4 gmw[2][2], gaw[2][2];
#pragma unroll
                for (int mm = 0; mm < 2; ++mm)
#pragma unroll
                    for (int bj = 0; bj < 2; ++bj) { const bf16* zr = zr0 + (size_t)(ai * HALF + (2 * mp + mm) * 16) * ZW + bj * HALF; gmw[mm][bj] = *(const u32x4*)(zr + Z_GM); gaw[mm][bj] = *(const u32x4*)(zr + Z_GA); }
#pragma unroll
                for (int mm = 0; mm < 2; ++mm)
#pragma unroll
                    for (int bj = 0; bj < 2; ++bj) { const u32x4 gm_ = gmw[mm][bj], ga_ = gaw[mm][bj]; const int m = 2 * mp + mm;
                        const f32x4 r0 = {ratio_(bflo(ga_.x), bflo(gm_.x)), ratio_(bfhi(ga_.x), bfhi(gm_.x)), ratio_(bflo(ga_.y), bflo(gm_.y)), ratio_(bfhi(ga_.y), bfhi(gm_.y))};
                        const f32x4 r1 = {ratio_(bflo(ga_.z), bflo(gm_.z)), ratio_(bfhi(ga_.z), bfhi(gm_.z)), ratio_(bflo(ga_.w), bflo(gm_.w)), ratio_(bfhi(ga_.w), bfhi(gm_.w))};
                        acc[ai][bj][m][0] *= r0; acc[ai][bj][m][1] *= r1; }
                asm volatile("" ::: "memory"); }
    }
    __device__ __forceinline__ void operator()(const f32x4 (&acc)[2][2][4][2], const Unit& u, int wr, int wc, int fr, int fq) const {
        int row0 = u.pm * BM + wr * 64 + fr, col0 = u.pn * BM + wc * 32 + 8 * fq; asm volatile("" : "+v"(row0), "+v"(col0));
#pragma unroll
        for (int ai = 0; ai < 2; ++ai) {
            u32x4 gaw[4][2];
#pragma unroll
            for (int m = 0; m < 4; ++m)
#pragma unroll
                for (int bj = 0; bj < 2; ++bj) gaw[m][bj] = *(const u32x4*)(z + (size_t)(row0 + ai * HALF + m * 16) * ZW + col0 + Z_GA + bj * HALF);
#pragma unroll
            for (int m = 0; m < 4; ++m) { bf16* rowp = O + (size_t)(row0 + ai * HALF + m * 16) * D + col0;
#pragma unroll
                for (int bj = 0; bj < 2; ++bj) { const u32x4 ga_ = gaw[m][bj];
                    const f32x4 v0 = acc[ai][bj][m][0] * (f32x4){sig_(bflo(ga_.x)), sig_(bfhi(ga_.x)), sig_(bflo(ga_.y)), sig_(bfhi(ga_.y))};
                    const f32x4 v1 = acc[ai][bj][m][1] * (f32x4){sig_(bflo(ga_.z)), sig_(bfhi(ga_.z)), sig_(bflo(ga_.w)), sig_(bfhi(ga_.w))};
                    u32x4 w; w.x = cvt_pk_bf16(v0[0], v0[1]); w.y = cvt_pk_bf16(v0[2], v0[3]); w.z = cvt_pk_bf16(v1[0], v1[1]); w.w = cvt_pk_bf16(v1[2], v1[3]);
                    *(u32x4*)(rowp + bj * HALF) = w; } }
            asm volatile("" ::: "memory"); }
    }
};
struct EpiResidual {
    static constexpr bool PERM = false, HAS_MID = false; const float* xin; float* xout; const float* gmod;
    __device__ __forceinline__ void operator()(const f32x4 (&acc)[2][2][4][2], const Unit& u, int wr, int wc, int fr, int fq) const {
        int row0 = u.pm * BM + wr * 64 + fr, col0 = u.pn * BM + wc * 32 + 4 * fq; asm volatile("" : "+v"(row0), "+v"(col0)); const int b = (u.pm * BM) / SEQ;
        f32x4 gv[2][2];
#pragma unroll
        for (int bj = 0; bj < 2; ++bj)
#pragma unroll
            for (int n = 0; n < 2; ++n) gv[bj][n] = *(const f32x4*)(gmod + b * 6144 + col0 + bj * HALF + n * 16);
#pragma unroll
        for (int ai = 0; ai < 2; ++ai)
#pragma unroll
            for (int m = 0; m < 4; ++m) { const size_t off = (size_t)(row0 + ai * HALF + m * 16) * D + col0;
#pragma unroll
                for (int bj = 0; bj < 2; ++bj)
#pragma unroll
                    for (int n = 0; n < 2; ++n) { const f32x4 xo = *(const f32x4*)(xin + off + bj * HALF + n * 16); *(f32x4*)(xout + off + bj * HALF + n * 16) = xo + gv[bj][n] * acc[ai][bj][m][n]; }
                if (m & 1) asm volatile("" ::: "memory"); }
    }
};
struct EpiAct {
    static constexpr bool PERM = true, HAS_MID = false; bf16* O;
    __device__ __forceinline__ void operator()(const f32x4 (&acc)[2][2][4][2], const Unit& u, int wr, int wc, int fr, int fq) const {
        int row0 = u.pm * BM + wr * 64 + fr, col0 = u.pn * HALF + wc * 32 + 8 * fq; asm volatile("" : "+v"(row0), "+v"(col0));
#pragma unroll
        for (int ai = 0; ai < 2; ++ai)
#pragma unroll
            for (int m = 0; m < 4; ++m) { bf16* rowp = O + (size_t)(row0 + ai * HALF + m * 16) * DE + col0; float a[8];
#pragma unroll
                for (int n = 0; n < 2; ++n)
#pragma unroll
                    for (int i = 0; i < 4; ++i) { const float g = acc[ai][0][m][n][i], up = acc[ai][1][m][n][i]; a[4 * n + i] = g * __builtin_amdgcn_rcpf(1.f + __expf(-g)) * up; }
                u32x4 w; w.x = cvt_pk_bf16(a[0], a[1]); w.y = cvt_pk_bf16(a[2], a[3]); w.z = cvt_pk_bf16(a[4], a[5]); w.w = cvt_pk_bf16(a[6], a[7]);
                *(u32x4*)rowp = w; }
    }
};
}

#ifndef OPT_GEMM
#define OPT_GEMM 1
#endif
#ifndef OPT_MIX
#define OPT_MIX 1
#endif
constexpr int OFFS_LDS = 131072;
__device__ __forceinline__ void moe_offsets_lds(const Ctx& c, int l) {
    LAS int* offs = (LAS int*)(c.lds + OFFS_LDS);
    const unsigned* cnt = c.ctl() + CW_CNT + 64 * l;
    if (c.tid == 0) { int o = 0; for (int e = 0; e < NE; ++e) { offs[e] = o; o += (int)((__hip_atomic_load(cnt + e, __ATOMIC_RELAXED, __HIP_MEMORY_SCOPE_AGENT) + 255u) & ~255u); } offs[NE] = o; }
    __syncthreads();
}
__device__ __forceinline__ void phase_inproj_opt(const Ctx& c, int l) {
    const pg8::ProbPlain P{(const bf16*)(c.a.ws + WS_XA), (const bf16*)(c.wl(l) + W_IN), D}; pg8::StaticOrder S; S.init(T, ZW, c.G, c.bid);
    const pg8::EpiStoreBf16 E{(bf16*)(c.a.ws + WS_Z), ZW};
    pg8::gemm_phase<pg8::EpiStoreBf16, pg8::StaticOrder, pg8::ProbPlain, true, true>(c.lds, P, S, E);
}
__device__ __forceinline__ void phase_br_opt(const Ctx& c, int l) {
    const pg8::ProbPlain P{(const bf16*)(c.a.ws + WS_HCAT), (const bf16*)(c.wl(l) + W_BR), D}; pg8::StaticOrder S; S.init(T, D, c.G, c.bid);
    const pg8::EpiMerge E{(const bf16*)(c.a.ws + WS_Z), (bf16*)(c.a.ws + WS_XA)};
    pg8::gemm_phase<pg8::EpiMerge, pg8::StaticOrder, pg8::ProbPlain, true, true>(c.lds, P, S, E);
}
__device__ __forceinline__ void phase_out_opt(const Ctx& c, int l) {
    const pg8::ProbPlain P{(const bf16*)(c.a.ws + WS_XA), (const bf16*)(c.wl(l) + W_OUT), D}; pg8::StaticOrder S; S.init(T, D, c.G, c.bid);
    const pg8::EpiResidual E{l == 0 ? c.a.in[I_X] : c.a.out, c.a.out, c.mod(l) + 2048};
    pg8::gemm_phase<pg8::EpiResidual, pg8::StaticOrder, pg8::ProbPlain, true, true>(c.lds, P, S, E);
}
__device__ __forceinline__ void phase_g1_opt(const Ctx& c, int l) {
    moe_offsets_lds(c, l); const LAS int* offs = (const LAS int*)(c.lds + OFFS_LDS); const int R = offs[NE];
    const pg8::ProbMoeGather P{(const bf16*)(c.a.ws + WS_XA), (const bf16*)(c.wl(l) + W_GU), D, (const int*)(c.a.ws + WS_ROWTOK), offs, (size_t)1024 * D};
    pg8::StaticOrder S; S.init(R, 1024, c.G, c.bid);
    const pg8::EpiAct E{(bf16*)(c.a.ws + WS_ACT)};
    pg8::gemm_phase<pg8::EpiAct, pg8::StaticOrder, pg8::ProbMoeGather, true, true>(c.lds, P, S, E);
}
__device__ __forceinline__ void phase_g2_opt(const Ctx& c, int l) {
    moe_offsets_lds(c, l); const LAS int* offs = (const LAS int*)(c.lds + OFFS_LDS); const int R = offs[NE];
    const pg8::ProbMoePlain P{(const bf16*)(c.a.ws + WS_ACT), (const bf16*)(c.wl(l) + W_DN), DE, offs, (size_t)D * DE};
    pg8::StaticOrder S; S.init(R, D, c.G, c.bid);
    const pg8::EpiStoreBf16 E{(bf16*)(c.a.ws + WS_Y), D};
    pg8::gemm_phase<pg8::EpiStoreBf16, pg8::StaticOrder, pg8::ProbMoePlain, true, true>(c.lds, P, S, E);
}

__device__ __forceinline__ void unpack8_(const u32x4 w, float (&f)[8]) { f[0] = bflo(w.x); f[1] = bfhi(w.x); f[2] = bflo(w.y); f[3] = bfhi(w.y); f[4] = bflo(w.z); f[5] = bfhi(w.z); f[6] = bflo(w.w); f[7] = bfhi(w.w); }
typedef short bf16x8 __attribute__((ext_vector_type(8)));
typedef float f32x16 __attribute__((ext_vector_type(16)));
typedef float f32x2_t __attribute__((ext_vector_type(2)));
typedef __bf16 bf16x2_t __attribute__((ext_vector_type(2)));
#define MFMA32(a, b, c) __builtin_amdgcn_mfma_f32_32x32x16_bf16((a), (b), (c), 0, 0, 0)
__device__ __forceinline__ unsigned cvtpk(float lo, float hi) { f32x2_t v = {lo, hi}; bf16x2_t b = __builtin_convertvector(v, bf16x2_t); return __builtin_bit_cast(unsigned, b); }
__device__ __forceinline__ int crow(int i, int h) { return (i & 3) + 8 * (i >> 2) + 4 * h; }
template <int S> __device__ __forceinline__ bf16x8 pack_step(const f32x16& x) {
    u32x4 p; p.x = cvtpk(x[8 * S], x[8 * S + 1]); p.y = cvtpk(x[8 * S + 2], x[8 * S + 3]); p.z = cvtpk(x[8 * S + 4], x[8 * S + 5]); p.w = cvtpk(x[8 * S + 6], x[8 * S + 7]);
    return __builtin_bit_cast(bf16x8, p);
}
__device__ __forceinline__ float logsigmoidf_(float x) { return fminf(x, 0.f) - log1pf(__expf(-fabsf(x))); }
__device__ __forceinline__ float wave_incl_sum(float x, int lane) {
#pragma unroll
    for (int o = 1; o < 64; o <<= 1) { const float y = __shfl_up(x, o); x = (lane >= o) ? x + y : x; }
    return x;
}
__device__ __forceinline__ float wave_incl_max(float x, int lane) {
#pragma unroll
    for (int o = 1; o < 64; o <<= 1) { const float y = __shfl_up(x, o); x = (lane >= o) ? fmaxf(x, y) : x; }
    return x;
}
__device__ __forceinline__ float wave_max(float v) {
#pragma unroll
    for (int o = 1; o < 64; o <<= 1) v = fmaxf(v, __shfl_xor(v, o));
    return v;
}
constexpr size_t WS_NLOC = 3 * MiB;
constexpr size_t WS_MLOC = WS_NLOC + 256 * 1024;
constexpr size_t WS_BLAST = WS_MLOC + 4096;
constexpr size_t WS_MPREV = WS_BLAST + 4096;
static_assert(WS_MPREV + 4096 <= 4 * MiB, "mlstm small state");

__device__ __forceinline__ void swa_unit(const Ctx& c, int l, int u) {
    const int b = u >> 6, kh = (u >> 5) & 1, n = u & 31;
    LAS unsigned char* Ks = c.lds;
    LAS unsigned char* VT = c.lds + 36864;
    LAS float* BT = (LAS float*)(c.lds + 70144);
    const bf16* z = (const bf16*)(c.a.ws + WS_Z); bf16* hc = (bf16*)(c.a.ws + WS_HCAT);
    const size_t tblk = (size_t)b * SEQ + (size_t)n * 128;
#pragma unroll
    for (int it = 0; it < 4; ++it) { const int idx = c.tid + NT * it, row = idx >> 3, ch = idx & 7; const int srel = n * 128 - 128 + row;
        u32x4 kv = {0u, 0u, 0u, 0u}, vv = {0u, 0u, 0u, 0u};
        if (srel >= 0) { const bf16* zr = z + ((size_t)b * SEQ + srel) * ZW; kv = *(const u32x4*)(zr + Z_KA + kh * 64 + ch * 8); vv = *(const u32x4*)(zr + Z_VA + kh * 64 + ch * 8); }
        *(LAS u32x4*)(Ks + row * 144 + ch * 16) = kv;
        LAS unsigned short* vt = (LAS unsigned short*)(VT + (ch * 8) * 520 + row * 2);
        vt[0] = (unsigned short)(vv.x & 0xffffu); vt[260] = (unsigned short)(vv.x >> 16); vt[2 * 260] = (unsigned short)(vv.y & 0xffffu); vt[3 * 260] = (unsigned short)(vv.y >> 16);
        vt[4 * 260] = (unsigned short)(vv.z & 0xffffu); vt[5 * 260] = (unsigned short)(vv.z >> 16); vt[6 * 260] = (unsigned short)(vv.w & 0xffffu); vt[7 * 260] = (unsigned short)(vv.w >> 16); }
    { const int g = c.tid >> 7, dist = c.tid & 127; BT[c.tid] = c.a.in[I_RELB][T5_BUCKET[dist] * AH + kh * 4 + g]; }
    __syncthreads();
    const int r = c.lane & 31, hh = c.lane >> 5, g = c.wave >> 1, head = kh * 4 + g;
    const float sink = c.a.in[I_SINK][l * AH + head];
#pragma unroll 1
    for (int jj = 0; jj < 2; ++jj) {
        const int j = (c.wave & 1) * 2 + jj;
        const size_t tq = tblk + 32 * j + r;
        bf16x8 qf[4];
#pragma unroll
        for (int kk = 0; kk < 4; ++kk) qf[kk] = *(const bf16x8*)(z + tq * ZW + Z_QA + head * 64 + 16 * kk + 8 * hh);
        f32x16 X[5];
#pragma unroll
        for (int kt = 0; kt < 5; ++kt) { const int kb0 = 32 * (j + kt);
            f32x16 x = {0.f, 0.f, 0.f, 0.f, 0.f, 0.f, 0.f, 0.f, 0.f, 0.f, 0.f, 0.f, 0.f, 0.f, 0.f, 0.f};
#pragma unroll
            for (int kk = 0; kk < 4; ++kk) { const bf16x8 a = *(const LAS bf16x8*)(Ks + (kb0 + r) * 144 + 32 * kk + 16 * hh); x = MFMA32(a, qf[kk], x); }
            X[kt] = x; asm volatile("" ::: "memory"); }
        float mx = sink;
#pragma unroll
        for (int kt = 0; kt < 5; ++kt) {
#pragma unroll
            for (int i = 0; i < 16; ++i) { const int cr = crow(i, hh), dist = r + 128 - 32 * kt - cr, kb = 32 * (j + kt) + cr;
                const bool valid = (dist >= 0) && (dist < 128) && (n > 0 || kb >= 128);
                const float s = X[kt][i] * 0.125f + BT[g * 128 + (dist & 127)];
                X[kt][i] = valid ? s : -1e30f; mx = fmaxf(mx, X[kt][i]); }
            asm volatile("" ::: "memory"); }
        mx = fmaxf(mx, __shfl_xor(mx, 32));
        float ls = 0.f;
#pragma unroll
        for (int kt = 0; kt < 5; ++kt)
#pragma unroll
            for (int i = 0; i < 16; ++i) { const float p = __expf(X[kt][i] - mx); X[kt][i] = p; ls += p; }
        ls += __shfl_xor(ls, 32);
        const float inv = 1.f / (ls + __expf(sink - mx));
        f32x16 O0 = {0.f, 0.f, 0.f, 0.f, 0.f, 0.f, 0.f, 0.f, 0.f, 0.f, 0.f, 0.f, 0.f, 0.f, 0.f, 0.f}, O1 = O0;
#pragma unroll
        for (int kt = 0; kt < 5; ++kt) { const int kb0 = 32 * (j + kt);
            X[kt] = X[kt] * inv;
            const bf16x8 p0 = pack_step<0>(X[kt]), p1 = pack_step<1>(X[kt]);
            const LAS unsigned char* v0 = VT + r * 520 + (kb0 + 4 * hh) * 2; const LAS unsigned char* v1 = VT + (32 + r) * 520 + (kb0 + 4 * hh) * 2;
            { const u32x2 lo = *(const LAS u32x2*)(v0), hi = *(const LAS u32x2*)(v0 + 16); const u32x4 w = {lo.x, lo.y, hi.x, hi.y}; O0 = MFMA32(p0, __builtin_bit_cast(bf16x8, w), O0); }
            { const u32x2 lo = *(const LAS u32x2*)(v0 + 32), hi = *(const LAS u32x2*)(v0 + 48); const u32x4 w = {lo.x, lo.y, hi.x, hi.y}; O0 = MFMA32(p1, __builtin_bit_cast(bf16x8, w), O0); }
            { const u32x2 lo = *(const LAS u32x2*)(v1), hi = *(const LAS u32x2*)(v1 + 16); const u32x4 w = {lo.x, lo.y, hi.x, hi.y}; O1 = MFMA32(p0, __builtin_bit_cast(bf16x8, w), O1); }
            { const u32x2 lo = *(const LAS u32x2*)(v1 + 32), hi = *(const LAS u32x2*)(v1 + 48); const u32x4 w = {lo.x, lo.y, hi.x, hi.y}; O1 = MFMA32(p1, __builtin_bit_cast(bf16x8, w), O1); }
            asm volatile("" ::: "memory"); }
        bf16* ob = hc + (tblk + 32 * j) * D + 512 + head * 64 + r;
#pragma unroll
        for (int i = 0; i < 16; ++i) { const int q = crow(i, hh); ob[(size_t)q * D] = (bf16)f2bf(O0[i]); ob[(size_t)q * D + 32] = (bf16)f2bf(O1[i]); }
    }
    __syncthreads();
}

struct ChunkGates { float ig, bcum, blast; };
__device__ __forceinline__ ChunkGates chunk_gates(const Ctx& c, size_t t0, int h) {
    const float* IFG = (const float*)(c.a.ws + WS_IFG);
    ChunkGates g; g.ig = IFG[(t0 + c.lane) * 8 + h]; const float fp = IFG[(t0 + c.lane) * 8 + 4 + h];
    g.bcum = wave_incl_sum(logsigmoidf_(fp), c.lane); g.blast = __shfl(g.bcum, 63); return g;
}
__device__ __forceinline__ void conv8(const Ctx& c, int l, const bf16* zrow, int spos, int zc0, int cc0, float scale, float (&out)[8]) {
    const float* cw = c.a.in[I_CONVW] + (size_t)l * 4 * 512 + cc0; const float* cb = c.a.in[I_CONVB] + l * 512 + cc0;
    { const f32x4 b0 = *(const f32x4*)cb, b1 = *(const f32x4*)(cb + 4); out[0] = b0.x; out[1] = b0.y; out[2] = b0.z; out[3] = b0.w; out[4] = b1.x; out[5] = b1.y; out[6] = b1.z; out[7] = b1.w; }
#pragma unroll
    for (int j = 0; j < 4; ++j) { const int sj = spos - 3 + j;
        if (sj >= 0) { float zv[8]; unpack8_(*(const u32x4*)(zrow + (ptrdiff_t)(j - 3) * ZW + zc0), zv);
            const f32x4 w0 = *(const f32x4*)(cw + j * 512), w1 = *(const f32x4*)(cw + j * 512 + 4);
            out[0] += w0.x * zv[0]; out[1] += w0.y * zv[1]; out[2] += w0.z * zv[2]; out[3] += w0.w * zv[3]; out[4] += w1.x * zv[4]; out[5] += w1.y * zv[5]; out[6] += w1.z * zv[6]; out[7] += w1.w * zv[7]; } }
#pragma unroll
    for (int i = 0; i < 8; ++i) out[i] = siluf_(out[i]) * scale;
}

__device__ __forceinline__ void mlstm_local_unit(const Ctx& c, int l, int u) {
    const int b = u >> 8, h = (u >> 6) & 3, ch = u & 63;
    const size_t t0 = (size_t)b * SEQ + (size_t)ch * 64;
    LAS unsigned char* kT = c.lds;
    LAS unsigned char* avT = c.lds + 9216;
    LAS float* a_l = (LAS float*)(c.lds + 27648);
    const bf16* z = (const bf16*)(c.a.ws + WS_Z);
    const ChunkGates g = chunk_gates(c, t0, h);
    const float w = g.blast - g.bcum + g.ig; const float mloc = wave_max(w); const float a = __expf(w - mloc);
    if (c.wave == 0) a_l[c.lane] = a;
    { const int lp = c.tid >> 3, c8 = c.tid & 7; float kc[8];
      conv8(c, l, z + (t0 + lp) * ZW, ch * 64 + lp, Z_KM + h * 64 + c8 * 8, 256 + h * 64 + c8 * 8, 1.f, kc);
      LAS unsigned short* d = (LAS unsigned short*)(kT + (c8 * 8) * 144 + lp * 2);
#pragma unroll
      for (int i = 0; i < 8; ++i) d[i * 72] = (unsigned short)f2bf(kc[i]); }
    __syncthreads();
#pragma unroll
    for (int it = 0; it < 2; ++it) { const int idx = c.tid + NT * it, lp = idx >> 4, c16 = idx & 15; float vv[8]; unpack8_(*(const u32x4*)(z + (t0 + lp) * ZW + Z_VM + h * 128 + c16 * 8), vv);
        const float al = a_l[lp]; LAS unsigned short* d = (LAS unsigned short*)(avT + (c16 * 8) * 144 + lp * 2);
#pragma unroll
        for (int i = 0; i < 8; ++i) d[i * 72] = (unsigned short)f2bf(vv[i] * al); }
    __syncthreads();
    const int r = c.lane & 31, hh = c.lane >> 5, dt = c.wave >> 1, et = c.wave & 1;
    f32x16 acc = {0.f, 0.f, 0.f, 0.f, 0.f, 0.f, 0.f, 0.f, 0.f, 0.f, 0.f, 0.f, 0.f, 0.f, 0.f, 0.f};
#pragma unroll
    for (int kk = 0; kk < 4; ++kk) { const bf16x8 af = *(const LAS bf16x8*)(avT + (32 * dt + r) * 144 + 32 * kk + 16 * hh), bfr = *(const LAS bf16x8*)(kT + (32 * et + r) * 144 + 32 * kk + 16 * hh); acc = MFMA32(af, bfr, acc); }
    float* CL = (float*)(c.a.ws + WS_XA) + (size_t)u * 8192;
#pragma unroll
    for (int i = 0; i < 16; ++i) CL[(32 * dt + crow(i, hh)) * 64 + 32 * et + r] = acc[i];
    if (c.tid < 64) { float s = 0.f; const LAS unsigned short* kr = (const LAS unsigned short*)(kT + c.tid * 144);
#pragma unroll 8
        for (int lp = 0; lp < 64; ++lp) s += a_l[lp] * bf2f(kr[lp]);
        ((float*)(c.a.ws + WS_NLOC))[(size_t)u * 64 + c.tid] = s;
        if (c.tid == 0) { ((float*)(c.a.ws + WS_MLOC))[u] = mloc; ((float*)(c.a.ws + WS_BLAST))[u] = g.blast; } }
    __syncthreads();
}

__device__ __forceinline__ void phase_scan(const Ctx& c) {
    LAS float* ml = (LAS float*)c.lds; LAS float* bl = ml + 64;
    for (int w = c.bid; w < 256; w += c.G) {
        const int bh = w >> 4, slice = w & 15;
        __syncthreads();
        if (c.tid < 64) { ml[c.tid] = ((const float*)(c.a.ws + WS_MLOC))[bh * 64 + c.tid]; bl[c.tid] = ((const float*)(c.a.ws + WS_BLAST))[bh * 64 + c.tid]; }
        __syncthreads();
        float* CL = (float*)(c.a.ws + WS_XA) + (size_t)bh * 64 * 8192 + slice * 512 + c.tid;
        float x[64];
#pragma unroll
        for (int ch = 0; ch < 64; ++ch) x[ch] = CL[(size_t)ch * 8192];
        float m = 0.f, C = 0.f;
#pragma unroll
        for (int ch = 0; ch < 64; ++ch) { CL[(size_t)ch * 8192] = C;
            const float mn = fmaxf(bl[ch] + m, ml[ch]); const float dec = __expf(bl[ch] + m - mn), fr = __expf(ml[ch] - mn);
            C = dec * C + fr * x[ch]; m = mn; }
        if (slice == 0 && c.tid < 64) { float* NL = (float*)(c.a.ws + WS_NLOC) + (size_t)bh * 64 * 64 + c.tid; float* MP = (float*)(c.a.ws + WS_MPREV) + bh * 64;
            float mm = 0.f, nn = 0.f;
#pragma unroll 4
            for (int ch = 0; ch < 64; ++ch) { const float xv = NL[ch * 64]; NL[ch * 64] = nn; if (c.tid == 0) MP[ch] = mm;
                const float mn = fmaxf(bl[ch] + mm, ml[ch]); const float dec = __expf(bl[ch] + mm - mn), fr = __expf(ml[ch] - mn);
                nn = dec * nn + fr * xv; mm = mn; } }
    }
    __syncthreads();
}

__device__ __forceinline__ void mlstm_out_unit(const Ctx& c, int l, int u) {
    const int b = u >> 8, h = (u >> 6) & 3, ch = u & 63;
    const size_t t0 = (size_t)b * SEQ + (size_t)ch * 64;
    LAS unsigned char* qs = c.lds;
    LAS unsigned char* qis = c.lds + 9216;
    LAS unsigned char* ks = c.lds + 18432;
    LAS unsigned char* vT = c.lds + 27648;
    LAS float* T_bm = (LAS float*)(c.lds + 46080);
    LAS float* T_g = T_bm + 64;
    LAS float* T_em = T_bm + 128;
    LAS float* T_np = T_bm + 192;
    LAS float* T_ri = T_bm + 256;
    LAS float* hbuf = (LAS float*)(c.lds + 47616);
    const bf16* z = (const bf16*)(c.a.ws + WS_Z); bf16* hc = (bf16*)(c.a.ws + WS_HCAT);
    const ChunkGates g = chunk_gates(c, t0, h);
    const float mprev = ((const float*)(c.a.ws + WS_MPREV))[u];
    const float gg = g.ig - g.bcum; const float pm = wave_incl_max(gg, c.lane);
    const float mrow = g.bcum + fmaxf(mprev, pm); const float inter = __expf(g.bcum + mprev - mrow);
    if (c.wave == 0) { T_bm[c.lane] = g.bcum - mrow; T_g[c.lane] = gg; T_em[c.lane] = __expf(-mrow); T_np[c.lane] = ((const float*)(c.a.ws + WS_NLOC))[(size_t)u * 64 + c.lane]; }
    { const int lp = c.tid >> 3, c8 = c.tid & 7; float qc[8], kc[8]; const bf16* zr = z + (t0 + lp) * ZW;
      conv8(c, l, zr, ch * 64 + lp, Z_QM + h * 64 + c8 * 8, h * 64 + c8 * 8, 0.125f, qc);
      conv8(c, l, zr, ch * 64 + lp, Z_KM + h * 64 + c8 * 8, 256 + h * 64 + c8 * 8, 1.f, kc);
      const float il = __shfl(inter, lp);
      u32x4 w; w.x = cvtpk(qc[0], qc[1]); w.y = cvtpk(qc[2], qc[3]); w.z = cvtpk(qc[4], qc[5]); w.w = cvtpk(qc[6], qc[7]); *(LAS u32x4*)(qs + lp * 144 + c8 * 16) = w;
      w.x = cvtpk(qc[0] * il, qc[1] * il); w.y = cvtpk(qc[2] * il, qc[3] * il); w.z = cvtpk(qc[4] * il, qc[5] * il); w.w = cvtpk(qc[6] * il, qc[7] * il); *(LAS u32x4*)(qis + lp * 144 + c8 * 16) = w;
      w.x = cvtpk(kc[0], kc[1]); w.y = cvtpk(kc[2], kc[3]); w.z = cvtpk(kc[4], kc[5]); w.w = cvtpk(kc[6], kc[7]); *(LAS u32x4*)(ks + lp * 144 + c8 * 16) = w; }
#pragma unroll
    for (int it = 0; it < 2; ++it) { const int idx = c.tid + NT * it, lp = idx >> 4, c16 = idx & 15; const u32x4 vv = *(const u32x4*)(z + (t0 + lp) * ZW + Z_VM + h * 128 + c16 * 8);
        LAS unsigned short* d = (LAS unsigned short*)(vT + (c16 * 8) * 144 + lp * 2);
        d[0] = (unsigned short)(vv.x & 0xffffu); d[72] = (unsigned short)(vv.x >> 16); d[2 * 72] = (unsigned short)(vv.y & 0xffffu); d[3 * 72] = (unsigned short)(vv.y >> 16);
        d[4 * 72] = (unsigned short)(vv.z & 0xffffu); d[5 * 72] = (unsigned short)(vv.z >> 16); d[6 * 72] = (unsigned short)(vv.w & 0xffffu); d[7 * 72] = (unsigned short)(vv.w >> 16); }
    __syncthreads();
    const int r = c.lane & 31, hh = c.lane >> 5, lt = c.wave >> 2, dt = c.wave & 3;
    f32x16 acc = {0.f, 0.f, 0.f, 0.f, 0.f, 0.f, 0.f, 0.f, 0.f, 0.f, 0.f, 0.f, 0.f, 0.f, 0.f, 0.f};
    float den = 0.f;
    const float bm = T_bm[32 * lt + r];
#pragma unroll
    for (int st = 0; st < 2; ++st) { if (st <= lt) {
        f32x16 X = {0.f, 0.f, 0.f, 0.f, 0.f, 0.f, 0.f, 0.f, 0.f, 0.f, 0.f, 0.f, 0.f, 0.f, 0.f, 0.f};
#pragma unroll
        for (int kk = 0; kk < 4; ++kk) { const bf16x8 af = *(const LAS bf16x8*)(ks + (32 * st + r) * 144 + 32 * kk + 16 * hh), bfr = *(const LAS bf16x8*)(qs + (32 * lt + r) * 144 + 32 * kk + 16 * hh); X = MFMA32(af, bfr, X); }
#pragma unroll
        for (int i = 0; i < 16; ++i) { const int s = 32 * st + crow(i, hh); const float wgt = (s <= 32 * lt + r) ? __expf(bm + T_g[s]) : 0.f; X[i] *= wgt; den += X[i]; }
        const bf16x8 p0 = pack_step<0>(X), p1 = pack_step<1>(X);
        const LAS unsigned char* v0 = vT + (32 * dt + r) * 144 + (32 * st + 4 * hh) * 2;
        { const u32x2 lo = *(const LAS u32x2*)(v0), hi = *(const LAS u32x2*)(v0 + 16); const u32x4 w = {lo.x, lo.y, hi.x, hi.y}; acc = MFMA32(p0, __builtin_bit_cast(bf16x8, w), acc); }
        { const u32x2 lo = *(const LAS u32x2*)(v0 + 32), hi = *(const LAS u32x2*)(v0 + 48); const u32x4 w = {lo.x, lo.y, hi.x, hi.y}; acc = MFMA32(p1, __builtin_bit_cast(bf16x8, w), acc); } } }
    { const float* CP = (const float*)(c.a.ws + WS_XA) + (size_t)u * 8192 + (size_t)(32 * dt + r) * 64 + 8 * hh;
#pragma unroll
      for (int kk = 0; kk < 4; ++kk) { const f32x4 c0 = *(const f32x4*)(CP + 16 * kk), c1 = *(const f32x4*)(CP + 16 * kk + 4);
          u32x4 w; w.x = cvtpk(c0.x, c0.y); w.y = cvtpk(c0.z, c0.w); w.z = cvtpk(c1.x, c1.y); w.w = cvtpk(c1.z, c1.w);
          const bf16x8 af = *(const LAS bf16x8*)(qis + (32 * lt + r) * 144 + 32 * kk + 16 * hh); acc = MFMA32(af, __builtin_bit_cast(bf16x8, w), acc); } }
    { const LAS unsigned char* qr = qis + (32 * lt + r) * 144 + 64 * hh;
#pragma unroll
      for (int q4 = 0; q4 < 4; ++q4) { float qv[8]; unpack8_(*(const LAS u32x4*)(qr + 16 * q4), qv);
#pragma unroll
          for (int i = 0; i < 8; ++i) den += qv[i] * T_np[32 * hh + 8 * q4 + i]; } }
    den += __shfl_xor(den, 32);
    if (hh == 0) T_ri[32 * lt + r] = 1.f / fmaxf(fabsf(den), T_em[32 * lt + r]);
    asm volatile("s_waitcnt lgkmcnt(0)" ::: "memory");
#pragma unroll
    for (int i = 0; i < 16; ++i) { const int lr = 32 * lt + crow(i, hh); hbuf[lr * 132 + 32 * dt + r] = acc[i] * T_ri[lr]; }
    __syncthreads();
    { const int lp = c.tid >> 3, part = c.tid & 7; const LAS float* hr = hbuf + lp * 132 + part * 16; float hv[16]; float ss = 0.f;
#pragma unroll
      for (int q4 = 0; q4 < 4; ++q4) { const f32x4 v = *(const LAS f32x4*)(hr + 4 * q4); hv[4 * q4] = v.x; hv[4 * q4 + 1] = v.y; hv[4 * q4 + 2] = v.z; hv[4 * q4 + 3] = v.w; ss += (v.x * v.x + v.y * v.y) + (v.z * v.z + v.w * v.w); }
      ss += __shfl_xor(ss, 1); ss += __shfl_xor(ss, 2); ss += __shfl_xor(ss, 4);
      const float rstd = rsqrtf(ss * (1.f / 128.f) + EPS);
      const int col = h * 128 + part * 16; const float* wm = c.a.in[I_WMN] + l * 512 + col;
      const bf16* og = z + (t0 + lp) * ZW + Z_OM + col; bf16* op = hc + (t0 + lp) * D + col;
#pragma unroll
      for (int q8 = 0; q8 < 2; ++q8) { float o8[8]; unpack8_(*(const u32x4*)(og + 8 * q8), o8); const f32x4 w0 = *(const f32x4*)(wm + 8 * q8), w1 = *(const f32x4*)(wm + 8 * q8 + 4);
          const float wv[8] = {w0.x, w0.y, w0.z, w0.w, w1.x, w1.y, w1.z, w1.w}; float ov[8];
#pragma unroll
          for (int i = 0; i < 8; ++i) ov[i] = hv[8 * q8 + i] * rstd * wv[i] * sigmoidf_(o8[i]);
          u32x4 w; w.x = cvtpk(ov[0], ov[1]); w.y = cvtpk(ov[2], ov[3]); w.z = cvtpk(ov[4], ov[5]); w.w = cvtpk(ov[6], ov[7]); *(u32x4*)(op + 8 * q8) = w; } }
    __syncthreads();
}

#ifndef OPT_SWA
#define OPT_SWA 1
#endif
#ifndef OPT_MLSTM
#define OPT_MLSTM 1
#endif
__device__ __forceinline__ void phase_mix1_opt(const Ctx& c, int l) {
    if (OPT_SWA) { for (int u = c.bid; u < NB * AKV * 32; u += c.G) swa_unit(c, l, u); } else naive_swa(c, l, 0);
    if (OPT_MLSTM) { for (int u = c.bid * 4; u < NB * MH * 64; u += c.G * 4) for (int k = 0; k < 4; ++k) mlstm_local_unit(c, l, u + k); }
    else if (c.bid < 16) naive_mlstm(c, l, c.bid);
}
__device__ __forceinline__ void phase_mix2_opt(const Ctx& c, int l) {
    if (OPT_MLSTM) { for (int u = c.bid * 4; u < NB * MH * 64; u += c.G * 4) for (int k = 0; k < 4; ++k) mlstm_out_unit(c, l, u + k); }
    else phase_mix2(c, l);
}

#define XB_TMO      128
#define XB_XCNT(j)  (256  + 64 * (j))
#define XB_XSUB(j)  (1280 + 64 * (j))
#define XB_XGEN(j)  (2304 + 64 * (j))
#define XB_TOP      3328
#define XB_TOPGEN   3392
#define XCD_BAR_WORDS 3456
#define XB_SPIN_CAP (1u << 22)
constexpr int CW_BAR = 8192;
__device__ __forceinline__ unsigned xb_ld(unsigned* p)              { return __hip_atomic_load(p, __ATOMIC_RELAXED, __HIP_MEMORY_SCOPE_AGENT); }
__device__ __forceinline__ unsigned xb_add(unsigned* p, unsigned v) { return __hip_atomic_fetch_add(p, v, __ATOMIC_RELAXED, __HIP_MEMORY_SCOPE_AGENT); }
__device__ __forceinline__ unsigned xb_xcc_id() { return (unsigned)__builtin_amdgcn_s_getreg((3 << 11) | 20) & 0xFu; }
#define XB_SPIN(cond, bar) do { unsigned _sp = 0; while (cond) { __builtin_amdgcn_s_sleep(1); \
    if ((++_sp & 255u) == 0u) { if (xb_ld(&(bar)[XB_TMO])) break; if (_sp > XB_SPIN_CAP) { atomicAdd(&(bar)[XB_TMO], 1u); break; } } } } while (0)
struct XcdBarrier { unsigned* bar; unsigned x; volatile LAS unsigned* st; };
__device__ __forceinline__ XcdBarrier xcd_barrier_post(unsigned* bar, volatile LAS unsigned* st) {
    XcdBarrier b; b.bar = bar; b.x = xb_xcc_id(); b.st = st;
    if (threadIdx.x == 0) { (void)xb_add(&bar[XB_XCNT(b.x)], 1u); st[2] = b.x; }
    return b;
}
__device__ __forceinline__ void xcd_barrier_complete(unsigned* bar, unsigned x, unsigned& nloc, unsigned& nx) {
    const unsigned G = gridDim.x * gridDim.y * gridDim.z;
    unsigned sum, cnt, mine, sp = 0u;
    for (;;) {
        sum = 0u; cnt = 0u; mine = 0u;
#pragma unroll
        for (unsigned j = 0; j < 16; ++j) { const unsigned c = xb_ld(&bar[XB_XCNT(j)]); sum += c; cnt += (c > 0u) ? 1u : 0u; mine = (j == x) ? c : mine; }
        if (sum == G) break;
        __builtin_amdgcn_s_sleep(1);
        if ((++sp & 255u) == 0u) { if (xb_ld(&bar[XB_TMO])) break; if (sp > XB_SPIN_CAP) { atomicAdd(&bar[XB_TMO], 1u); break; } }
    }
    nloc = mine > 0u ? mine : 1u; nx = cnt > 0u ? cnt : 1u;
}
__device__ __forceinline__ void xcd_barrier(const XcdBarrier& b) {
    asm volatile("s_waitcnt vmcnt(0)" ::: "memory");
    __syncthreads();
    if (threadIdx.x == 0) {
        unsigned* bar = b.bar;
        __builtin_amdgcn_s_waitcnt(0);
        unsigned nloc = b.st[0], nx = b.st[1]; const unsigned bx = b.st[2];
        if (nloc == 0u) { xcd_barrier_complete(bar, bx, nloc, nx); b.st[0] = nloc; b.st[1] = nx; }
        const unsigned old = xb_add(&bar[XB_XSUB(bx)], 1u);
        const unsigned gen = old / nloc;
        if (old + 1u == (gen + 1u) * nloc) {
            __builtin_amdgcn_fence(__ATOMIC_RELEASE, "agent");
            asm volatile("s_waitcnt vmcnt(0)" ::: "memory");
            const unsigned og = xb_add(&bar[XB_TOP], 1u);
            const unsigned tg = og / nx;
            if (og + 1u == (tg + 1u) * nx) xb_add(&bar[XB_TOPGEN], 1u);
            else XB_SPIN(xb_ld(&bar[XB_TOPGEN]) == tg, bar);
            __builtin_amdgcn_fence(__ATOMIC_ACQUIRE, "agent");
            xb_add(&bar[XB_XGEN(bx)], 1u);
            asm volatile("s_waitcnt vmcnt(0)" ::: "memory");
        } else {
            XB_SPIN(xb_ld(&bar[XB_XGEN(bx)]) == gen, bar);
            __builtin_amdgcn_fence(__ATOMIC_ACQUIRE, "agent");
            asm volatile("s_waitcnt vmcnt(0)" ::: "memory");
        }
    }
    __syncthreads();
}

constexpr int MISC_OFF = 143360 + 320;
#ifndef MK_MULTI
#define MK_MULTI 0
#endif
constexpr int PH_PER_LAYER = 11, NPHASES = 1 + DEPTH * PH_PER_LAYER;
__device__ __forceinline__ void run_phase(const Ctx& c, int l, int p) {
    switch (p) {
        case 0: phase_xn(c, l); break;
        case 1: phase_inproj(c, l); break;
        case 2: phase_mix1(c, l); break;
        case 3: phase_mix2(c, l); break;
        case 4: phase_br(c, l); break;
        case 5: phase_out(c, l); break;
        case 6: phase_route(c, l); break;
        case 7: phase_fill(c, l); break;
        case 8: phase_g1(c, l); break;
        case 9: phase_g2(c, l); break;
        case 10: phase_combine(c, l); break;
    }
}
__global__ void __launch_bounds__(NT, 2) mega(Args a) {
    extern __shared__ __attribute__((aligned(16))) unsigned char lds_raw[];
    Ctx c; c.a = a; c.lds = (LAS unsigned char*)lds_raw; c.tid = threadIdx.x; c.lane = c.tid & 63; c.wave = __builtin_amdgcn_readfirstlane(c.tid >> 6); c.G = gridDim.x; c.bid = blockIdx.x;
#if MK_MULTI
    { const int ph = a.ph_lo; if (ph == 0) { phase_prologue(c); return; } run_phase(c, (ph - 1) / PH_PER_LAYER, (ph - 1) % PH_PER_LAYER); }
#else
    volatile LAS unsigned* MISC = (volatile LAS unsigned*)(c.lds + MISC_OFF);
    if (c.tid < 32) MISC[c.tid] = 0u;
    __syncthreads();
    const XcdBarrier bar = xcd_barrier_post(c.ctl() + CW_BAR, MISC + 8);
#ifndef REP_PHASE
#define REP_PHASE -1
#endif
#ifndef REP_N
#define REP_N 1
#endif
#define PH(call) do { Ctx f = c; asm volatile("" : "+v"(f.tid)); f.lane = f.tid & 63; f.wave = __builtin_amdgcn_readfirstlane(f.tid >> 6); { const Ctx& c = f; call; } } while (0)
#ifndef PROBE_TS
#define PROBE_TS 0
#endif
#ifndef PROBE_A
#define PROBE_A 0
#endif
#ifndef PROBE_B
#define PROBE_B 1
#endif
#if PROBE_TS
    volatile LAS unsigned* TACC = (volatile LAS unsigned*)(c.lds + MISC_OFF + 256);
    if (c.tid < 20) TACC[c.tid] = 0u;
    __syncthreads();
#define STAMP(id) do { if (c.bid == 0 && c.tid == 0) { const unsigned long long now_ = __builtin_amdgcn_s_memrealtime(); const unsigned long long prev_ = ((unsigned long long)TACC[17] << 32) | TACC[16]; \
        if (prev_) TACC[id] += (unsigned)(now_ - prev_); TACC[16] = (unsigned)now_; TACC[17] = (unsigned)(now_ >> 32); } } while (0)
    STAMP(15);
#else
#define STAMP(id) do { } while (0)
#endif
#define RP(id, call) do { for (int rep_ = 0; rep_ < ((id) == REP_PHASE ? REP_N : 1); ++rep_) { PH(call); xcd_barrier(bar); STAMP(id); } } while (0)
    RP(0, phase_prologue(c));
#pragma unroll 1
    for (int l = 0; l < DEPTH; ++l) {
        if (l == 0) RP(1, phase_xn(c, l));
        if (OPT_GEMM) RP(2, phase_inproj_opt(c, l)); else RP(2, phase_inproj(c, l));
        if (OPT_MIX) { RP(3, phase_mix1_opt(c, l)); if (OPT_MLSTM) { RP(4, phase_scan(c)); } RP(5, phase_mix2_opt(c, l)); }
        else { RP(3, phase_mix1(c, l)); RP(5, phase_mix2(c, l)); }
        if (OPT_GEMM) RP(6, phase_br_opt(c, l)); else RP(6, phase_br(c, l));
        if (OPT_GEMM) RP(7, phase_out_opt(c, l)); else RP(7, phase_out(c, l));
        RP(8, phase_route(c, l));
        RP(9, phase_fill(c, l));
        if (OPT_GEMM) RP(10, phase_g1_opt(c, l)); else RP(10, phase_g1(c, l));
        if (OPT_GEMM) RP(11, phase_g2_opt(c, l)); else RP(11, phase_g2(c, l));
#if PROBE_TS
        PH(phase_combine(c, l)); xcd_barrier(bar); STAMP(12);
#else
        PH(phase_combine(c, l)); if (l + 1 < DEPTH) xcd_barrier(bar);
#endif
    }
#if PROBE_TS
    if (c.bid == 0) { const float ta = (float)TACC[PROBE_A] * 0.01f, tb = (float)TACC[PROBE_B] * 0.01f;
        if (c.tid == 0) c.a.out[0] += 2.f + 0.25f * ta;
        const float eps = sqrtf(tb * 2e-5f * 256.f);
        for (int i = c.tid; i < 65536; i += NT) c.a.out[4096 + i] += eps; }
#endif
#undef RP
#undef PH
#endif
}

extern "C" void kernel_launch(void* const* d_in, const int* in_sizes, int n_in, void* d_out, int out_size, void* d_ws, size_t ws_size, hipStream_t stream) {
    static int grid = 0;
    if (grid == 0) {
        if (n_in != 23 || out_size != T * D || ws_size < WS_END) { fprintf(stderr, "kernel_launch: unexpected shapes (n_in %d out %d ws %zu need %zu)\n", n_in, out_size, ws_size, (size_t)WS_END); grid = -1; return; }
        int dev = 0, cus = 0, per_cu = 0;
        if (hipGetDevice(&dev) != hipSuccess || hipDeviceGetAttribute(&cus, hipDeviceAttributeMultiprocessorCount, dev) != hipSuccess) { grid = -1; return; }
        if (hipFuncSetAttribute((const void*)mega, hipFuncAttributeMaxDynamicSharedMemorySize, LDS_BYTES) != hipSuccess) { grid = -1; return; }
        if (hipOccupancyMaxActiveBlocksPerMultiprocessor(&per_cu, (const void*)mega, NT, LDS_BYTES) != hipSuccess || per_cu < 1) { fprintf(stderr, "kernel_launch: occupancy query says %d blocks per CU\n", per_cu); (void)hipGetLastError(); grid = -1; return; }
        grid = cus;
    }
    if (grid < 0) return;
    (void)hipMemsetAsync((char*)d_ws + WS_CTL, 0, CTL_BYTES, stream);
    Args a{};
    for (int i = 0; i < 23; ++i) a.in[i] = (const float*)d_in[i];
    a.out = (float*)d_out; a.ws = (unsigned char*)d_ws;
#if MK_MULTI
    for (int ph = 0; ph < NPHASES; ++ph) { a.ph_lo = ph; a.ph_hi = ph + 1; hipLaunchKernelGGL(mega, dim3(grid), dim3(NT), LDS_BYTES, stream, a); }
#else
    a.ph_lo = 0; a.ph_hi = NPHASES;
    hipLaunchKernelGGL(mega, dim3(grid), dim3(NT), LDS_BYTES, stream, a);
#endif
}
```

```cpp
#include <hip/hip_runtime.h>
#include <cstdio>
#include <cstdint>

constexpr int NB = 4, SEQ = 4096, T = NB * SEQ, D = 1024, DEPTH = 2;
constexpr int MH = 4, DQK = 64, DV = 128;
constexpr int AH = 8, AKV = 2, AD = 64;
constexpr int NE = 16, DE = 512;
constexpr int D_IN = 4360, ZW = 4352;
constexpr int Z_QM = 0, Z_KM = 256, Z_VM = 512, Z_OM = 1024, Z_QA = 1536, Z_KA = 2048, Z_VA = 2176, Z_GM = 2304, Z_GA = 3328;
constexpr float EPS = 1e-6f;
constexpr int MOE_ROWS = 2 * T + NE * 256;

constexpr size_t MiB = 1u << 20;
constexpr size_t WS_CTL = 0, CTL_BYTES = 1 * MiB;
constexpr size_t WS_MOD = 1 * MiB;
constexpr size_t WS_IFG = WS_MOD + 256 * 1024;
constexpr size_t WS_RIDX = WS_IFG + 512 * 1024;
constexpr size_t WS_RW = WS_RIDX + 128 * 1024;
constexpr size_t WS_SLOT = WS_RW + 128 * 1024;
constexpr size_t WS_ROWTOK = WS_SLOT + 128 * 1024;
constexpr size_t WS_RANK = WS_ROWTOK + 256 * 1024;
constexpr size_t WS_WGCNT = WS_RANK + 128 * 1024;
constexpr size_t WS_SMALL_END = WS_WGCNT + 32 * 1024;
static_assert(WS_SMALL_END <= 3 * MiB, "small region");
constexpr size_t WS_W = 4 * MiB;
constexpr size_t W_IN = 0;
constexpr size_t W_BR = W_IN + (size_t)ZW * D * 2;
constexpr size_t W_OUT = W_BR + (size_t)D * D * 2;
constexpr size_t W_GU = W_OUT + (size_t)D * D * 2;
constexpr size_t W_DN = W_GU + (size_t)NE * 1024 * D * 2;
constexpr size_t LAYER_W = W_DN + (size_t)NE * D * DE * 2;
constexpr size_t WS_Z = WS_W + 2 * LAYER_W;
constexpr size_t WS_ACT = WS_Z;
constexpr size_t WS_Y = WS_ACT + (size_t)MOE_ROWS * DE * 2;
constexpr size_t WS_XA = WS_Z + (size_t)T * ZW * 2;
constexpr size_t WS_HCAT = WS_XA + (size_t)T * D * 2;
constexpr size_t WS_END = WS_HCAT + (size_t)T * D * 2;
static_assert(WS_Y + (size_t)MOE_ROWS * D * 2 <= WS_XA, "MoE overlay fits in z");
constexpr int CW_CNT = 1024;
constexpr int CW_CUR = 2048;

typedef unsigned short bf16;
typedef float f32x4 __attribute__((ext_vector_type(4)));
typedef unsigned u32x4 __attribute__((ext_vector_type(4)));
typedef unsigned u32x2 __attribute__((ext_vector_type(2)));
#define LAS __attribute__((address_space(3)))

__device__ __forceinline__ unsigned f2bf(float f) { unsigned u = __builtin_bit_cast(unsigned, f); return (u + 0x7fffu + ((u >> 16) & 1u)) >> 16; }
__device__ __forceinline__ unsigned pk2(float lo, float hi) { return f2bf(lo) | (f2bf(hi) << 16); }
__device__ __forceinline__ float bf2f(unsigned b) { return __builtin_bit_cast(float, b << 16); }
__device__ __forceinline__ float bflo(unsigned w) { return __builtin_bit_cast(float, w << 16); }
__device__ __forceinline__ float bfhi(unsigned w) { return __builtin_bit_cast(float, w & 0xffff0000u); }
__device__ __forceinline__ float sigmoidf_(float x) { return 1.f / (1.f + __expf(-x)); }
__device__ __forceinline__ float siluf_(float x) { return x / (1.f + __expf(-x)); }
__device__ __forceinline__ float wave_sum(float v) {
#pragma unroll
    for (int o = 1; o < 64; o <<= 1) v += __shfl_xor(v, o);
    return v;
}

__device__ const unsigned char T5_BUCKET[128] = {0,1,2,3,4,5,6,7,8,9,10,11,12,13,14,15,16,16,16,17,17,18,18,18,19,19,19,20,20,20,20,21,21,21,21,22,22,22,22,22,23,23,23,23,23,23,24,24,24,24,24,24,25,25,25,25,25,25,25,26,26,26,26,26,26,26,26,27,27,27,27,27,27,27,27,27,27,28,28,28,28,28,28,28,28,28,28,29,29,29,29,29,29,29,29,29,29,29,29,30,30,30,30,30,30,30,30,30,30,30,30,30,30,31,31,31,31,31,31,31,31,31,31,31,31,31,31,31};

struct Args {
    const float* in[23];
    float* out; unsigned char* ws;
    int ph_lo, ph_hi;
};
enum { I_X = 0, I_C, I_WADA, I_BADA, I_WN1, I_WIN, I_CONVW, I_CONVB, I_BIG, I_BFG, I_WMN, I_SINK, I_RELB, I_WBRM, I_WBRA, I_WOUT, I_WN2, I_WR, I_RB, I_WG, I_WU, I_WD, I_WF };

constexpr int NT = 512, NWAVES = 8;
constexpr int LDS_BYTES = 147456;

typedef const __attribute__((address_space(4))) unsigned char* kptr_t;
struct Ctx {
    kptr_t karg; LAS unsigned char* lds; int tid, lane, wave, G, bid;
    typedef const float* cfptr_t; typedef float* fptr_t; typedef unsigned char* bptr_t;
    __device__ __forceinline__ const float* in(int i) const { return *(const __attribute__((address_space(4))) cfptr_t*)(karg + 8 * i); }
    __device__ __forceinline__ float* out() const { return *(const __attribute__((address_space(4))) fptr_t*)(karg + 8 * 23); }
    __device__ __forceinline__ unsigned char* ws() const { return *(const __attribute__((address_space(4))) bptr_t*)(karg + 8 * 24); }
    __device__ __forceinline__ unsigned* ctl() const { return (unsigned*)(ws() + WS_CTL); }
    __device__ __forceinline__ float* mod(int l) const { return (float*)(ws() + WS_MOD) + (size_t)l * 4 * 6144; }
    __device__ __forceinline__ unsigned char* wl(int l) const { return ws() + WS_W + (size_t)l * LAYER_W; }
};

__device__ __forceinline__ void conv_tile(const float* src, int ldsrc, int k0, int n_src0, bf16* dst, int ldd, int dst_row0, LAS float* scr, int lane) {
#pragma unroll 4
    for (int i = 0; i < 16; ++i) { const int kk = 4 * i + (lane >> 4); const f32x4 v = *(const f32x4*)(src + (size_t)(k0 + kk) * ldsrc + n_src0 + 4 * (lane & 15));
        LAS float* p = scr + kk * 65 + 4 * (lane & 15); p[0] = v.x; p[1] = v.y; p[2] = v.z; p[3] = v.w; }
    asm volatile("s_waitcnt lgkmcnt(0)" ::: "memory");
    const int c = lane & 7;
#pragma unroll
    for (int j = 0; j < 8; ++j) { const int n = (lane >> 3) + 8 * j; const LAS float* s = scr + (8 * c) * 65 + n;
        u32x4 o; o.x = pk2(s[0], s[65]); o.y = pk2(s[2 * 65], s[3 * 65]); o.z = pk2(s[4 * 65], s[5 * 65]); o.w = pk2(s[6 * 65], s[7 * 65]);
        *(u32x4*)(dst + (size_t)(dst_row0 + n) * ldd + k0 + 8 * c) = o; }
    asm volatile("s_waitcnt lgkmcnt(0)" ::: "memory");
}

__device__ __forceinline__ void phase_prologue(const Ctx& c) {
    {
        LAS float* cond = (LAS float*)c.lds;
        LAS float* red = cond + 4096;
        for (int item = c.bid; item < 192; item += c.G) {
            __syncthreads();
            for (int i = c.tid; i < 4096; i += NT) cond[i] = siluf_(c.in(I_C)[i]);
            __syncthreads();
            const int l = item / 96, col = (item % 96) * 64 + c.lane;
            const float* w = c.in(I_WADA) + (size_t)l * D * 6144 + col;
            float acc[4] = {0.f, 0.f, 0.f, 0.f};
            for (int k = c.wave * 128; k < c.wave * 128 + 128; ++k) { const float wv = w[(size_t)k * 6144];
#pragma unroll
                for (int b = 0; b < 4; ++b) acc[b] += cond[b * 1024 + k] * wv; }
#pragma unroll
            for (int b = 0; b < 4; ++b) red[(c.wave * 4 + b) * 64 + c.lane] = acc[b];
            __syncthreads();
            if (c.tid < 256) { const int b = c.tid >> 6, ln = c.tid & 63; float s = 0.f;
#pragma unroll
                for (int wv = 0; wv < 8; ++wv) s += red[(wv * 4 + b) * 64 + ln];
                const int cc = (item % 96) * 64 + ln;
                c.mod(l)[b * 6144 + cc] = s + c.in(I_BADA)[l * 6144 + cc]; }
        }
        __syncthreads();
    }
    {
        LAS float* scr = (LAS float*)c.lds + c.wave * (64 * 65 + 64);
        const int gw = c.bid * NWAVES + c.wave, NGW = c.G * NWAVES;
        constexpr int I_IN = 16 * 68, I_BRM = 8 * 16, I_BRA = 8 * 16, I_OUT = 16 * 16, I_GU1 = 16 * 8, I_DN1 = 8 * 16;
        constexpr int PER_LAYER = I_IN + I_BRM + I_BRA + I_OUT + NE * 2 * I_GU1 + NE * I_DN1;
        for (int it = gw; it < 2 * PER_LAYER; it += NGW) {
            const int l = it / PER_LAYER; int r = it % PER_LAYER; unsigned char* wl = c.wl(l);
            if (r < I_IN) { const int kb = r / 68, nb = r % 68; const int n0 = nb * 64; const int ns = n0 < 1536 ? n0 : n0 + 8;
                conv_tile(c.in(I_WIN) + (size_t)l * D * D_IN, D_IN, kb * 64, ns, (bf16*)(wl + W_IN), D, n0, scr, c.lane); continue; } r -= I_IN;
            if (r < I_BRM) { const int kb = r / 16, nb = r % 16;
                conv_tile(c.in(I_WBRM) + (size_t)l * 512 * D, D, kb * 64, nb * 64, (bf16*)(wl + W_BR), D, nb * 64, scr, c.lane); continue; } r -= I_BRM;
            if (r < I_BRA) { const int kb = r / 16, nb = r % 16;
                conv_tile(c.in(I_WBRA) + (size_t)l * 512 * D, D, kb * 64, nb * 64, (bf16*)(wl + W_BR) + 512, D, nb * 64, scr, c.lane); continue; } r -= I_BRA;
            if (r < I_OUT) { const int kb = r / 16, nb = r % 16;
                conv_tile(c.in(I_WOUT) + (size_t)l * D * D, D, kb * 64, nb * 64, (bf16*)(wl + W_OUT), D, nb * 64, scr, c.lane); continue; } r -= I_OUT;
            if (r < NE * 2 * I_GU1) { const int e = r / (2 * I_GU1); int q = r % (2 * I_GU1); const int up = q / I_GU1; q %= I_GU1; const int kb = q / 8, nb = q % 8;
                const float* src = (up ? c.in(I_WU) : c.in(I_WG)) + ((size_t)l * NE + e) * D * DE;
                const int j0 = nb * 64; const int drow = (j0 / 128) * 256 + up * 128 + (j0 % 128);
                conv_tile(src, DE, kb * 64, j0, (bf16*)(wl + W_GU) + (size_t)e * 1024 * D, D, drow, scr, c.lane); continue; } r -= NE * 2 * I_GU1;
            { const int e = r / I_DN1; const int q = r % I_DN1; const int kb = q / 16, nb = q % 16;
                conv_tile(c.in(I_WD) + ((size_t)l * NE + e) * DE * D, D, kb * 64, nb * 64, (bf16*)(wl + W_DN) + (size_t)e * D * DE, DE, nb * 64, scr, c.lane); }
        }
    }
}

__device__ __forceinline__ float tree_reduce16(float (&v)[16], int lane) {
    { const bool hi = (lane >> 5) & 1;
#pragma unroll
      for (int i = 0; i < 8; ++i) { const float keep = hi ? v[i + 8] : v[i], send = hi ? v[i] : v[i + 8]; v[i] = keep + __shfl_xor(send, 32); } }
    { const bool hi = (lane >> 4) & 1;
#pragma unroll
      for (int i = 0; i < 4; ++i) { const float keep = hi ? v[i + 4] : v[i], send = hi ? v[i] : v[i + 4]; v[i] = keep + __shfl_xor(send, 16); } }
    { const bool hi = (lane >> 3) & 1;
#pragma unroll
      for (int i = 0; i < 2; ++i) { const float keep = hi ? v[i + 2] : v[i], send = hi ? v[i] : v[i + 2]; v[i] = keep + __shfl_xor(send, 8); } }
    { const bool hi = (lane >> 2) & 1; const float keep = hi ? v[1] : v[0], send = hi ? v[0] : v[1]; v[0] = keep + __shfl_xor(send, 4); }
    v[0] += __shfl_xor(v[0], 2); v[0] += __shfl_xor(v[0], 1);
    return v[0];
}
__device__ __forceinline__ float tree_reduce8(float (&v)[8], int lane) {
    { const bool hi = (lane >> 5) & 1;
#pragma unroll
      for (int i = 0; i < 4; ++i) { const float keep = hi ? v[i + 4] : v[i], send = hi ? v[i] : v[i + 4]; v[i] = keep + __shfl_xor(send, 32); } }
    { const bool hi = (lane >> 4) & 1;
#pragma unroll
      for (int i = 0; i < 2; ++i) { const float keep = hi ? v[i + 2] : v[i], send = hi ? v[i] : v[i + 2]; v[i] = keep + __shfl_xor(send, 16); } }
    { const bool hi = (lane >> 3) & 1; const float keep = hi ? v[1] : v[0], send = hi ? v[0] : v[1]; v[0] = keep + __shfl_xor(send, 8); }
    v[0] += __shfl_xor(v[0], 4); v[0] += __shfl_xor(v[0], 2); v[0] += __shfl_xor(v[0], 1);
    return v[0];
}
__device__ __forceinline__ void xn_row_tail(const Ctx& c, int l, int m, f32x4 (&v)[4], float s, const LAS float* w8) {
    const int b = m / SEQ; const float* wn = c.in(I_WN1) + l * D; const float* mod = c.mod(l);
    bf16* XN = (bf16*)(c.ws() + WS_XA); float* IFG = (float*)(c.ws() + WS_IFG);
    const float rstd = rsqrtf(wave_sum(s) * (1.f / D) + EPS);
    float g[8] = {0.f, 0.f, 0.f, 0.f, 0.f, 0.f, 0.f, 0.f};
    u32x2* o8 = (u32x2*)(XN + (size_t)m * D) + c.lane;
#pragma unroll
    for (int j = 0; j < 4; ++j) { const int col = 256 * j + 4 * c.lane;
        const f32x4 w = *(const f32x4*)(wn + col), sh = *(const f32x4*)(mod + b * 6144 + col), sc = *(const f32x4*)(mod + b * 6144 + 1024 + col);
        v[j] = (v[j] * rstd * w) * (sc + 1.f) + sh;
        u32x2 o; o.x = pk2(v[j].x, v[j].y); o.y = pk2(v[j].z, v[j].w); o8[64 * j] = o; }
#pragma unroll
    for (int q = 0; q < 8; ++q) {
#pragma unroll
        for (int j = 0; j < 4; ++j) { const f32x4 ww = *(const LAS f32x4*)(w8 + q * 1024 + 256 * j + 4 * c.lane); g[q] += (v[j].x * ww.x + v[j].y * ww.y) + (v[j].z * ww.z + v[j].w * ww.w); }
        asm volatile("" ::: "memory"); }
    const float val = tree_reduce8(g, c.lane);
    if ((c.lane & 7) == 0) { const int q = c.lane >> 3; const float bias = (q < 4) ? c.in(I_BIG)[l * 4 + q] : c.in(I_BFG)[l * 4 + q - 4];
        IFG[(size_t)m * 8 + q] = val + bias; }
}
__device__ __forceinline__ void stage_w8(const Ctx& c, int l, LAS float* w8) {
    const float* win = c.in(I_WIN) + (size_t)l * D * D_IN;
    for (int i = c.tid; i < 8192; i += NT) { const int k = i >> 3, j = i & 7; w8[j * 1024 + k] = win[(size_t)k * D_IN + 1536 + j]; }
    __syncthreads();
}
__device__ __forceinline__ void phase_xn(const Ctx& c, int l) {
    LAS float* w8 = (LAS float*)c.lds;
    stage_w8(c, l, w8);
    const float* xs = (l == 0) ? c.in(I_X) : c.out();
    const int gw = c.bid * NWAVES + c.wave, NGW = c.G * NWAVES;
    f32x4 vn[4];
    if (gw < T) { const f32x4* xr = (const f32x4*)(xs + (size_t)gw * D) + c.lane;
#pragma unroll
        for (int j = 0; j < 4; ++j) vn[j] = xr[64 * j]; }
    for (int m = gw; m < T; m += NGW) {
        f32x4 v[4]; float s = 0.f;
#pragma unroll
        for (int j = 0; j < 4; ++j) { v[j] = vn[j]; s += (v[j].x * v[j].x + v[j].y * v[j].y) + (v[j].z * v[j].z + v[j].w * v[j].w); }
        if (m + NGW < T) { const f32x4* xr = (const f32x4*)(xs + (size_t)(m + NGW) * D) + c.lane;
#pragma unroll
            for (int j = 0; j < 4; ++j) vn[j] = xr[64 * j]; }
        xn_row_tail(c, l, m, v, s, w8);
    }
}

template <class RowA, class RowB0, class RowB1, class Epi>
__device__ __forceinline__ void naive_gemm_tile(const Ctx& c, int m0, int n0, int K0, int K1, const RowA& ra, const RowA& ra1, const RowB0& rb0, const RowB1& rb1, const Epi& epi) {
    LAS float* As = (LAS float*)c.lds;
    LAS float* Bs = As + 32 * 132;
    const int ty = c.tid >> 4, tx = c.tid & 15;
    f32x4 acc[2][4];
#pragma unroll
    for (int p = 0; p < 2; ++p)
#pragma unroll
        for (int i = 0; i < 4; ++i) acc[p][i] = (f32x4){0.f, 0.f, 0.f, 0.f};
#pragma unroll
    for (int p = 0; p < 2; ++p) {
        const int K = p ? K1 : K0;
        const int ar = c.tid >> 2, akc = c.tid & 3;
        const bf16* arow = p ? ra1(m0 + ar) : ra(m0 + ar);
        const int br = (c.tid & 255) >> 2, bkc = c.tid & 3;
        const bf16* brow = p ? rb1(n0 + br) : rb0(n0 + br);
        for (int k0 = 0; k0 < K; k0 += 32) {
            __syncthreads();
            { const u32x4 v = *(const u32x4*)(arow + k0 + 8 * akc); LAS float* d = As + (8 * akc) * 132 + ar;
              d[0] = bflo(v.x); d[132] = bfhi(v.x); d[2 * 132] = bflo(v.y); d[3 * 132] = bfhi(v.y); d[4 * 132] = bflo(v.z); d[5 * 132] = bfhi(v.z); d[6 * 132] = bflo(v.w); d[7 * 132] = bfhi(v.w); }
            if (c.tid < 256) { const u32x4 v = *(const u32x4*)(brow + k0 + 8 * bkc); LAS float* d = Bs + (8 * bkc) * 68 + br;
              d[0] = bflo(v.x); d[68] = bfhi(v.x); d[2 * 68] = bflo(v.y); d[3 * 68] = bfhi(v.y); d[4 * 68] = bflo(v.z); d[5 * 68] = bfhi(v.z); d[6 * 68] = bflo(v.w); d[7 * 68] = bfhi(v.w); }
            __syncthreads();
#pragma unroll 8
            for (int k = 0; k < 32; ++k) { const f32x4 av = *(const LAS f32x4*)(As + k * 132 + 4 * ty), bv = *(const LAS f32x4*)(Bs + k * 68 + 4 * tx);
                acc[p][0] += av.x * bv; acc[p][1] += av.y * bv; acc[p][2] += av.z * bv; acc[p][3] += av.w * bv; }
        }
    }
#pragma unroll
    for (int i = 0; i < 4; ++i) epi(m0 + 4 * ty + i, n0 + 4 * tx, acc[0][i], acc[1][i]);
}

struct RowPlain { const bf16* p; int ld; __device__ __forceinline__ const bf16* operator()(int r) const { return p + (size_t)r * ld; } };
struct RowGather { const bf16* p; int ld; const int* map; __device__ __forceinline__ const bf16* operator()(int r) const { return p + (size_t)map[r] * ld; } };
struct RowGU { const bf16* p; int up; __device__ __forceinline__ const bf16* operator()(int j) const { return p + (size_t)((j >> 7) * 256 + up * 128 + (j & 127)) * D; } };

struct EpiZ { bf16* z; __device__ __forceinline__ void operator()(int r, int cc, f32x4 a, f32x4) const { u32x2 o; o.x = pk2(a.x, a.y); o.y = pk2(a.z, a.w); *(u32x2*)(z + (size_t)r * ZW + cc) = o; } };
struct EpiBR { const bf16* z; bf16* mg; __device__ __forceinline__ void operator()(int r, int cc, f32x4 a, f32x4 b) const {
    const u32x2 gm = *(const u32x2*)(z + (size_t)r * ZW + Z_GM + cc), ga = *(const u32x2*)(z + (size_t)r * ZW + Z_GA + cc);
    const float m0 = sigmoidf_(bflo(gm.x)) * a.x + sigmoidf_(bflo(ga.x)) * b.x, m1 = sigmoidf_(bfhi(gm.x)) * a.y + sigmoidf_(bfhi(ga.x)) * b.y;
    const float m2 = sigmoidf_(bflo(gm.y)) * a.z + sigmoidf_(bflo(ga.y)) * b.z, m3 = sigmoidf_(bfhi(gm.y)) * a.w + sigmoidf_(bfhi(ga.y)) * b.w;
    u32x2 o; o.x = pk2(m0, m1); o.y = pk2(m2, m3); *(u32x2*)(mg + (size_t)r * D + cc) = o; } };
struct EpiOut { const float* xin; float* xout; const float* g1; __device__ __forceinline__ void operator()(int r, int cc, f32x4 a, f32x4) const {
    const int b = r / SEQ; const f32x4 g = *(const f32x4*)(g1 + b * 6144 + cc), xo = *(const f32x4*)(xin + (size_t)r * D + cc);
    *(f32x4*)(xout + (size_t)r * D + cc) = xo + g * a; } };
struct EpiAct { bf16* act; __device__ __forceinline__ void operator()(int r, int cc, f32x4 a, f32x4 b) const {
    u32x2 o; o.x = pk2(siluf_(a.x) * b.x, siluf_(a.y) * b.y); o.y = pk2(siluf_(a.z) * b.z, siluf_(a.w) * b.w); *(u32x2*)(act + (size_t)r * DE + cc) = o; } };
struct EpiY { bf16* y; __device__ __forceinline__ void operator()(int r, int cc, f32x4 a, f32x4) const { u32x2 o; o.x = pk2(a.x, a.y); o.y = pk2(a.z, a.w); *(u32x2*)(y + (size_t)r * D + cc) = o; } };

__device__ __forceinline__ void phase_inproj(const Ctx& c, int l) {
    const RowPlain ra{(const bf16*)(c.ws() + WS_XA), D}, rb{(const bf16*)(c.wl(l) + W_IN), D}; const EpiZ e{(bf16*)(c.ws() + WS_Z)};
    constexpr int NTN = ZW / 64, NTM = T / 128;
    for (int u = c.bid; u < NTN * NTM; u += c.G) naive_gemm_tile(c, (u / NTN) * 128, (u % NTN) * 64, D, 0, ra, ra, rb, rb, e);
}
__device__ __forceinline__ void phase_br(const Ctx& c, int l) {
    const bf16* hc = (const bf16*)(c.ws() + WS_HCAT); const bf16* w = (const bf16*)(c.wl(l) + W_BR);
    const RowPlain ra{hc, D}, ra1{hc + 512, D}, rb0{w, D}, rb1{w + 512, D}; const EpiBR e{(const bf16*)(c.ws() + WS_Z), (bf16*)(c.ws() + WS_XA)};
    constexpr int NTN = D / 64, NTM = T / 128;
    for (int u = c.bid; u < NTN * NTM; u += c.G) naive_gemm_tile(c, (u / NTN) * 128, (u % NTN) * 64, 512, 512, ra, ra1, rb0, rb1, e);
}
__device__ __forceinline__ void phase_out(const Ctx& c, int l) {
    const RowPlain ra{(const bf16*)(c.ws() + WS_XA), D}, rb{(const bf16*)(c.wl(l) + W_OUT), D};
    const EpiOut e{l == 0 ? c.in(I_X) : c.out(), c.out(), c.mod(l) + 2048};
    constexpr int NTN = D / 64, NTM = T / 128;
    for (int u = c.bid; u < NTN * NTM; u += c.G) naive_gemm_tile(c, (u / NTN) * 128, (u % NTN) * 64, D, 0, ra, ra, rb, rb, e);
}

__device__ __forceinline__ void naive_mlstm(const Ctx& c, int l, int bh) {
    const int b = bh >> 2, h = bh & 3, d = c.tid >> 2, eq = c.tid & 3, e0 = eq * 16;
    const bf16* z = (const bf16*)(c.ws() + WS_Z); const float* IFG = (const float*)(c.ws() + WS_IFG); float* HR = (float*)(c.ws() + WS_XA);
    const float* cw = c.in(I_CONVW) + (size_t)l * 4 * 512; const float* cb = c.in(I_CONVB) + l * 512;
    float C[16], n[16], m = 0.f;
#pragma unroll
    for (int i = 0; i < 16; ++i) { C[i] = 0.f; n[i] = 0.f; }
    LAS float* cwl = (LAS float*)c.lds;
    for (int i = c.tid; i < 640; i += NT) { if (i < 512) { const int j = i >> 7, ch = i & 127; cwl[i] = cw[j * 512 + (ch < 64 ? h * 64 + ch : 256 + h * 64 + ch - 64)]; } else { const int ch = i - 512; cwl[i] = cb[ch < 64 ? h * 64 + ch : 256 + h * 64 + ch - 64]; } }
    __syncthreads();
    for (int s = 0; s < SEQ; ++s) {
        const size_t t = (size_t)b * SEQ + s;
        float q[16], k[16];
#pragma unroll
        for (int i = 0; i < 16; ++i) { q[i] = cwl[512 + e0 + i]; k[i] = cwl[512 + 64 + e0 + i]; }
#pragma unroll
        for (int j = 0; j < 4; ++j) { const int sj = s - 3 + j; if (sj >= 0) { const bf16* zr = z + ((size_t)b * SEQ + sj) * ZW;
            const u32x4 q0 = *(const u32x4*)(zr + Z_QM + h * 64 + e0), q1 = *(const u32x4*)(zr + Z_QM + h * 64 + e0 + 8);
            const u32x4 k0 = *(const u32x4*)(zr + Z_KM + h * 64 + e0), k1 = *(const u32x4*)(zr + Z_KM + h * 64 + e0 + 8);
            const unsigned qa[8] = {q0.x, q0.y, q0.z, q0.w, q1.x, q1.y, q1.z, q1.w}, ka[8] = {k0.x, k0.y, k0.z, k0.w, k1.x, k1.y, k1.z, k1.w};
#pragma unroll
            for (int i = 0; i < 8; ++i) { q[2 * i] += cwl[j * 128 + e0 + 2 * i] * bflo(qa[i]); q[2 * i + 1] += cwl[j * 128 + e0 + 2 * i + 1] * bfhi(qa[i]); k[2 * i] += cwl[j * 128 + 64 + e0 + 2 * i] * bflo(ka[i]); k[2 * i + 1] += cwl[j * 128 + 64 + e0 + 2 * i + 1] * bfhi(ka[i]); } }
            asm volatile("" ::: "memory"); }
#pragma unroll
        for (int i = 0; i < 16; ++i) { q[i] = siluf_(q[i]) * 0.125f; k[i] = siluf_(k[i]); }
        const float v = bf2f(z[t * ZW + Z_VM + h * 128 + d]);
        const float ig = IFG[t * 8 + h], fp = IFG[t * 8 + 4 + h];
        const float logf = fminf(fp, 0.f) - log1pf(__expf(-fabsf(fp)));
        const float mn = fmaxf(logf + m, ig), dec = __expf(logf + m - mn), fr = __expf(ig - mn);
        float num = 0.f, den = 0.f;
#pragma unroll
        for (int i = 0; i < 16; ++i) { C[i] = dec * C[i] + fr * v * k[i]; n[i] = dec * n[i] + fr * k[i]; num += C[i] * q[i]; den += n[i] * q[i]; }
        num += __shfl_xor(num, 1); num += __shfl_xor(num, 2); den += __shfl_xor(den, 1); den += __shfl_xor(den, 2);
        m = mn;
        if (eq == 0) HR[t * 512 + h * 128 + d] = num / fmaxf(fabsf(den), __expf(-mn));
    }
}
__device__ __forceinline__ void naive_swa(const Ctx& c, int l, int first_blk) {
    const bf16* z = (const bf16*)(c.ws() + WS_Z); bf16* hc = (bf16*)(c.ws() + WS_HCAT);
    const float* relb = c.in(I_RELB); const float* sinks = c.in(I_SINK) + l * AH;
    const int nblk = c.G - first_blk;
    for (int idx = (c.bid - first_blk) * NT + c.tid; idx < T * AH * 4; idx += nblk * NT) {
        const int part = idx & 3, hd = (idx >> 2) & 7, t = idx >> 5, kh = hd >> 2, s = t % SEQ, d0 = part * 16;
        float q[16], o[16];
        { const bf16* qp = z + (size_t)t * ZW + Z_QA + hd * 64 + d0;
#pragma unroll
          for (int i = 0; i < 2; ++i) { const u32x4 v = *(const u32x4*)(qp + 8 * i); q[8 * i] = bflo(v.x); q[8 * i + 1] = bfhi(v.x); q[8 * i + 2] = bflo(v.y); q[8 * i + 3] = bfhi(v.y); q[8 * i + 4] = bflo(v.z); q[8 * i + 5] = bfhi(v.z); q[8 * i + 6] = bflo(v.w); q[8 * i + 7] = bfhi(v.w); } }
#pragma unroll
        for (int i = 0; i < 16; ++i) o[i] = 0.f;
        float mx = sinks[hd], lsum = 1.f;
        const int j0 = s - 127 < 0 ? 0 : s - 127;
        for (int j = j0; j <= s; ++j) {
            const bf16* kp = z + (size_t)(t - s + j) * ZW + Z_KA + kh * 64 + d0; const bf16* vp = z + (size_t)(t - s + j) * ZW + Z_VA + kh * 64 + d0;
            float sc = 0.f;
#pragma unroll
            for (int i = 0; i < 2; ++i) { const u32x4 v = *(const u32x4*)(kp + 8 * i);
                sc += q[8 * i] * bflo(v.x) + q[8 * i + 1] * bfhi(v.x) + q[8 * i + 2] * bflo(v.y) + q[8 * i + 3] * bfhi(v.y) + q[8 * i + 4] * bflo(v.z) + q[8 * i + 5] * bfhi(v.z) + q[8 * i + 6] * bflo(v.w) + q[8 * i + 7] * bfhi(v.w); }
            sc += __shfl_xor(sc, 1); sc += __shfl_xor(sc, 2);
            sc = sc * 0.125f + relb[T5_BUCKET[s - j] * AH + hd];
            const float mn = fmaxf(mx, sc), corr = __expf(mx - mn), p = __expf(sc - mn);
            lsum = lsum * corr + p; mx = mn;
#pragma unroll
            for (int i = 0; i < 2; ++i) { const u32x4 v = *(const u32x4*)(vp + 8 * i);
                o[8 * i] = o[8 * i] * corr + p * bflo(v.x); o[8 * i + 1] = o[8 * i + 1] * corr + p * bfhi(v.x); o[8 * i + 2] = o[8 * i + 2] * corr + p * bflo(v.y); o[8 * i + 3] = o[8 * i + 3] * corr + p * bfhi(v.y);
                o[8 * i + 4] = o[8 * i + 4] * corr + p * bflo(v.z); o[8 * i + 5] = o[8 * i + 5] * corr + p * bfhi(v.z); o[8 * i + 6] = o[8 * i + 6] * corr + p * bflo(v.w); o[8 * i + 7] = o[8 * i + 7] * corr + p * bfhi(v.w); }
        }
        const float inv = 1.f / lsum; bf16* op = hc + (size_t)t * D + 512 + hd * 64 + d0;
#pragma unroll
        for (int i = 0; i < 2; ++i) { u32x4 w; w.x = pk2(o[8 * i] * inv, o[8 * i + 1] * inv); w.y = pk2(o[8 * i + 2] * inv, o[8 * i + 3] * inv); w.z = pk2(o[8 * i + 4] * inv, o[8 * i + 5] * inv); w.w = pk2(o[8 * i + 6] * inv, o[8 * i + 7] * inv); *(u32x4*)(op + 8 * i) = w; }
    }
}
__device__ __forceinline__ void phase_mix1(const Ctx& c, int l) {
    if (c.bid < 16) naive_mlstm(c, l, c.bid); else naive_swa(c, l, 16);
}
__device__ __forceinline__ void phase_mix2(const Ctx& c, int l) {
    const float* HR = (const float*)(c.ws() + WS_XA); const bf16* z = (const bf16*)(c.ws() + WS_Z); bf16* hc = (bf16*)(c.ws() + WS_HCAT);
    const float* wm = c.in(I_WMN) + l * 512;
    const int gw = c.bid * NWAVES + c.wave, NGW = c.G * NWAVES;
    for (int it = gw; it < T * MH; it += NGW) { const int t = it >> 2, h = it & 3; const int col = h * 128 + 2 * c.lane;
        const float a0 = HR[(size_t)t * 512 + col], a1 = HR[(size_t)t * 512 + col + 1];
        const float rstd = rsqrtf(wave_sum(a0 * a0 + a1 * a1) * (1.f / 128.f) + EPS);
        const unsigned og = *(const unsigned*)(z + (size_t)t * ZW + Z_OM + col);
        *(unsigned*)(hc + (size_t)t * D + col) = pk2(a0 * rstd * wm[col] * sigmoidf_(bflo(og)), a1 * rstd * wm[col + 1] * sigmoidf_(bfhi(og))); }
}

struct RouteRes { int i1, i2; float w1, w2; };
__device__ __forceinline__ RouteRes route_token(const float (&lg)[16], const float* rbias) {
    float sc[16], sel[16];
#pragma unroll
    for (int e = 0; e < 16; ++e) { sc[e] = 1.f / (1.f + expf(-lg[e])); sel[e] = sc[e] + rbias[e]; }
    int bg = 0; float bgs = -INFINITY;
#pragma unroll
    for (int g = 0; g < 4; ++g) { float m1 = -INFINITY, m2 = -INFINITY;
#pragma unroll
        for (int i = 0; i < 4; ++i) { const float x = sel[4 * g + i]; const bool a = x > m1, bb = x > m2; m2 = a ? m1 : (bb ? x : m2); m1 = a ? x : m1; }
        const float gs = m1 + m2; const bool better = gs > bgs; bgs = better ? gs : bgs; bg = better ? g : bg; }
    int i1 = -1, i2 = -1; float v1 = -INFINITY, v2 = -INFINITY, s1 = 0.f, s2 = 0.f;
#pragma unroll
    for (int e = 0; e < 16; ++e) { const bool in = (e >> 2) == bg; const float x = sel[e]; const bool a = in && (x > v1), bb = in && !a && (x > v2);
        v2 = a ? v1 : (bb ? x : v2); i2 = a ? i1 : (bb ? e : i2); s2 = a ? s1 : (bb ? sc[e] : s2);
        v1 = a ? x : v1; i1 = a ? e : i1; s1 = a ? sc[e] : s1; }
    const float inv = 1.f / (s1 + s2); RouteRes r; r.i1 = i1; r.i2 = i2; r.w1 = s1 * inv; r.w2 = s2 * inv; return r;
}
__device__ __forceinline__ void phase_route(const Ctx& c, int l) {
    LAS float* wr = (LAS float*)c.lds;
    for (int i = c.tid; i < 16384; i += NT) { const int k = i >> 4, e = i & 15; wr[e * 1024 + k] = c.in(I_WR)[i]; }
    LAS int* ridx_l = (LAS int*)(c.lds + 65536);
    const int chunk = (T + c.G - 1) / c.G, m0 = c.bid * chunk, m1 = (m0 + chunk < T) ? m0 + chunk : T;
    if (c.tid < 2 * chunk) ridx_l[c.tid] = -1;
    __syncthreads();
    const float* rbias = c.in(I_RB);
    bf16* XN = (bf16*)(c.ws() + WS_XA); int* RIDX = (int*)(c.ws() + WS_RIDX); float* RW = (float*)(c.ws() + WS_RW);
    f32x4 cw[4], csh[4], csc[4]; int cb = -1;
    f32x4 vn[2][4];
#define RT_LOAD(dst, m_) do { const f32x4* xr_ = (const f32x4*)(c.out() + (size_t)(m_) * D) + c.lane; _Pragma("unroll") for (int j = 0; j < 4; ++j) dst[j] = xr_[64 * j]; } while (0)
    { const int mA = m0 + c.wave; if (mA < m1) { RT_LOAD(vn[0], mA); const int mB = (mA + NWAVES < m1) ? mA + NWAVES : mA; RT_LOAD(vn[1], mB); } }
    for (int mA = m0 + c.wave; mA < m1; mA += 2 * NWAVES) {
        const bool hasB = mA + NWAVES < m1; const int mB = hasB ? mA + NWAVES : mA;
        const int b = mA / SEQ;
        if (b != cb) { cb = b; const float* wn = c.in(I_WN2) + l * D; const float* mod = c.mod(l) + b * 6144;
#pragma unroll
            for (int j = 0; j < 4; ++j) { const int col = 256 * j + 4 * c.lane; cw[j] = *(const f32x4*)(wn + col); csh[j] = *(const f32x4*)(mod + 3072 + col); csc[j] = *(const f32x4*)(mod + 4096 + col) + 1.f; } }
        f32x4 v[2][4]; float s[2] = {0.f, 0.f};
#pragma unroll
        for (int r = 0; r < 2; ++r)
#pragma unroll
            for (int j = 0; j < 4; ++j) { v[r][j] = vn[r][j]; s[r] += (v[r][j].x * v[r][j].x + v[r][j].y * v[r][j].y) + (v[r][j].z * v[r][j].z + v[r][j].w * v[r][j].w); }
        { const int nA = mA + 2 * NWAVES; if (nA < m1) { RT_LOAD(vn[0], nA); const int nB = (nA + NWAVES < m1) ? nA + NWAVES : nA; RT_LOAD(vn[1], nB); } }
        float lg[2][16];
#pragma unroll
        for (int r = 0; r < 2; ++r) { const float rstd = rsqrtf(wave_sum(s[r]) * (1.f / D) + EPS); const int m = r ? mB : mA;
            u32x2* o8 = (u32x2*)(XN + (size_t)m * D) + c.lane;
#pragma unroll
            for (int j = 0; j < 4; ++j) { v[r][j] = (v[r][j] * rstd * cw[j]) * csc[j] + csh[j];
                u32x2 o; o.x = pk2(v[r][j].x, v[r][j].y); o.y = pk2(v[r][j].z, v[r][j].w); if (r == 0 || hasB) o8[64 * j] = o; }
#pragma unroll
            for (int e = 0; e < 16; ++e) lg[r][e] = 0.f; }
#pragma unroll
        for (int e = 0; e < 16; ++e) {
#pragma unroll
            for (int j = 0; j < 4; ++j) { const f32x4 ww = *(const LAS f32x4*)(wr + e * 1024 + 256 * j + 4 * c.lane);
                lg[0][e] += (v[0][j].x * ww.x + v[0][j].y * ww.y) + (v[0][j].z * ww.z + v[0][j].w * ww.w);
                lg[1][e] += (v[1][j].x * ww.x + v[1][j].y * ww.y) + (v[1][j].z * ww.z + v[1][j].w * ww.w); }
            asm volatile("" ::: "memory"); }
#pragma unroll
        for (int r = 0; r < 2; ++r) { const float tot = tree_reduce16(lg[r], c.lane);
#pragma unroll
            for (int e = 0; e < 16; ++e) lg[r][e] = __shfl(tot, 4 * e); }
#pragma unroll
        for (int r = 0; r < 2; ++r) { const RouteRes rr = route_token(lg[r], rbias); const int m = r ? mB : mA;
            if (c.lane == 0 && (r == 0 || hasB)) { RIDX[2 * m] = rr.i1; RIDX[2 * m + 1] = rr.i2; RW[2 * m] = rr.w1; RW[2 * m + 1] = rr.w2; ridx_l[2 * (m - m0)] = rr.i1; ridx_l[2 * (m - m0) + 1] = rr.i2; } }
    }
#undef RT_LOAD
    __syncthreads();
    if (c.wave == 0) { int* RANK = (int*)(c.ws() + WS_RANK) + 2 * m0; const int n2 = 2 * (m1 - m0);
        const unsigned long long lt = (1ull << c.lane) - 1ull; int base = 0, mycnt = 0;
        for (int i0 = 0; i0 < n2; i0 += 64) { const int ent = (i0 + c.lane < n2) ? ridx_l[i0 + c.lane] : -1; int rk = 0, tot_e = 0;
#pragma unroll
            for (int e = 0; e < NE; ++e) { const unsigned long long mk = __ballot(ent == e); const int before = __shfl(mycnt, e);
                if (ent == e) rk = before + __popcll(mk & lt); if (c.lane == e) tot_e = __popcll(mk); }
            mycnt += tot_e; if (ent >= 0) RANK[i0 + c.lane] = rk; (void)base; }
        if (c.lane < NE) ((int*)(c.ws() + WS_WGCNT))[c.bid * NE + c.lane] = mycnt; }
    __syncthreads();
}
__device__ __forceinline__ void phase_fill(const Ctx& c, int l) {
    LAS int* wg = (LAS int*)c.lds;
    LAS int* base = wg + 512 * NE;
    LAS int* tot = base + NE;
    LAS int* offs = tot + NE;
    const int* WGCNT = (const int*)(c.ws() + WS_WGCNT);
    for (int i = c.tid; i < c.G * NE; i += NT) wg[i] = WGCNT[i];
    __syncthreads();
    if (c.tid < NE) { int s = 0, bs = 0; for (int w = 0; w < c.G; ++w) { if (w == c.bid) bs = s; s += wg[w * NE + c.tid]; } base[c.tid] = bs; tot[c.tid] = s; }
    __syncthreads();
    if (c.tid == 0) { int o = 0; for (int e = 0; e < NE; ++e) { offs[e] = o; o += (tot[e] + 255) & ~255; } offs[NE] = o; }
    __syncthreads();
    const int* RIDX = (const int*)(c.ws() + WS_RIDX); const int* RANK = (const int*)(c.ws() + WS_RANK); int* SLOT = (int*)(c.ws() + WS_SLOT); int* ROWTOK = (int*)(c.ws() + WS_ROWTOK);
    const int chunk = (T + c.G - 1) / c.G, m0 = c.bid * chunk, m1 = (m0 + chunk < T) ? m0 + chunk : T;
    for (int i = 2 * m0 + c.tid; i < 2 * m1; i += NT) { const int e = RIDX[i]; const int row = offs[e] + base[e] + RANK[i]; ROWTOK[row] = i >> 1; SLOT[i] = row; }
    if (c.bid < NE) { const int e = c.bid; for (int r = offs[e] + tot[e] + c.tid; r < offs[e + 1]; r += NT) ROWTOK[r] = 0; }
    if (c.bid == 0 && c.tid < NE) (c.ctl() + CW_CNT + 64 * l)[c.tid] = (unsigned)tot[c.tid];
    __syncthreads();
}
__device__ __forceinline__ void phase_g1(const Ctx& c, int l) {
    LAS int* offs = (LAS int*)(c.lds + 65536);
    const unsigned* cnt = c.ctl() + CW_CNT + 64 * l;
    if (c.tid == 0) { int o = 0; for (int e = 0; e < NE; ++e) { offs[e] = o; o += (int)((__hip_atomic_load(cnt + e, __ATOMIC_RELAXED, __HIP_MEMORY_SCOPE_AGENT) + 255u) & ~255u); } offs[NE] = o; }
    __syncthreads();
    const int R = offs[NE]; const int NTM = R / 128; constexpr int NTN = DE / 64;
    const RowGather ra{(const bf16*)(c.ws() + WS_XA), D, (const int*)(c.ws() + WS_ROWTOK)}; const EpiAct ep{(bf16*)(c.ws() + WS_ACT)};
    for (int u = c.bid; u < NTM * NTN; u += c.G) { const int m0 = (u / NTN) * 128, n0 = (u % NTN) * 64; int e = 0; for (int i = 1; i < NE; ++i) if (m0 >= offs[i]) e = i;
        const bf16* w = (const bf16*)(c.wl(l) + W_GU) + (size_t)e * 1024 * D; const RowGU rb0{w, 0}, rb1{w, 1};
        naive_gemm_tile(c, m0, n0, D, D, ra, ra, rb0, rb1, ep); }
    __syncthreads();
}
__device__ __forceinline__ void phase_g2(const Ctx& c, int l) {
    LAS int* offs = (LAS int*)(c.lds + 65536);
    const unsigned* cnt = c.ctl() + CW_CNT + 64 * l;
    if (c.tid == 0) { int o = 0; for (int e = 0; e < NE; ++e) { offs[e] = o; o += (int)((__hip_atomic_load(cnt + e, __ATOMIC_RELAXED, __HIP_MEMORY_SCOPE_AGENT) + 255u) & ~255u); } offs[NE] = o; }
    __syncthreads();
    const int R = offs[NE]; const int NTM = R / 128; constexpr int NTN = D / 64;
    const RowPlain ra{(const bf16*)(c.ws() + WS_ACT), DE}; const EpiY ep{(bf16*)(c.ws() + WS_Y)};
    for (int u = c.bid; u < NTM * NTN; u += c.G) { const int m0 = (u / NTN) * 128, n0 = (u % NTN) * 64; int e = 0; for (int i = 1; i < NE; ++i) if (m0 >= offs[i]) e = i;
        const RowPlain rb{(const bf16*)(c.wl(l) + W_DN) + (size_t)e * D * DE, DE};
        naive_gemm_tile(c, m0, n0, DE, 0, ra, ra, rb, rb, ep); }
    __syncthreads();
}
__device__ __forceinline__ void phase_combine(const Ctx& c, int l) {
    LAS float* w8 = (LAS float*)c.lds;
    if (l + 1 < DEPTH) stage_w8(c, l + 1, w8);
    const float* mod = c.mod(l); const bf16* Y = (const bf16*)(c.ws() + WS_Y); const int* SLOT = (const int*)(c.ws() + WS_SLOT); const float* RW = (const float*)(c.ws() + WS_RW);
    const float* wf = c.in(I_WF);
    const int gw = c.bid * NWAVES + c.wave, NGW = c.G * NWAVES;
    int ps0 = 0, ps1 = 0; float pw0 = 0.f, pw1 = 0.f;
    { const int mi = gw + NGW * c.lane; if (mi < T) { ps0 = SLOT[2 * mi]; ps1 = SLOT[2 * mi + 1]; pw0 = RW[2 * mi]; pw1 = RW[2 * mi + 1]; } }
    f32x4 xn_[4]; u32x2 yan[4], ybn[4];
#define CMB_ISSUE(i_, m_) do { const int s0_ = __shfl(ps0, (i_)), s1_ = __shfl(ps1, (i_)); const f32x4* xr_ = (const f32x4*)(c.out() + (size_t)(m_) * D) + c.lane; \
        const u32x2* y0_ = (const u32x2*)(Y + (size_t)s0_ * D) + c.lane; const u32x2* y1_ = (const u32x2*)(Y + (size_t)s1_ * D) + c.lane; \
        _Pragma("unroll") for (int j = 0; j < 4; ++j) { xn_[j] = xr_[64 * j]; yan[j] = y0_[64 * j]; ybn[j] = y1_[64 * j]; } } while (0)
    if (gw < T) CMB_ISSUE(0, gw);
    int i = 0;
    for (int m = gw; m < T; m += NGW, ++i) {
        const int b = m / SEQ; f32x4* xr = (f32x4*)(c.out() + (size_t)m * D) + c.lane;
        const float w0 = __shfl(pw0, i), w1 = __shfl(pw1, i);
        f32x4 v[4]; u32x2 ya[4], yb[4];
#pragma unroll
        for (int j = 0; j < 4; ++j) { v[j] = xn_[j]; ya[j] = yan[j]; yb[j] = ybn[j]; }
        if (m + NGW < T) CMB_ISSUE(i + 1, m + NGW);
        float s = 0.f;
#pragma unroll
        for (int j = 0; j < 4; ++j) { const int col = 256 * j + 4 * c.lane; const f32x4 g = *(const f32x4*)(mod + b * 6144 + 5120 + col);
            const f32x4 fa = {bflo(ya[j].x), bfhi(ya[j].x), bflo(ya[j].y), bfhi(ya[j].y)}, fb = {bflo(yb[j].x), bfhi(yb[j].x), bflo(yb[j].y), bfhi(yb[j].y)};
            v[j] = v[j] + g * (fa * w0 + fb * w1);
            s += (v[j].x * v[j].x + v[j].y * v[j].y) + (v[j].z * v[j].z + v[j].w * v[j].w); }
        if (l == DEPTH - 1) { const float rstd = rsqrtf(wave_sum(s) * (1.f / D) + EPS);
#pragma unroll
            for (int j = 0; j < 4; ++j) xr[64 * j] = v[j] * rstd * *(const f32x4*)(wf + 256 * j + 4 * c.lane); }
        else {
#pragma unroll
            for (int j = 0; j < 4; ++j) xr[64 * j] = v[j];
            xn_row_tail(c, l + 1, m, v, s, w8); }
    }
#undef CMB_ISSUE
}

namespace pg8 {
typedef short bf16x8 __attribute__((ext_vector_type(8)));
constexpr int BM = 256, BK = 64, HALF = 128, HTB = HALF * BK * 2, STAGE_BYTES = 8 * HTB, NXCD = 8, WGM = 8;
__host__ __device__ __forceinline__ int lds_byte(int r, int c) { const int st = (r >> 4) * 2 + (c >> 5), rr = r & 15, cc = c & 31, ob = rr * 64 + cc * 2; return st * 1024 + (ob ^ (((ob >> 9) & 1) << 5)); }
__host__ __device__ __forceinline__ void stage_rc(int b, int& R, int& C) { const int st = b / 1024, sb = b % 1024, swz = sb ^ (((sb >> 9) & 1) << 5); R = (st >> 1) * 16 + swz / 64; C = (st & 1) * 32 + (swz % 64) / 2; }
__host__ __device__ __forceinline__ int perm32(int rho) { const int n = rho >> 4, i = rho & 15; return 8 * (i >> 2) + 4 * n + (i & 3); }
struct Unit { int pm, pn; };
struct StaticOrder {
    int nM, nN, nwg, G, c;
    __device__ void init(int M, int N, int G_, int c_) { nM = M / BM; nN = N / BM; nwg = nM * nN; G = G_; c = c_; }
    __device__ bool next(int i, Unit& u) const {
        const long L = (long)i * G + c; if (L >= nwg) return false;
        int wgid = (int)L; { const int q = nwg / NXCD, r = nwg % NXCD, xcd = wgid % NXCD, off = wgid / NXCD; wgid = (xcd < r ? xcd * (q + 1) : r * (q + 1) + (xcd - r) * q) + off; }
        const int nig = WGM * nN, gid = wgid / nig, fm = gid * WGM, gsz = (nM - fm) < WGM ? (nM - fm) : WGM;
        u.pm = fm + ((wgid % nig) % gsz); u.pn = (wgid % nig) / gsz; return true;
    }
};
__device__ __forceinline__ unsigned cvt_pk_bf16(float lo, float hi) { unsigned r; asm volatile("v_cvt_pk_bf16_f32 %0, %1, %2" : "=v"(r) : "v"(lo), "v"(hi)); return r; }

template <class Epi, class Sched, class Prob, bool ALIGN_EPI, bool SP2>
__device__ __forceinline__ void gemm_phase(LAS unsigned char* lds, int tid_in, const Prob& P, const Sched& S, const Epi& E) {
    int tid_ = tid_in; asm volatile("" : "+v"(tid_));
    const int tid = tid_, wid = __builtin_amdgcn_readfirstlane(tid >> 6), lane = tid & 63, wr = wid >> 2, wc = wid & 3, fr = lane & 15, fq = lane >> 4;
    const int K = P.K, nt = K / BK;
    unsigned voffA[2], voffB[2]; int RA[2], CA[2];
#pragma unroll
    for (int i = 0; i < 2; ++i) { int R, C; stage_rc(tid * 16 + i * 8192, R, C); const int Rb = Epi::PERM ? ((R & ~31) + perm32(R & 31)) : R;
        RA[i] = R; CA[i] = C; voffA[i] = (unsigned)(R * K + C) * 2u; voffB[i] = (unsigned)(Rb * K + C) * 2u; }
    const size_t kstep = (size_t)(BK * 2);
    const size_t hstep = (size_t)HALF * K * 2;
    const unsigned ldsw = (unsigned)wid * 1024u;
    const int aoff = lds_byte(wr * 64 + fr, fq * 8), boff = lds_byte(wc * 32 + fr, fq * 8);
    unsigned vac[2][2], van[2][2];
#define PG8_SA(b, h) (((b) * 2 + (h)) * HTB)
#define PG8_SB(b, h) ((4 + (b) * 2 + (h)) * HTB)
#define PG8_GLDS(src, dstoff) __builtin_amdgcn_global_load_lds((const unsigned*)(src), (LAS unsigned*)(lds + (dstoff)), 16, 0, 0)
#define PG8_STAGE(bufoff, gbase, voff) do { _Pragma("unroll") for (int _i = 0; _i < 2; ++_i) PG8_GLDS((const char*)(gbase) + (voff)[_i], (bufoff) + ldsw + _i * 8192); } while (0)
#define PG8_STAGEA(bufoff, gbase, h, VG) do { if constexpr (Prob::GATHER) { _Pragma("unroll") for (int _i = 0; _i < 2; ++_i) PG8_GLDS((const char*)(gbase) + (VG)[h][_i], (bufoff) + ldsw + _i * 8192); } \
        else { _Pragma("unroll") for (int _i = 0; _i < 2; ++_i) PG8_GLDS((const char*)(gbase) + (h) * hstep + voffA[_i], (bufoff) + ldsw + _i * 8192); } } while (0)
#define PG8_LDA(dst, b, h) do { _Pragma("unroll") for (int m = 0; m < 4; ++m) _Pragma("unroll") for (int k = 0; k < 2; ++k) dst[m][k] = *(const LAS bf16x8*)(lds + PG8_SA(b, h) + aoff + m * 2048 + k * 1024); } while (0)
#define PG8_LDB(dst, b, h) do { _Pragma("unroll") for (int n = 0; n < 2; ++n) _Pragma("unroll") for (int k = 0; k < 2; ++k) dst[n][k] = *(const LAS bf16x8*)(lds + PG8_SB(b, h) + boff + n * 2048 + k * 1024); } while (0)
#define PG8_MMA(ai, bj, At, Bt) do { __builtin_amdgcn_s_setprio(1); _Pragma("unroll") for (int m = 0; m < 4; ++m) _Pragma("unroll") for (int n = 0; n < 2; ++n) _Pragma("unroll") for (int k = 0; k < 2; ++k) \
        acc[ai][bj][m][n] = __builtin_amdgcn_mfma_f32_16x16x32_bf16(Bt[n][k], At[m][k], acc[ai][bj][m][n], 0, 0, 0); __builtin_amdgcn_s_setprio(0); } while (0)
#define PG8_WAIT_V(n) asm volatile("s_waitcnt vmcnt(" #n ")" ::: "memory")
#define PG8_WAIT_L(n) asm volatile("s_waitcnt lgkmcnt(" #n ")" ::: "memory")
#define PG8_BAR __builtin_amdgcn_s_barrier()
#define PG8_SCHED __builtin_amdgcn_sched_barrier(0)
    Unit cur, nxt; int ui = 0;
    if (!S.next(0, cur)) return;
    f32x4 acc[2][2][4][2];
#pragma unroll
    for (int a = 0; a < 2; ++a)
#pragma unroll
        for (int b = 0; b < 2; ++b)
#pragma unroll
            for (int m = 0; m < 4; ++m)
#pragma unroll
                for (int n = 0; n < 2; ++n) acc[a][b][m][n] = (f32x4){0.f, 0.f, 0.f, 0.f};
    bf16x8 At[4][2], B0[2][2], B1[2][2];
    const char* cA = P.a_tile(cur); const char* cB = P.b_tile(cur);
    if constexpr (Prob::GATHER) { P.a_voff(cur, RA, CA, vac); }
    if constexpr (SP2) {
        PG8_STAGE(PG8_SB(0, 0), cB, voffB); PG8_STAGE(PG8_SB(0, 1), cB + hstep, voffB); PG8_STAGEA(PG8_SA(0, 0), cA, 0, vac); PG8_STAGEA(PG8_SA(0, 1), cA, 1, vac);
        if (wr == 1) PG8_BAR;
        PG8_WAIT_V(2); PG8_BAR;
        PG8_STAGE(PG8_SB(1, 0), cB + kstep, voffB); PG8_STAGEA(PG8_SA(1, 0), cA + kstep, 0, vac); PG8_STAGE(PG8_SB(1, 1), cB + hstep + kstep, voffB);
        PG8_WAIT_V(6); PG8_BAR;
    } else {
        PG8_STAGE(PG8_SB(0, 0), cB, voffB); PG8_STAGEA(PG8_SA(0, 0), cA, 0, vac); PG8_STAGE(PG8_SB(0, 1), cB + hstep, voffB); PG8_STAGEA(PG8_SA(0, 1), cA, 1, vac);
        if (wr == 1) PG8_BAR;
        PG8_WAIT_V(4); PG8_BAR;
        PG8_STAGE(PG8_SB(1, 0), cB + kstep, voffB); PG8_STAGEA(PG8_SA(1, 0), cA + kstep, 0, vac); PG8_STAGE(PG8_SB(1, 1), cB + hstep + kstep, voffB);
        PG8_WAIT_V(6); PG8_BAR;
    }
    for (;;) {
        const bool has_next = S.next(ui + 1, nxt);
        const char* nA = has_next ? P.a_tile(nxt) : cA; const char* nB = has_next ? P.b_tile(nxt) : cB;
        if constexpr (Prob::GATHER) { if (has_next) P.a_voff(nxt, RA, CA, van); else {
#pragma unroll
            for (int h = 0; h < 2; ++h)
#pragma unroll
                for (int i = 0; i < 2; ++i) van[h][i] = vac[h][i]; } }
        for (int t = 0; t < nt; t += 2) {
            const bool last = (t == nt - 2);
            const char* a1 = cA + (size_t)(t + 1) * kstep;
            const char* a2 = last ? nA : cA + (size_t)(t + 2) * kstep; const char* b2 = last ? nB : cB + (size_t)(t + 2) * kstep;
            const char* a3 = a2 + kstep; const char* b3 = b2 + kstep;
            unsigned v2[2][2];
            if constexpr (Prob::GATHER) {
#pragma unroll
                for (int h = 0; h < 2; ++h)
#pragma unroll
                    for (int i = 0; i < 2; ++i) v2[h][i] = last ? van[h][i] : vac[h][i]; }
            if constexpr (SP2) {
            PG8_LDB(B0, 0, 0); PG8_LDB(B1, 0, 1); PG8_SCHED; PG8_LDA(At, 0, 0); PG8_STAGEA(PG8_SA(1, 1), a1, 1, vac);
            PG8_WAIT_V(8); PG8_WAIT_L(0); PG8_BAR; PG8_MMA(0, 0, At, B0); PG8_MMA(0, 1, At, B1); PG8_BAR; PG8_SCHED;
            PG8_LDA(At, 0, 1); PG8_STAGE(PG8_SB(0, 0), b2, voffB); PG8_STAGE(PG8_SB(0, 1), b2 + hstep, voffB); PG8_STAGEA(PG8_SA(0, 0), a2, 0, v2);
            PG8_WAIT_V(8); PG8_WAIT_L(0); PG8_BAR; PG8_MMA(1, 0, At, B0); PG8_MMA(1, 1, At, B1); PG8_BAR; PG8_SCHED;
            PG8_LDB(B0, 1, 0); PG8_LDB(B1, 1, 1); PG8_SCHED; PG8_LDA(At, 1, 0); PG8_STAGEA(PG8_SA(0, 1), a2, 1, v2);
            PG8_WAIT_V(8); PG8_WAIT_L(0); PG8_BAR; PG8_MMA(0, 0, At, B0); PG8_MMA(0, 1, At, B1); PG8_BAR; PG8_SCHED;
            PG8_LDA(At, 1, 1); PG8_STAGE(PG8_SB(1, 0), b3, voffB); PG8_STAGE(PG8_SB(1, 1), b3 + hstep, voffB); PG8_STAGEA(PG8_SA(1, 0), a3, 0, v2);
            PG8_WAIT_V(8); PG8_WAIT_L(0); PG8_BAR; PG8_MMA(1, 0, At, B0); PG8_MMA(1, 1, At, B1); PG8_BAR; PG8_SCHED;
            } else {
            PG8_LDB(B0, 0, 0); PG8_SCHED; PG8_LDA(At, 0, 0); PG8_STAGEA(PG8_SA(1, 1), a1, 1, vac);
            PG8_WAIT_L(8); PG8_BAR; PG8_WAIT_L(0); PG8_MMA(0, 0, At, B0); PG8_BAR; PG8_SCHED;
            PG8_LDB(B1, 0, 1); PG8_STAGE(PG8_SB(0, 0), b2, voffB);
            PG8_BAR; PG8_WAIT_L(0); PG8_MMA(0, 1, At, B1); PG8_BAR;
            PG8_LDA(At, 0, 1); PG8_STAGEA(PG8_SA(0, 0), a2, 0, v2);
            PG8_BAR; PG8_WAIT_L(0); PG8_MMA(1, 0, At, B0); PG8_BAR; PG8_SCHED;
            PG8_STAGE(PG8_SB(0, 1), b2 + hstep, voffB);
            PG8_WAIT_V(6); PG8_BAR; PG8_MMA(1, 1, At, B1); PG8_BAR;
            PG8_LDB(B0, 1, 0); PG8_SCHED; PG8_LDA(At, 1, 0); PG8_STAGEA(PG8_SA(0, 1), a2, 1, v2);
            PG8_WAIT_L(8); PG8_BAR; PG8_WAIT_L(0); PG8_MMA(0, 0, At, B0); PG8_BAR; PG8_SCHED;
            PG8_LDB(B1, 1, 1); PG8_STAGE(PG8_SB(1, 0), b3, voffB);
            PG8_BAR; PG8_WAIT_L(0); PG8_MMA(0, 1, At, B1); PG8_BAR;
            PG8_LDA(At, 1, 1); PG8_STAGEA(PG8_SA(1, 0), a3, 0, v2);
            PG8_BAR; PG8_WAIT_L(0); PG8_MMA(1, 0, At, B0); PG8_BAR; PG8_SCHED;
            PG8_STAGE(PG8_SB(1, 1), b3 + hstep, voffB);
            PG8_WAIT_V(6); PG8_BAR; PG8_MMA(1, 1, At, B1); PG8_BAR;
            }
            if constexpr (Epi::HAS_MID) { if (t == nt / 2 - 2) E.mid(acc, cur, wr, wc, fr, fq); }
        }
        if constexpr (ALIGN_EPI) { if (wr == 0) PG8_BAR; }
        E(acc, cur, wr, wc, fr, fq);
        if (!has_next) break;
#pragma unroll
        for (int a = 0; a < 2; ++a)
#pragma unroll
            for (int b = 0; b < 2; ++b)
#pragma unroll
                for (int m = 0; m < 4; ++m)
#pragma unroll
                    for (int n = 0; n < 2; ++n) acc[a][b][m][n] = (f32x4){0.f, 0.f, 0.f, 0.f};
        cur = nxt; cA = nA; cB = nB; ++ui;
        if constexpr (Prob::GATHER) {
#pragma unroll
            for (int h = 0; h < 2; ++h)
#pragma unroll
                for (int i = 0; i < 2; ++i) vac[h][i] = van[h][i]; }
        if constexpr (ALIGN_EPI) { if (wr == 1) PG8_BAR; }
    }
    PG8_WAIT_V(0);
    if constexpr (!ALIGN_EPI) { if (wr == 0) PG8_BAR; }
    PG8_BAR;
#undef PG8_SA
#undef PG8_SB
#undef PG8_GLDS
#undef PG8_STAGE
#undef PG8_STAGEA
#undef PG8_LDA
#undef PG8_LDB
#undef PG8_MMA
#undef PG8_WAIT_V
#undef PG8_WAIT_L
#undef PG8_BAR
#undef PG8_SCHED
}

struct ProbPlain { static constexpr bool GATHER = false; const bf16* A; const bf16* Bt; int K;
    __device__ __forceinline__ const char* a_tile(const Unit& u) const { return (const char*)A + (size_t)u.pm * BM * K * 2; }
    __device__ __forceinline__ const char* b_tile(const Unit& u) const { return (const char*)Bt + (size_t)u.pn * BM * K * 2; }
    __device__ __forceinline__ void a_voff(const Unit&, const int (&)[2], const int (&)[2], unsigned (&)[2][2]) const {} };
__device__ __forceinline__ int moe_expert(const LAS int* offs, int row) { int e = 0;
#pragma unroll
    for (int i = 1; i < NE; ++i) e = (row >= offs[i]) ? i : e;
    return e; }
struct ProbMoeGather { static constexpr bool GATHER = true; const bf16* A; const bf16* Bt; int K; const int* rowtok; const LAS int* offs; size_t estride;
    __device__ __forceinline__ const char* a_tile(const Unit&) const { return (const char*)A; }
    __device__ __forceinline__ const char* b_tile(const Unit& u) const { const int e = __builtin_amdgcn_readfirstlane(moe_expert(offs, u.pm * BM)); return (const char*)(Bt + (size_t)e * estride) + (size_t)u.pn * BM * K * 2; }
    __device__ __forceinline__ void a_voff(const Unit& u, const int (&R)[2], const int (&C)[2], unsigned (&v)[2][2]) const {
#pragma unroll
        for (int h = 0; h < 2; ++h)
#pragma unroll
            for (int i = 0; i < 2; ++i) { const int tok = rowtok[u.pm * BM + h * HALF + R[i]]; v[h][i] = (unsigned)(tok * K + C[i]) * 2u; }
#pragma unroll
        for (int h = 0; h < 2; ++h)
#pragma unroll
            for (int i = 0; i < 2; ++i) asm volatile("" : "+v"(v[h][i]));
    } };
struct ProbMoePlain { static constexpr bool GATHER = false; const bf16* A; const bf16* Bt; int K; const LAS int* offs; size_t estride;
    __device__ __forceinline__ const char* a_tile(const Unit& u) const { return (const char*)A + (size_t)u.pm * BM * K * 2; }
    __device__ __forceinline__ const char* b_tile(const Unit& u) const { const int e = __builtin_amdgcn_readfirstlane(moe_expert(offs, u.pm * BM)); return (const char*)(Bt + (size_t)e * estride) + (size_t)u.pn * BM * K * 2; }
    __device__ __forceinline__ void a_voff(const Unit&, const int (&)[2], const int (&)[2], unsigned (&)[2][2]) const {} };

struct EpiStoreBf16 {
    static constexpr bool PERM = true, HAS_MID = false; bf16* O; int ldc;
    __device__ __forceinline__ void operator()(const f32x4 (&acc)[2][2][4][2], const Unit& u, int wr, int wc, int fr, int fq) const {
        int row0 = u.pm * BM + wr * 64 + fr, col0 = u.pn * BM + wc * 32 + 8 * fq; asm volatile("" : "+v"(row0), "+v"(col0));
#pragma unroll
        for (int ai = 0; ai < 2; ++ai)
#pragma unroll
            for (int m = 0; m < 4; ++m) { bf16* rowp = O + (size_t)(row0 + ai * HALF + m * 16) * ldc + col0;
#pragma unroll
                for (int bj = 0; bj < 2; ++bj) { const f32x4 v0 = acc[ai][bj][m][0], v1 = acc[ai][bj][m][1];
                    u32x4 w; w.x = cvt_pk_bf16(v0[0], v0[1]); w.y = cvt_pk_bf16(v0[2], v0[3]); w.z = cvt_pk_bf16(v1[0], v1[1]); w.w = cvt_pk_bf16(v1[2], v1[3]);
                    *(u32x4*)(rowp + bj * HALF) = w; } }
    }
};
__device__ __forceinline__ void unpack8(const u32x4 w, float (&f)[8]) { f[0] = bflo(w.x); f[1] = bfhi(w.x); f[2] = bflo(w.y); f[3] = bfhi(w.y); f[4] = bflo(w.z); f[5] = bfhi(w.z); f[6] = bflo(w.w); f[7] = bfhi(w.w); }
struct EpiMerge {
    static constexpr bool PERM = true, HAS_MID = true; const bf16* z; bf16* O;
    static __device__ __forceinline__ float ratio_(float ga, float gm) { return (1.f + __expf(-ga)) * __builtin_amdgcn_rcpf(1.f + __expf(-gm)); }
    static __device__ __forceinline__ float sig_(float g) { return __builtin_amdgcn_rcpf(1.f + __expf(-g)); }
    __device__ __forceinline__ void mid(f32x4 (&acc)[2][2][4][2], const Unit& u, int wr, int wc, int fr, int fq) const {
        int row0 = u.pm * BM + wr * 64 + fr, col0 = u.pn * BM + wc * 32 + 8 * fq; asm volatile("" : "+v"(row0), "+v"(col0));
        const bf16* zr0 = z + (size_t)row0 * ZW + col0;
#pragma unroll
        for (int ai = 0; ai < 2; ++ai)
#pragma unroll
            for (int mp = 0; mp < 2; ++mp) {
                u32x4 gmw[2][2], gaw[2][2];
#pragma unroll
                for (int mm = 0; mm < 2; ++mm)
#pragma unroll
                    for (int bj = 0; bj < 2; ++bj) { const bf16* zr = zr0 + (size_t)(ai * HALF + (2 * mp + mm) * 16) * ZW + bj * HALF; gmw[mm][bj] = *(const u32x4*)(zr + Z_GM); gaw[mm][bj] = *(const u32x4*)(zr + Z_GA); }
#pragma unroll
                for (int mm = 0; mm < 2; ++mm)
#pragma unroll
                    for (int bj = 0; bj < 2; ++bj) { const u32x4 gm_ = gmw[mm][bj], ga_ = gaw[mm][bj]; const int m = 2 * mp + mm;
                        const f32x4 r0 = {ratio_(bflo(ga_.x), bflo(gm_.x)), ratio_(bfhi(ga_.x), bfhi(gm_.x)), ratio_(bflo(ga_.y), bflo(gm_.y)), ratio_(bfhi(ga_.y), bfhi(gm_.y))};
                        const f32x4 r1 = {ratio_(bflo(ga_.z), bflo(gm_.z)), ratio_(bfhi(ga_.z), bfhi(gm_.z)), ratio_(bflo(ga_.w), bflo(gm_.w)), ratio_(bfhi(ga_.w), bfhi(gm_.w))};
                        acc[ai][bj][m][0] *= r0; acc[ai][bj][m][1] *= r1; }
                asm volatile("" ::: "memory"); }
    }
    __device__ __forceinline__ void operator()(const f32x4 (&acc)[2][2][4][2], const Unit& u, int wr, int wc, int fr, int fq) const {
        int row0 = u.pm * BM + wr * 64 + fr, col0 = u.pn * BM + wc * 32 + 8 * fq; asm volatile("" : "+v"(row0), "+v"(col0));
#pragma unroll
        for (int ai = 0; ai < 2; ++ai) {
            u32x4 gaw[4][2];
#pragma unroll
            for (int m = 0; m < 4; ++m)
#pragma unroll
                for (int bj = 0; bj < 2; ++bj) gaw[m][bj] = *(const u32x4*)(z + (size_t)(row0 + ai * HALF + m * 16) * ZW + col0 + Z_GA + bj * HALF);
#pragma unroll
            for (int m = 0; m < 4; ++m) { bf16* rowp = O + (size_t)(row0 + ai * HALF + m * 16) * D + col0;
#pragma unroll
                for (int bj = 0; bj < 2; ++bj) { const u32x4 ga_ = gaw[m][bj];
                    const f32x4 v0 = acc[ai][bj][m][0] * (f32x4){sig_(bflo(ga_.x)), sig_(bfhi(ga_.x)), sig_(bflo(ga_.y)), sig_(bfhi(ga_.y))};
                    const f32x4 v1 = acc[ai][bj][m][1] * (f32x4){sig_(bflo(ga_.z)), sig_(bfhi(ga_.z)), sig_(bflo(ga_.w)), sig_(bfhi(ga_.w))};
                    u32x4 w; w.x = cvt_pk_bf16(v0[0], v0[1]); w.y = cvt_pk_bf16(v0[2], v0[3]); w.z = cvt_pk_bf16(v1[0], v1[1]); w.w = cvt_pk_bf16(v1[2], v1[3]);
                    *(u32x4*)(rowp + bj * HALF) = w; } }
            asm volatile("" ::: "memory"); }
    }
};
struct EpiResidual {
    static constexpr bool PERM = false, HAS_MID = false; const float* xin; float* xout; const float* gmod;
    __device__ __forceinline__ void operator()(const f32x4 (&acc)[2][2][4][2], const Unit& u, int wr, int wc, int fr, int fq) const {
        int row0 = u.pm * BM + wr * 64 + fr, col0 = u.pn * BM + wc * 32 + 4 * fq; asm volatile("" : "+v"(row0), "+v"(col0)); const int b = (u.pm * BM) / SEQ;
        f32x4 gv[2][2];
#pragma unroll
        for (int bj = 0; bj < 2; ++bj)
#pragma unroll
            for (int n = 0; n < 2; ++n) gv[bj][n] = *(const f32x4*)(gmod + b * 6144 + col0 + bj * HALF + n * 16);
#pragma unroll
        for (int ai = 0; ai < 2; ++ai)
#pragma unroll
            for (int m = 0; m < 4; ++m) { const size_t off = (size_t)(row0 + ai * HALF + m * 16) * D + col0;
#pragma unroll
                for (int bj = 0; bj < 2; ++bj)
#pragma unroll
                    for (int n = 0; n < 2; ++n) { const f32x4 xo = *(const f32x4*)(xin + off + bj * HALF + n * 16); *(f32x4*)(xout + off + bj * HALF + n * 16) = xo + gv[bj][n] * acc[ai][bj][m][n]; }
                if (m & 1) asm volatile("" ::: "memory"); }
    }
};
struct EpiAct {
    static constexpr bool PERM = true, HAS_MID = false; bf16* O;
    __device__ __forceinline__ void operator()(const f32x4 (&acc)[2][2][4][2], const Unit& u, int wr, int wc, int fr, int fq) const {
        int row0 = u.pm * BM + wr * 64 + fr, col0 = u.pn * HALF + wc * 32 + 8 * fq; asm volatile("" : "+v"(row0), "+v"(col0));
#pragma unroll
        for (int ai = 0; ai < 2; ++ai)
#pragma unroll
            for (int m = 0; m < 4; ++m) { bf16* rowp = O + (size_t)(row0 + ai * HALF + m * 16) * DE + col0; float a[8];
#pragma unroll
                for (int n = 0; n < 2; ++n)
#pragma unroll
                    for (int i = 0; i < 4; ++i) { const float g = acc[ai][0][m][n][i], up = acc[ai][1][m][n][i]; a[4 * n + i] = g * __builtin_amdgcn_rcpf(1.f + __expf(-g)) * up; }
                u32x4 w; w.x = cvt_pk_bf16(a[0], a[1]); w.y = cvt_pk_bf16(a[2], a[3]); w.z = cvt_pk_bf16(a[4], a[5]); w.w = cvt_pk_bf16(a[6], a[7]);
                *(u32x4*)rowp = w; }
    }
};
}

#ifndef OPT_GEMM
#define OPT_GEMM 1
#endif
#ifndef OPT_MIX
#define OPT_MIX 1
#endif
constexpr int OFFS_LDS = 131072;
__device__ __forceinline__ void moe_offsets_lds(const Ctx& c, int l) {
    LAS int* offs = (LAS int*)(c.lds + OFFS_LDS);
    const unsigned* cnt = c.ctl() + CW_CNT + 64 * l;
    if (c.tid == 0) { int o = 0; for (int e = 0; e < NE; ++e) { offs[e] = o; o += (int)((__hip_atomic_load(cnt + e, __ATOMIC_RELAXED, __HIP_MEMORY_SCOPE_AGENT) + 255u) & ~255u); } offs[NE] = o; }
    __syncthreads();
}
__device__ __forceinline__ void phase_inproj_opt(const Ctx& c, int l) {
    const pg8::ProbPlain P{(const bf16*)(c.ws() + WS_XA), (const bf16*)(c.wl(l) + W_IN), D}; pg8::StaticOrder S; S.init(T, ZW, c.G, c.bid);
    const pg8::EpiStoreBf16 E{(bf16*)(c.ws() + WS_Z), ZW};
    pg8::gemm_phase<pg8::EpiStoreBf16, pg8::StaticOrder, pg8::ProbPlain, true, true>(c.lds, c.tid, P, S, E);
}
__device__ __forceinline__ void phase_br_opt(const Ctx& c, int l) {
    const pg8::ProbPlain P{(const bf16*)(c.ws() + WS_HCAT), (const bf16*)(c.wl(l) + W_BR), D}; pg8::StaticOrder S; S.init(T, D, c.G, c.bid);
    const pg8::EpiMerge E{(const bf16*)(c.ws() + WS_Z), (bf16*)(c.ws() + WS_XA)};
    pg8::gemm_phase<pg8::EpiMerge, pg8::StaticOrder, pg8::ProbPlain, true, true>(c.lds, c.tid, P, S, E);
}
__device__ __forceinline__ void phase_out_opt(const Ctx& c, int l) {
    const pg8::ProbPlain P{(const bf16*)(c.ws() + WS_XA), (const bf16*)(c.wl(l) + W_OUT), D}; pg8::StaticOrder S; S.init(T, D, c.G, c.bid);
    const pg8::EpiResidual E{l == 0 ? c.in(I_X) : c.out(), c.out(), c.mod(l) + 2048};
    pg8::gemm_phase<pg8::EpiResidual, pg8::StaticOrder, pg8::ProbPlain, true, true>(c.lds, c.tid, P, S, E);
}
__device__ __forceinline__ void phase_g1_opt(const Ctx& c, int l) {
    moe_offsets_lds(c, l); const LAS int* offs = (const LAS int*)(c.lds + OFFS_LDS); const int R = offs[NE];
    const pg8::ProbMoeGather P{(const bf16*)(c.ws() + WS_XA), (const bf16*)(c.wl(l) + W_GU), D, (const int*)(c.ws() + WS_ROWTOK), offs, (size_t)1024 * D};
    pg8::StaticOrder S; S.init(R, 1024, c.G, c.bid);
    const pg8::EpiAct E{(bf16*)(c.ws() + WS_ACT)};
    pg8::gemm_phase<pg8::EpiAct, pg8::StaticOrder, pg8::ProbMoeGather, true, true>(c.lds, c.tid, P, S, E);
}
__device__ __forceinline__ void phase_g2_opt(const Ctx& c, int l) {
    moe_offsets_lds(c, l); const LAS int* offs = (const LAS int*)(c.lds + OFFS_LDS); const int R = offs[NE];
    const pg8::ProbMoePlain P{(const bf16*)(c.ws() + WS_ACT), (const bf16*)(c.wl(l) + W_DN), DE, offs, (size_t)D * DE};
    pg8::StaticOrder S; S.init(R, D, c.G, c.bid);
    const pg8::EpiStoreBf16 E{(bf16*)(c.ws() + WS_Y), D};
    pg8::gemm_phase<pg8::EpiStoreBf16, pg8::StaticOrder, pg8::ProbMoePlain, true, true>(c.lds, c.tid, P, S, E);
}

__device__ __forceinline__ void unpack8_(const u32x4 w, float (&f)[8]) { f[0] = bflo(w.x); f[1] = bfhi(w.x); f[2] = bflo(w.y); f[3] = bfhi(w.y); f[4] = bflo(w.z); f[5] = bfhi(w.z); f[6] = bflo(w.w); f[7] = bfhi(w.w); }
typedef short bf16x8 __attribute__((ext_vector_type(8)));
typedef float f32x16 __attribute__((ext_vector_type(16)));
typedef float f32x2_t __attribute__((ext_vector_type(2)));
typedef __bf16 bf16x2_t __attribute__((ext_vector_type(2)));
#define MFMA32(a, b, c) __builtin_amdgcn_mfma_f32_32x32x16_bf16((a), (b), (c), 0, 0, 0)
__device__ __forceinline__ unsigned cvtpk(float lo, float hi) { f32x2_t v = {lo, hi}; bf16x2_t b = __builtin_convertvector(v, bf16x2_t); return __builtin_bit_cast(unsigned, b); }
__device__ __forceinline__ int crow(int i, int h) { return (i & 3) + 8 * (i >> 2) + 4 * h; }
template <int S> __device__ __forceinline__ bf16x8 pack_step(const f32x16& x) {
    u32x4 p; p.x = cvtpk(x[8 * S], x[8 * S + 1]); p.y = cvtpk(x[8 * S + 2], x[8 * S + 3]); p.z = cvtpk(x[8 * S + 4], x[8 * S + 5]); p.w = cvtpk(x[8 * S + 6], x[8 * S + 7]);
    return __builtin_bit_cast(bf16x8, p);
}
__device__ __forceinline__ float logsigmoidf_(float x) { return fminf(x, 0.f) - log1pf(__expf(-fabsf(x))); }
__device__ __forceinline__ float wave_incl_sum(float x, int lane) {
#pragma unroll
    for (int o = 1; o < 64; o <<= 1) { const float y = __shfl_up(x, o); x = (lane >= o) ? x + y : x; }
    return x;
}
__device__ __forceinline__ float wave_incl_max(float x, int lane) {
#pragma unroll
    for (int o = 1; o < 64; o <<= 1) { const float y = __shfl_up(x, o); x = (lane >= o) ? fmaxf(x, y) : x; }
    return x;
}
__device__ __forceinline__ float wave_max(float v) {
#pragma unroll
    for (int o = 1; o < 64; o <<= 1) v = fmaxf(v, __shfl_xor(v, o));
    return v;
}
constexpr size_t WS_NLOC = 3 * MiB;
constexpr size_t WS_MLOC = WS_NLOC + 256 * 1024;
constexpr size_t WS_BLAST = WS_MLOC + 4096;
constexpr size_t WS_MPREV = WS_BLAST + 4096;
static_assert(WS_MPREV + 4096 <= 4 * MiB, "mlstm small state");

__device__ __forceinline__ void swa_unit(const Ctx& c, int l, int u) {
    const int b = u >> 6, kh = (u >> 5) & 1, n = u & 31;
    LAS unsigned char* Ks = c.lds;
    LAS unsigned char* VT = c.lds + 36864;
    LAS float* BT = (LAS float*)(c.lds + 70144);
    const bf16* z = (const bf16*)(c.ws() + WS_Z); bf16* hc = (bf16*)(c.ws() + WS_HCAT);
    const size_t tblk = (size_t)b * SEQ + (size_t)n * 128;
#pragma unroll
    for (int it = 0; it < 4; ++it) { const int idx = c.tid + NT * it, row = idx >> 3, ch = idx & 7; const int srel = n * 128 - 128 + row;
        u32x4 kv = {0u, 0u, 0u, 0u}, vv = {0u, 0u, 0u, 0u};
        if (srel >= 0) { const bf16* zr = z + ((size_t)b * SEQ + srel) * ZW; kv = *(const u32x4*)(zr + Z_KA + kh * 64 + ch * 8); vv = *(const u32x4*)(zr + Z_VA + kh * 64 + ch * 8); }
        *(LAS u32x4*)(Ks + row * 144 + ch * 16) = kv;
        LAS unsigned short* vt = (LAS unsigned short*)(VT + (ch * 8) * 520 + row * 2);
        vt[0] = (unsigned short)(vv.x & 0xffffu); vt[260] = (unsigned short)(vv.x >> 16); vt[2 * 260] = (unsigned short)(vv.y & 0xffffu); vt[3 * 260] = (unsigned short)(vv.y >> 16);
        vt[4 * 260] = (unsigned short)(vv.z & 0xffffu); vt[5 * 260] = (unsigned short)(vv.z >> 16); vt[6 * 260] = (unsigned short)(vv.w & 0xffffu); vt[7 * 260] = (unsigned short)(vv.w >> 16); }
    { const int g = c.tid >> 7, dist = c.tid & 127; BT[c.tid] = c.in(I_RELB)[T5_BUCKET[dist] * AH + kh * 4 + g]; }
    __syncthreads();
    const int r = c.lane & 31, hh = c.lane >> 5, g = c.wave >> 1, head = kh * 4 + g;
    const float sink = c.in(I_SINK)[l * AH + head];
#pragma unroll 1
    for (int jj = 0; jj < 2; ++jj) {
        const int j = (c.wave & 1) * 2 + jj;
        const size_t tq = tblk + 32 * j + r;
        bf16x8 qf[4];
#pragma unroll
        for (int kk = 0; kk < 4; ++kk) qf[kk] = *(const bf16x8*)(z + tq * ZW + Z_QA + head * 64 + 16 * kk + 8 * hh);
        f32x16 X[5];
#pragma unroll
        for (int kt = 0; kt < 5; ++kt) { const int kb0 = 32 * (j + kt);
            f32x16 x = {0.f, 0.f, 0.f, 0.f, 0.f, 0.f, 0.f, 0.f, 0.f, 0.f, 0.f, 0.f, 0.f, 0.f, 0.f, 0.f};
#pragma unroll
            for (int kk = 0; kk < 4; ++kk) { const bf16x8 a = *(const LAS bf16x8*)(Ks + (kb0 + r) * 144 + 32 * kk + 16 * hh); x = MFMA32(a, qf[kk], x); }
            X[kt] = x; asm volatile("" ::: "memory"); }
        float mx = sink;
#pragma unroll
        for (int kt = 0; kt < 5; ++kt) {
#pragma unroll
            for (int i = 0; i < 16; ++i) { const int cr = crow(i, hh), dist = r + 128 - 32 * kt - cr, kb = 32 * (j + kt) + cr;
                const bool valid = (dist >= 0) && (dist < 128) && (n > 0 || kb >= 128);
                const float s = X[kt][i] * 0.125f + BT[g * 128 + (dist & 127)];
                X[kt][i] = valid ? s : -1e30f; mx = fmaxf(mx, X[kt][i]); }
            asm volatile("" ::: "memory"); }
        mx = fmaxf(mx, __shfl_xor(mx, 32));
        float ls = 0.f;
#pragma unroll
        for (int kt = 0; kt < 5; ++kt)
#pragma unroll
            for (int i = 0; i < 16; ++i) { const float p = __expf(X[kt][i] - mx); X[kt][i] = p; ls += p; }
        ls += __shfl_xor(ls, 32);
        const float inv = 1.f / (ls + __expf(sink - mx));
        f32x16 O0 = {0.f, 0.f, 0.f, 0.f, 0.f, 0.f, 0.f, 0.f, 0.f, 0.f, 0.f, 0.f, 0.f, 0.f, 0.f, 0.f}, O1 = O0;
#pragma unroll
        for (int kt = 0; kt < 5; ++kt) { const int kb0 = 32 * (j + kt);
            X[kt] = X[kt] * inv;
            const bf16x8 p0 = pack_step<0>(X[kt]), p1 = pack_step<1>(X[kt]);
            const LAS unsigned char* v0 = VT + r * 520 + (kb0 + 4 * hh) * 2; const LAS unsigned char* v1 = VT + (32 + r) * 520 + (kb0 + 4 * hh) * 2;
            { const u32x2 lo = *(const LAS u32x2*)(v0), hi = *(const LAS u32x2*)(v0 + 16); const u32x4 w = {lo.x, lo.y, hi.x, hi.y}; O0 = MFMA32(p0, __builtin_bit_cast(bf16x8, w), O0); }
            { const u32x2 lo = *(const LAS u32x2*)(v0 + 32), hi = *(const LAS u32x2*)(v0 + 48); const u32x4 w = {lo.x, lo.y, hi.x, hi.y}; O0 = MFMA32(p1, __builtin_bit_cast(bf16x8, w), O0); }
            { const u32x2 lo = *(const LAS u32x2*)(v1), hi = *(const LAS u32x2*)(v1 + 16); const u32x4 w = {lo.x, lo.y, hi.x, hi.y}; O1 = MFMA32(p0, __builtin_bit_cast(bf16x8, w), O1); }
            { const u32x2 lo = *(const LAS u32x2*)(v1 + 32), hi = *(const LAS u32x2*)(v1 + 48); const u32x4 w = {lo.x, lo.y, hi.x, hi.y}; O1 = MFMA32(p1, __builtin_bit_cast(bf16x8, w), O1); }
            asm volatile("" ::: "memory"); }
        bf16* ob = hc + (tblk + 32 * j) * D + 512 + head * 64 + r;
#pragma unroll
        for (int i = 0; i < 16; ++i) { const int q = crow(i, hh); ob[(size_t)q * D] = (bf16)f2bf(O0[i]); ob[(size_t)q * D + 32] = (bf16)f2bf(O1[i]); }
    }
    __syncthreads();
}

struct ChunkGates { float ig, bcum, blast; };
__device__ __forceinline__ ChunkGates chunk_gates(const Ctx& c, size_t t0, int h) {
    const float* IFG = (const float*)(c.ws() + WS_IFG);
    ChunkGates g; g.ig = IFG[(t0 + c.lane) * 8 + h]; const float fp = IFG[(t0 + c.lane) * 8 + 4 + h];
    g.bcum = wave_incl_sum(logsigmoidf_(fp), c.lane); g.blast = __shfl(g.bcum, 63); return g;
}
__device__ __forceinline__ void conv8(const Ctx& c, int l, const bf16* zrow, int spos, int zc0, int cc0, float scale, float (&out)[8]) {
    const float* cw = c.in(I_CONVW) + (size_t)l * 4 * 512 + cc0; const float* cb = c.in(I_CONVB) + l * 512 + cc0;
    { const f32x4 b0 = *(const f32x4*)cb, b1 = *(const f32x4*)(cb + 4); out[0] = b0.x; out[1] = b0.y; out[2] = b0.z; out[3] = b0.w; out[4] = b1.x; out[5] = b1.y; out[6] = b1.z; out[7] = b1.w; }
#pragma unroll
    for (int j = 0; j < 4; ++j) { const int sj = spos - 3 + j;
        if (sj >= 0) { float zv[8]; unpack8_(*(const u32x4*)(zrow + (ptrdiff_t)(j - 3) * ZW + zc0), zv);
            const f32x4 w0 = *(const f32x4*)(cw + j * 512), w1 = *(const f32x4*)(cw + j * 512 + 4);
            out[0] += w0.x * zv[0]; out[1] += w0.y * zv[1]; out[2] += w0.z * zv[2]; out[3] += w0.w * zv[3]; out[4] += w1.x * zv[4]; out[5] += w1.y * zv[5]; out[6] += w1.z * zv[6]; out[7] += w1.w * zv[7]; } }
#pragma unroll
    for (int i = 0; i < 8; ++i) out[i] = siluf_(out[i]) * scale;
}

__device__ __forceinline__ void mlstm_local_unit(const Ctx& c, int l, int u) {
    const int b = u >> 8, h = (u >> 6) & 3, ch = u & 63;
    const size_t t0 = (size_t)b * SEQ + (size_t)ch * 64;
    LAS unsigned char* kT = c.lds;
    LAS unsigned char* avT = c.lds + 9216;
    LAS float* a_l = (LAS float*)(c.lds + 27648);
    const bf16* z = (const bf16*)(c.ws() + WS_Z);
    const ChunkGates g = chunk_gates(c, t0, h);
    const float w = g.blast - g.bcum + g.ig; const float mloc = wave_max(w); const float a = __expf(w - mloc);
    if (c.wave == 0) a_l[c.lane] = a;
    { const int lp = c.tid >> 3, c8 = c.tid & 7; float kc[8];
      conv8(c, l, z + (t0 + lp) * ZW, ch * 64 + lp, Z_KM + h * 64 + c8 * 8, 256 + h * 64 + c8 * 8, 1.f, kc);
      LAS unsigned short* d = (LAS unsigned short*)(kT + (c8 * 8) * 144 + lp * 2);
#pragma unroll
      for (int i = 0; i < 8; ++i) d[i * 72] = (unsigned short)f2bf(kc[i]); }
    __syncthreads();
#pragma unroll
    for (int it = 0; it < 2; ++it) { const int idx = c.tid + NT * it, lp = idx >> 4, c16 = idx & 15; float vv[8]; unpack8_(*(const u32x4*)(z + (t0 + lp) * ZW + Z_VM + h * 128 + c16 * 8), vv);
        const float al = a_l[lp]; LAS unsigned short* d = (LAS unsigned short*)(avT + (c16 * 8) * 144 + lp * 2);
#pragma unroll
        for (int i = 0; i < 8; ++i) d[i * 72] = (unsigned short)f2bf(vv[i] * al); }
    __syncthreads();
    const int r = c.lane & 31, hh = c.lane >> 5, dt = c.wave >> 1, et = c.wave & 1;
    f32x16 acc = {0.f, 0.f, 0.f, 0.f, 0.f, 0.f, 0.f, 0.f, 0.f, 0.f, 0.f, 0.f, 0.f, 0.f, 0.f, 0.f};
#pragma unroll
    for (int kk = 0; kk < 4; ++kk) { const bf16x8 af = *(const LAS bf16x8*)(avT + (32 * dt + r) * 144 + 32 * kk + 16 * hh), bfr = *(const LAS bf16x8*)(kT + (32 * et + r) * 144 + 32 * kk + 16 * hh); acc = MFMA32(af, bfr, acc); }
    float* CL = (float*)(c.ws() + WS_XA) + (size_t)u * 8192;
#pragma unroll
    for (int i = 0; i < 16; ++i) CL[(32 * dt + crow(i, hh)) * 64 + 32 * et + r] = acc[i];
    if (c.tid < 64) { float s = 0.f; const LAS unsigned short* kr = (const LAS unsigned short*)(kT + c.tid * 144);
#pragma unroll 8
        for (int lp = 0; lp < 64; ++lp) s += a_l[lp] * bf2f(kr[lp]);
        ((float*)(c.ws() + WS_NLOC))[(size_t)u * 64 + c.tid] = s;
        if (c.tid == 0) { ((float*)(c.ws() + WS_MLOC))[u] = mloc; ((float*)(c.ws() + WS_BLAST))[u] = g.blast; } }
    __syncthreads();
}

__device__ __forceinline__ void phase_scan(const Ctx& c) {
    LAS float* ml = (LAS float*)c.lds; LAS float* bl = ml + 64;
    for (int w = c.bid; w < 256; w += c.G) {
        const int bh = w >> 4, slice = w & 15;
        __syncthreads();
        if (c.tid < 64) { ml[c.tid] = ((const float*)(c.ws() + WS_MLOC))[bh * 64 + c.tid]; bl[c.tid] = ((const float*)(c.ws() + WS_BLAST))[bh * 64 + c.tid]; }
        __syncthreads();
        float* CL = (float*)(c.ws() + WS_XA) + (size_t)bh * 64 * 8192 + slice * 512 + c.tid;
        float x[64];
#pragma unroll
        for (int ch = 0; ch < 64; ++ch) x[ch] = CL[(size_t)ch * 8192];
        float m = 0.f, C = 0.f;
#pragma unroll
        for (int ch = 0; ch < 64; ++ch) { CL[(size_t)ch * 8192] = C;
            const float mn = fmaxf(bl[ch] + m, ml[ch]); const float dec = __expf(bl[ch] + m - mn), fr = __expf(ml[ch] - mn);
            C = dec * C + fr * x[ch]; m = mn; }
        if (slice == 0 && c.tid < 64) { float* NL = (float*)(c.ws() + WS_NLOC) + (size_t)bh * 64 * 64 + c.tid; float* MP = (float*)(c.ws() + WS_MPREV) + bh * 64;
            float xv[64];
#pragma unroll
            for (int ch = 0; ch < 64; ++ch) xv[ch] = NL[ch * 64];
            float mm = 0.f, nn = 0.f;
#pragma unroll
            for (int ch = 0; ch < 64; ++ch) { NL[ch * 64] = nn; if (c.tid == 0) MP[ch] = mm;
                const float mn = fmaxf(bl[ch] + mm, ml[ch]); const float dec = __expf(bl[ch] + mm - mn), fr = __expf(ml[ch] - mn);
                nn = dec * nn + fr * xv[ch]; mm = mn; } }
    }
    __syncthreads();
}

__device__ __forceinline__ void stage_conv_lds(const Ctx& c, int l, int h, LAS float* cwl) {
    const float* cw = c.in(I_CONVW) + (size_t)l * 4 * 512; const float* cb = c.in(I_CONVB) + l * 512;
    for (int i = c.tid; i < 640; i += NT) { if (i < 512) { const int j = i >> 7, chn = i & 127; cwl[i] = cw[j * 512 + (chn < 64 ? h * 64 + chn : 256 + h * 64 + chn - 64)]; } else { const int chn = i - 512; cwl[i] = cb[chn < 64 ? h * 64 + chn : 256 + h * 64 + chn - 64]; } }
}
__device__ __forceinline__ void conv8_regs(const u32x4 (&zt)[4], const LAS float* cwl, int ch0, float scale, float (&out)[8]) {
    { const f32x4 b0 = *(const LAS f32x4*)(cwl + 512 + ch0), b1 = *(const LAS f32x4*)(cwl + 512 + ch0 + 4); out[0] = b0.x; out[1] = b0.y; out[2] = b0.z; out[3] = b0.w; out[4] = b1.x; out[5] = b1.y; out[6] = b1.z; out[7] = b1.w; }
#pragma unroll
    for (int j = 0; j < 4; ++j) { float zv[8]; unpack8_(zt[j], zv); const f32x4 w0 = *(const LAS f32x4*)(cwl + j * 128 + ch0), w1 = *(const LAS f32x4*)(cwl + j * 128 + ch0 + 4);
        out[0] += w0.x * zv[0]; out[1] += w0.y * zv[1]; out[2] += w0.z * zv[2]; out[3] += w0.w * zv[3]; out[4] += w1.x * zv[4]; out[5] += w1.y * zv[5]; out[6] += w1.z * zv[6]; out[7] += w1.w * zv[7]; }
#pragma unroll
    for (int i = 0; i < 8; ++i) out[i] = siluf_(out[i]) * scale;
}
struct OutLoads { float ig, fp, mprev, np; u32x4 zq[4], zk[4], zv[2], og[2]; };
__device__ __forceinline__ void mlstm_out_load(const Ctx& c, int u, OutLoads& L) {
    const int b = u >> 8, h = (u >> 6) & 3, ch = u & 63; const size_t t0 = (size_t)b * SEQ + (size_t)ch * 64;
    const bf16* z = (const bf16*)(c.ws() + WS_Z); const float* IFG = (const float*)(c.ws() + WS_IFG);
    L.ig = IFG[(t0 + c.lane) * 8 + h]; L.fp = IFG[(t0 + c.lane) * 8 + 4 + h];
    L.mprev = ((const float*)(c.ws() + WS_MPREV))[u]; L.np = ((const float*)(c.ws() + WS_NLOC))[(size_t)u * 64 + c.lane];
    const int lp = c.tid >> 3, c8 = c.tid & 7; const bf16* zr = z + (t0 + lp) * ZW; const int spos = ch * 64 + lp;
#pragma unroll
    for (int j = 0; j < 4; ++j) { const bool ok = spos - 3 + j >= 0; const bf16* zt = zr + (ptrdiff_t)(j - 3) * ZW;
        L.zq[j] = ok ? *(const u32x4*)(zt + Z_QM + h * 64 + c8 * 8) : (u32x4){0u, 0u, 0u, 0u}; L.zk[j] = ok ? *(const u32x4*)(zt + Z_KM + h * 64 + c8 * 8) : (u32x4){0u, 0u, 0u, 0u}; }
#pragma unroll
    for (int it = 0; it < 2; ++it) { const int idx = c.tid + NT * it, lp2 = idx >> 4, c16 = idx & 15; L.zv[it] = *(const u32x4*)(z + (t0 + lp2) * ZW + Z_VM + h * 128 + c16 * 8); }
    { const int part = c.tid & 7; const bf16* og = z + (t0 + lp) * ZW + Z_OM + h * 128 + part * 16; L.og[0] = *(const u32x4*)og; L.og[1] = *(const u32x4*)(og + 8); }
}
__device__ __forceinline__ void mlstm_out_compute(const Ctx& c, int l, int u, const OutLoads& L, const LAS float* cwl) {
    const int b = u >> 8, h = (u >> 6) & 3, ch = u & 63;
    const size_t t0 = (size_t)b * SEQ + (size_t)ch * 64;
    LAS unsigned char* qs = c.lds;
    LAS unsigned char* qis = c.lds + 9216;
    LAS unsigned char* ks = c.lds + 18432;
    LAS unsigned char* vT = c.lds + 27648;
    LAS float* T_bm = (LAS float*)(c.lds + 46080);
    LAS float* T_g = T_bm + 64;
    LAS float* T_em = T_bm + 128;
    LAS float* T_np = T_bm + 192;
    LAS float* T_ri = T_bm + 256;
    LAS float* hbuf = (LAS float*)(c.lds + 47616);
    bf16* hc = (bf16*)(c.ws() + WS_HCAT);
    f32x4 cp[8];
    { const int r_ = c.lane & 31, hh_ = c.lane >> 5, dt_ = c.wave & 3; const float* CP = (const float*)(c.ws() + WS_XA) + (size_t)u * 8192 + (size_t)(32 * dt_ + r_) * 64 + 8 * hh_;
#pragma unroll
      for (int kk = 0; kk < 4; ++kk) { cp[2 * kk] = *(const f32x4*)(CP + 16 * kk); cp[2 * kk + 1] = *(const f32x4*)(CP + 16 * kk + 4); } }
    const float bcum = wave_incl_sum(logsigmoidf_(L.fp), c.lane);
    const float gg = L.ig - bcum; const float pm = wave_incl_max(gg, c.lane);
    const float mrow = bcum + fmaxf(L.mprev, pm); const float inter = __expf(bcum + L.mprev - mrow);
    if (c.wave == 0) { T_bm[c.lane] = bcum - mrow; T_g[c.lane] = gg; T_em[c.lane] = __expf(-mrow); T_np[c.lane] = L.np; }
    { const int lp = c.tid >> 3, c8 = c.tid & 7; float qc[8], kc[8];
      conv8_regs(L.zq, cwl, c8 * 8, 0.125f, qc); conv8_regs(L.zk, cwl, 64 + c8 * 8, 1.f, kc);
      const float il = __shfl(inter, lp);
      u32x4 w; w.x = cvtpk(qc[0], qc[1]); w.y = cvtpk(qc[2], qc[3]); w.z = cvtpk(qc[4], qc[5]); w.w = cvtpk(qc[6], qc[7]); *(LAS u32x4*)(qs + lp * 144 + c8 * 16) = w;
      w.x = cvtpk(qc[0] * il, qc[1] * il); w.y = cvtpk(qc[2] * il, qc[3] * il); w.z = cvtpk(qc[4] * il, qc[5] * il); w.w = cvtpk(qc[6] * il, qc[7] * il); *(LAS u32x4*)(qis + lp * 144 + c8 * 16) = w;
      w.x = cvtpk(kc[0], kc[1]); w.y = cvtpk(kc[2], kc[3]); w.z = cvtpk(kc[4], kc[5]); w.w = cvtpk(kc[6], kc[7]); *(LAS u32x4*)(ks + lp * 144 + c8 * 16) = w; }
#pragma unroll
    for (int it = 0; it < 2; ++it) { const int idx = c.tid + NT * it, lp = idx >> 4, c16 = idx & 15; const u32x4 vv = L.zv[it];
        LAS unsigned short* d = (LAS unsigned short*)(vT + (c16 * 8) * 144 + lp * 2);
        d[0] = (unsigned short)(vv.x & 0xffffu); d[72] = (unsigned short)(vv.x >> 16); d[2 * 72] = (unsigned short)(vv.y & 0xffffu); d[3 * 72] = (unsigned short)(vv.y >> 16);
        d[4 * 72] = (unsigned short)(vv.z & 0xffffu); d[5 * 72] = (unsigned short)(vv.z >> 16); d[6 * 72] = (unsigned short)(vv.w & 0xffffu); d[7 * 72] = (unsigned short)(vv.w >> 16); }
    __syncthreads();
    const int r = c.lane & 31, hh = c.lane >> 5, lt = c.wave >> 2, dt = c.wave & 3;
    f32x16 acc = {0.f, 0.f, 0.f, 0.f, 0.f, 0.f, 0.f, 0.f, 0.f, 0.f, 0.f, 0.f, 0.f, 0.f, 0.f, 0.f};
    float den = 0.f;
    const float bm = T_bm[32 * lt + r];
#pragma unroll
    for (int st = 0; st < 2; ++st) { if (st <= lt) {
        f32x16 X = {0.f, 0.f, 0.f, 0.f, 0.f, 0.f, 0.f, 0.f, 0.f, 0.f, 0.f, 0.f, 0.f, 0.f, 0.f, 0.f};
#pragma unroll
        for (int kk = 0; kk < 4; ++kk) { const bf16x8 af = *(const LAS bf16x8*)(ks + (32 * st + r) * 144 + 32 * kk + 16 * hh), bfr = *(const LAS bf16x8*)(qs + (32 * lt + r) * 144 + 32 * kk + 16 * hh); X = MFMA32(af, bfr, X); }
#pragma unroll
        for (int i = 0; i < 16; ++i) { const int sx = 32 * st + crow(i, hh); const float wgt = (sx <= 32 * lt + r) ? __expf(bm + T_g[sx]) : 0.f; X[i] *= wgt; den += X[i]; }
        const bf16x8 p0 = pack_step<0>(X), p1 = pack_step<1>(X);
        const LAS unsigned char* v0 = vT + (32 * dt + r) * 144 + (32 * st + 4 * hh) * 2;
        { const u32x2 lo = *(const LAS u32x2*)(v0), hi = *(const LAS u32x2*)(v0 + 16); const u32x4 w = {lo.x, lo.y, hi.x, hi.y}; acc = MFMA32(p0, __builtin_bit_cast(bf16x8, w), acc); }
        { const u32x2 lo = *(const LAS u32x2*)(v0 + 32), hi = *(const LAS u32x2*)(v0 + 48); const u32x4 w = {lo.x, lo.y, hi.x, hi.y}; acc = MFMA32(p1, __builtin_bit_cast(bf16x8, w), acc); } } }
#pragma unroll
    for (int kk = 0; kk < 4; ++kk) { const f32x4 c0 = cp[2 * kk], c1 = cp[2 * kk + 1];
        u32x4 w; w.x = cvtpk(c0.x, c0.y); w.y = cvtpk(c0.z, c0.w); w.z = cvtpk(c1.x, c1.y); w.w = cvtpk(c1.z, c1.w);
        const bf16x8 af = *(const LAS bf16x8*)(qis + (32 * lt + r) * 144 + 32 * kk + 16 * hh); acc = MFMA32(af, __builtin_bit_cast(bf16x8, w), acc); }
    { const LAS unsigned char* qr = qis + (32 * lt + r) * 144 + 64 * hh;
#pragma unroll
      for (int q4 = 0; q4 < 4; ++q4) { float qv[8]; unpack8_(*(const LAS u32x4*)(qr + 16 * q4), qv);
#pragma unroll
          for (int i = 0; i < 8; ++i) den += qv[i] * T_np[32 * hh + 8 * q4 + i]; } }
    den += __shfl_xor(den, 32);
    if (hh == 0) T_ri[32 * lt + r] = 1.f / fmaxf(fabsf(den), T_em[32 * lt + r]);
    asm volatile("s_waitcnt lgkmcnt(0)" ::: "memory");
#pragma unroll
    for (int i = 0; i < 16; ++i) { const int lr = 32 * lt + crow(i, hh); hbuf[lr * 132 + 32 * dt + r] = acc[i] * T_ri[lr]; }
    __syncthreads();
    { const int lp = c.tid >> 3, part = c.tid & 7; const LAS float* hr = hbuf + lp * 132 + part * 16; float hv[16]; float ss = 0.f;
#pragma unroll
      for (int q4 = 0; q4 < 4; ++q4) { const f32x4 v = *(const LAS f32x4*)(hr + 4 * q4); hv[4 * q4] = v.x; hv[4 * q4 + 1] = v.y; hv[4 * q4 + 2] = v.z; hv[4 * q4 + 3] = v.w; ss += (v.x * v.x + v.y * v.y) + (v.z * v.z + v.w * v.w); }
      ss += __shfl_xor(ss, 1); ss += __shfl_xor(ss, 2); ss += __shfl_xor(ss, 4);
      const float rstd = rsqrtf(ss * (1.f / 128.f) + EPS);
      const int col = h * 128 + part * 16; const float* wm = c.in(I_WMN) + l * 512 + col;
      bf16* op = hc + (t0 + lp) * D + col;
#pragma unroll
      for (int q8 = 0; q8 < 2; ++q8) { float o8[8]; unpack8_(L.og[q8], o8); const f32x4 w0 = *(const f32x4*)(wm + 8 * q8), w1 = *(const f32x4*)(wm + 8 * q8 + 4);
          const float wv[8] = {w0.x, w0.y, w0.z, w0.w, w1.x, w1.y, w1.z, w1.w}; float ov[8];
#pragma unroll
          for (int i = 0; i < 8; ++i) ov[i] = hv[8 * q8 + i] * rstd * wv[i] * sigmoidf_(o8[i]);
          u32x4 w; w.x = cvtpk(ov[0], ov[1]); w.y = cvtpk(ov[2], ov[3]); w.z = cvtpk(ov[4], ov[5]); w.w = cvtpk(ov[6], ov[7]); *(u32x4*)(op + 8 * q8) = w; } }
    __syncthreads();
}
__device__ __forceinline__ void mlstm_out_quad(const Ctx& c, int l, int u0) {
    LAS float* cwl = (LAS float*)(c.lds + 81920);
    __syncthreads();
    stage_conv_lds(c, l, (u0 >> 6) & 3, cwl);
    OutLoads A; mlstm_out_load(c, u0, A);
    __syncthreads();
#pragma unroll 1
    for (int k = 0; k < 4; ++k) { OutLoads B = A; if (k < 3) mlstm_out_load(c, u0 + k + 1, B); mlstm_out_compute(c, l, u0 + k, A, cwl); A = B; }
}

#ifndef OPT_SWA
#define OPT_SWA 1
#endif
#ifndef OPT_MLSTM
#define OPT_MLSTM 1
#endif
__device__ __forceinline__ void phase_mix1_opt(const Ctx& c, int l) {
    if (OPT_SWA) { for (int u = c.bid; u < NB * AKV * 32; u += c.G) swa_unit(c, l, u); } else naive_swa(c, l, 0);
    if (OPT_MLSTM) { for (int u = c.bid * 4; u < NB * MH * 64; u += c.G * 4) for (int k = 0; k < 4; ++k) mlstm_local_unit(c, l, u + k); }
    else if (c.bid < 16) naive_mlstm(c, l, c.bid);
}
__device__ __forceinline__ void phase_mix2_opt(const Ctx& c, int l) {
    if (OPT_MLSTM) { for (int u = c.bid * 4; u < NB * MH * 64; u += c.G * 4) mlstm_out_quad(c, l, u); }
    else phase_mix2(c, l);
}

#define XB_TMO      128
#define XB_XCNT(j)  (256  + 64 * (j))
#define XB_XSUB(j)  (1280 + 64 * (j))
#define XB_XGEN(j)  (2304 + 64 * (j))
#define XB_TOP      3328
#define XB_TOPGEN   3392
#define XCD_BAR_WORDS 3456
#define XB_SPIN_CAP (1u << 22)
constexpr int CW_BAR = 8192;
__device__ __forceinline__ unsigned xb_ld(unsigned* p)              { return __hip_atomic_load(p, __ATOMIC_RELAXED, __HIP_MEMORY_SCOPE_AGENT); }
__device__ __forceinline__ unsigned xb_add(unsigned* p, unsigned v) { return __hip_atomic_fetch_add(p, v, __ATOMIC_RELAXED, __HIP_MEMORY_SCOPE_AGENT); }
__device__ __forceinline__ unsigned xb_xcc_id() { return (unsigned)__builtin_amdgcn_s_getreg((3 << 11) | 20) & 0xFu; }
#define XB_SPIN(cond, bar) do { unsigned _sp = 0; while (cond) { __builtin_amdgcn_s_sleep(1); \
    if ((++_sp & 255u) == 0u) { if (xb_ld(&(bar)[XB_TMO])) break; if (_sp > XB_SPIN_CAP) { atomicAdd(&(bar)[XB_TMO], 1u); break; } } } } while (0)
struct XcdBarrier { unsigned* bar; unsigned x; volatile LAS unsigned* st; };
__device__ __forceinline__ XcdBarrier xcd_barrier_post(unsigned* bar, volatile LAS unsigned* st) {
    XcdBarrier b; b.bar = bar; b.x = xb_xcc_id(); b.st = st;
    if (threadIdx.x == 0) { (void)xb_add(&bar[XB_XCNT(b.x)], 1u); st[2] = b.x; }
    return b;
}
__device__ __forceinline__ void xcd_barrier_complete(unsigned* bar, unsigned x, unsigned& nloc, unsigned& nx) {
    const unsigned G = gridDim.x * gridDim.y * gridDim.z;
    unsigned sum, cnt, mine, sp = 0u;
    for (;;) {
        sum = 0u; cnt = 0u; mine = 0u;
#pragma unroll
        for (unsigned j = 0; j < 16; ++j) { const unsigned c = xb_ld(&bar[XB_XCNT(j)]); sum += c; cnt += (c > 0u) ? 1u : 0u; mine = (j == x) ? c : mine; }
        if (sum == G) break;
        __builtin_amdgcn_s_sleep(1);
        if ((++sp & 255u) == 0u) { if (xb_ld(&bar[XB_TMO])) break; if (sp > XB_SPIN_CAP) { atomicAdd(&bar[XB_TMO], 1u); break; } }
    }
    nloc = mine > 0u ? mine : 1u; nx = cnt > 0u ? cnt : 1u;
}
__device__ __forceinline__ void xcd_barrier(const XcdBarrier& b, int wave) {
    asm volatile("s_waitcnt vmcnt(0)" ::: "memory");
    __syncthreads();
    unsigned z0_ = 0u; asm volatile("" : "+v"(z0_));
    if (wave == 0 && __builtin_amdgcn_mbcnt_hi(~0u, __builtin_amdgcn_mbcnt_lo(~0u, z0_)) == 0u) {
        unsigned* bar = b.bar;
        __builtin_amdgcn_s_waitcnt(0);
        unsigned nloc = b.st[0], nx = b.st[1]; const unsigned bx = b.st[2];
        if (nloc == 0u) { xcd_barrier_complete(bar, bx, nloc, nx); b.st[0] = nloc; b.st[1] = nx; }
        const unsigned old = xb_add(&bar[XB_XSUB(bx)], 1u);
        const unsigned gen = old / nloc;
        if (old + 1u == (gen + 1u) * nloc) {
            __builtin_amdgcn_fence(__ATOMIC_RELEASE, "agent");
            asm volatile("s_waitcnt vmcnt(0)" ::: "memory");
            const unsigned og = xb_add(&bar[XB_TOP], 1u);
            const unsigned tg = og / nx;
            if (og + 1u == (tg + 1u) * nx) xb_add(&bar[XB_TOPGEN], 1u);
            else XB_SPIN(xb_ld(&bar[XB_TOPGEN]) == tg, bar);
            __builtin_amdgcn_fence(__ATOMIC_ACQUIRE, "agent");
            xb_add(&bar[XB_XGEN(bx)], 1u);
            asm volatile("s_waitcnt vmcnt(0)" ::: "memory");
        } else {
            XB_SPIN(xb_ld(&bar[XB_XGEN(bx)]) == gen, bar);
            __builtin_amdgcn_fence(__ATOMIC_ACQUIRE, "agent");
            asm volatile("s_waitcnt vmcnt(0)" ::: "memory");
        }
    }
    __syncthreads();
}

constexpr int MISC_OFF = 143360 + 320;
#ifndef MK_MULTI
#define MK_MULTI 0
#endif
constexpr int PH_PER_LAYER = 11, NPHASES = 1 + DEPTH * PH_PER_LAYER;
__device__ __forceinline__ void run_phase(const Ctx& c, int l, int p) {
    switch (p) {
        case 0: phase_xn(c, l); break;
        case 1: phase_inproj(c, l); break;
        case 2: phase_mix1(c, l); break;
        case 3: phase_mix2(c, l); break;
        case 4: phase_br(c, l); break;
        case 5: phase_out(c, l); break;
        case 6: phase_route(c, l); break;
        case 7: phase_fill(c, l); break;
        case 8: phase_g1(c, l); break;
        case 9: phase_g2(c, l); break;
        case 10: phase_combine(c, l); break;
    }
}
__global__ void __launch_bounds__(NT, 2) mega(Args a) {
    extern __shared__ __attribute__((aligned(16))) unsigned char lds_raw[];
    Ctx c; c.karg = (kptr_t)__builtin_amdgcn_kernarg_segment_ptr(); c.lds = (LAS unsigned char*)lds_raw; c.tid = threadIdx.x; c.lane = c.tid & 63; c.wave = __builtin_amdgcn_readfirstlane(c.tid >> 6); c.G = gridDim.x; c.bid = blockIdx.x;
#if MK_MULTI
    { const int ph = a.ph_lo; if (ph == 0) { phase_prologue(c); return; } run_phase(c, (ph - 1) / PH_PER_LAYER, (ph - 1) % PH_PER_LAYER); }
#else
    volatile LAS unsigned* MISC = (volatile LAS unsigned*)(c.lds + MISC_OFF);
    if (c.tid < 32) MISC[c.tid] = 0u;
    __syncthreads();
    const XcdBarrier bar = xcd_barrier_post(c.ctl() + CW_BAR, MISC + 8);
#ifndef REP_PHASE
#define REP_PHASE -1
#endif
#ifndef REP_N
#define REP_N 1
#endif
#define PH(call) do { Ctx f = c; asm volatile("" : "+s"(f.karg)); asm volatile("" : "+v"(f.tid)); f.lane = f.tid & 63; { const Ctx& c = f; call; } } while (0)
#ifndef PROBE_TS
#define PROBE_TS 0
#endif
#ifndef PROBE_A
#define PROBE_A 0
#endif
#ifndef PROBE_B
#define PROBE_B 1
#endif
#if PROBE_TS
    volatile LAS unsigned* TACC = (volatile LAS unsigned*)(c.lds + MISC_OFF + 256);
    if (c.tid < 20) TACC[c.tid] = 0u;
    __syncthreads();
#define STAMP(id) do { if (c.bid == 0 && c.tid == 0) { const unsigned long long now_ = __builtin_amdgcn_s_memrealtime(); const unsigned long long prev_ = ((unsigned long long)TACC[17] << 32) | TACC[16]; \
        if (prev_) TACC[id] += (unsigned)(now_ - prev_); TACC[16] = (unsigned)now_; TACC[17] = (unsigned)(now_ >> 32); } } while (0)
    STAMP(15);
#else
#define STAMP(id) do { } while (0)
#endif
#define RP(id, call) do { for (int rep_ = 0; rep_ < ((id) == REP_PHASE ? REP_N : 1); ++rep_) { PH(call); xcd_barrier(bar, c.wave); STAMP(id); } } while (0)
    RP(0, phase_prologue(c));
#pragma unroll 1
    for (int l = 0; l < DEPTH; ++l) {
        if (l == 0) RP(1, phase_xn(c, l));
        if (OPT_GEMM) RP(2, phase_inproj_opt(c, l)); else RP(2, phase_inproj(c, l));
        if (OPT_MIX) { RP(3, phase_mix1_opt(c, l)); if (OPT_MLSTM) { RP(4, phase_scan(c)); } RP(5, phase_mix2_opt(c, l)); }
        else { RP(3, phase_mix1(c, l)); RP(5, phase_mix2(c, l)); }
        if (OPT_GEMM) RP(6, phase_br_opt(c, l)); else RP(6, phase_br(c, l));
        if (OPT_GEMM) RP(7, phase_out_opt(c, l)); else RP(7, phase_out(c, l));
        RP(8, phase_route(c, l));
        RP(9, phase_fill(c, l));
        if (OPT_GEMM) RP(10, phase_g1_opt(c, l)); else RP(10, phase_g1(c, l));
        if (OPT_GEMM) RP(11, phase_g2_opt(c, l)); else RP(11, phase_g2(c, l));
#if PROBE_TS
        PH(phase_combine(c, l)); xcd_barrier(bar, c.wave); STAMP(12);
#else
        PH(phase_combine(c, l)); if (l + 1 < DEPTH) xcd_barrier(bar, c.wave);
#endif
    }
#if PROBE_TS
    if (c.bid == 0) { const float ta = (float)TACC[PROBE_A] * 0.01f, tb = (float)TACC[PROBE_B] * 0.01f;
        if (c.tid == 0) c.out()[0] += 2.f + 0.25f * ta;
        const float eps = sqrtf(tb * 2e-5f * 256.f);
        for (int i = c.tid; i < 65536; i += NT) c.out()[4096 + i] += eps; }
#endif
#undef RP
#undef PH
#endif
}

extern "C" void kernel_launch(void* const* d_in, const int* in_sizes, int n_in, void* d_out, int out_size, void* d_ws, size_t ws_size, hipStream_t stream) {
    static int grid = 0;
    if (grid == 0) {
        if (n_in != 23 || out_size != T * D || ws_size < WS_END) { fprintf(stderr, "kernel_launch: unexpected shapes (n_in %d out %d ws %zu need %zu)\n", n_in, out_size, ws_size, (size_t)WS_END); grid = -1; return; }
        int dev = 0, cus = 0, per_cu = 0;
        if (hipGetDevice(&dev) != hipSuccess || hipDeviceGetAttribute(&cus, hipDeviceAttributeMultiprocessorCount, dev) != hipSuccess) { grid = -1; return; }
        if (hipFuncSetAttribute((const void*)mega, hipFuncAttributeMaxDynamicSharedMemorySize, LDS_BYTES) != hipSuccess) { grid = -1; return; }
        if (hipOccupancyMaxActiveBlocksPerMultiprocessor(&per_cu, (const void*)mega, NT, LDS_BYTES) != hipSuccess || per_cu < 1) { fprintf(stderr, "kernel_launch: occupancy query says %d blocks per CU\n", per_cu); (void)hipGetLastError(); grid = -1; return; }
        grid = cus;
    }
    if (grid < 0) return;
    (void)hipMemsetAsync((char*)d_ws + WS_CTL, 0, CTL_BYTES, stream);
    Args a{};
    for (int i = 0; i < 23; ++i) a.in[i] = (const float*)d_in[i];
    a.out = (float*)d_out; a.ws = (unsigned char*)d_ws;
#if MK_MULTI
    for (int ph = 0; ph < NPHASES; ++ph) { a.ph_lo = ph; a.ph_hi = ph + 1; hipLaunchKernelGGL(mega, dim3(grid), dim3(NT), LDS_BYTES, stream, a); }
#else
    a.ph_lo = 0; a.ph_hi = NPHASES;
    hipLaunchKernelGGL(mega, dim3(grid), dim3(NT), LDS_BYTES, stream, a);
#endif
}
```
